# Optimizing an MI355X kernel written in HIP

```python
import jax, jax.numpy as jnp
from jax import lax
import numpy as np

D_MODEL = 1024
BATCH = 16
SEQ = 256
DEPTH = 2
DEC_BATCH = 4
DEC_SEQ = 4096
PAST_LEN = 512

GRID_W = 64
N_MIXERS = 2
N_CONV_LAYERS = (DEPTH + 1) // 2
N_MLA_LAYERS = DEPTH // 2
D_CONV = D_MODEL
CONV_K = 3
N_HEADS = 16
QK_NOPE = 64
QK_ROPE = 32
V_HEAD = 64
Q_LORA = 384
KV_LORA = 256
QK_HEAD = QK_NOPE + QK_ROPE
MLA_GATE = N_HEADS * V_HEAD
MLA_IN = Q_LORA + KV_LORA + QK_ROPE + MLA_GATE
ROPE_BASE = 10000.0
EPS = 1e-6
Q_BLOCK = 128
SM_SCALE = QK_HEAD ** -0.5

kernel_name = "hybrid_conv_mla_diffusion_step"


def rmsnorm(x, g):
    xf = x.astype(jnp.float32)
    y = xf * lax.rsqrt(jnp.mean(xf * xf, axis=-1, keepdims=True) + EPS)
    return (y * g.astype(jnp.float32)).astype(x.dtype)


def modulation(cond, w_mod, b_mod):
    m = jax.nn.silu(cond) @ w_mod + b_mod
    return jnp.split(m, 3, axis=-1)


def axial_angles(n_tok):
    rows = n_tok // GRID_W
    row = jnp.repeat(jnp.arange(rows), GRID_W).astype(jnp.float32)
    col = jnp.tile(jnp.arange(GRID_W), rows).astype(jnp.float32)
    half = QK_ROPE // 2
    freqs = jnp.power(ROPE_BASE, -jnp.arange(0, half, 2, dtype=jnp.float32) / half)
    return row[:, None] * freqs, col[:, None] * freqs


def _rotate(x, ang):
    n = x.shape[-1] // 2
    x1, x2 = x[..., :n], x[..., n:]
    cos = jnp.cos(ang).astype(x.dtype)
    sin = jnp.sin(ang).astype(x.dtype)
    return jnp.concatenate([x1 * cos - x2 * sin, x1 * sin + x2 * cos], axis=-1)


def axial_rope(x, ang_r, ang_c):
    half = QK_ROPE // 2
    return jnp.concatenate([_rotate(x[..., :half], ang_r), _rotate(x[..., half:], ang_c)], axis=-1)


def short_conv_mixer(h, w_in, conv_w, w_out):
    b, cg, u, z = jnp.split(h @ w_in, 4, axis=-1)
    v = cg * u
    vp = jnp.pad(v, ((0, 0), (1, 1), (0, 0)))
    conv = conv_w[0] * vp[:, :-2] + conv_w[1] * vp[:, 1:-1] + conv_w[2] * vp[:, 2:]
    return (jax.nn.silu(z) * b * conv) @ w_out


def mla_project(h, w_in, q_norm_g, w_q_up, kv_norm_g):
    B, T, _ = h.shape
    q_lat, kv_lat, k_rope, gate = jnp.split(
        h @ w_in, [Q_LORA, Q_LORA + KV_LORA, Q_LORA + KV_LORA + QK_ROPE], axis=-1)
    q = (rmsnorm(q_lat, q_norm_g) @ w_q_up).reshape(B, T, N_HEADS, QK_HEAD)
    ckv = rmsnorm(kv_lat, kv_norm_g)
    return q, ckv, k_rope, gate


def mla_expand(ckv, k_rope, w_kv_up):
    B, L, _ = ckv.shape
    kv = (ckv @ w_kv_up).reshape(B, L, N_HEADS, QK_NOPE + V_HEAD)
    k_nope, v = kv[..., :QK_NOPE], kv[..., QK_NOPE:]
    k_r = jnp.broadcast_to(k_rope[:, :, None, :], (B, L, N_HEADS, QK_ROPE))
    return jnp.concatenate([k_nope, k_r], axis=-1), v


def block_attention(q, k, v):
    B, T, H, Dk = q.shape
    nb = T // Q_BLOCK
    qb = q.reshape(B, nb, Q_BLOCK, H, Dk).transpose(1, 0, 2, 3, 4)

    def one(qi):
        s = jnp.einsum('bqhd,bkhd->bhqk', qi, k, preferred_element_type=jnp.float32) * SM_SCALE
        p = jax.nn.softmax(s, axis=-1).astype(v.dtype)
        return jnp.einsum('bhqk,bkhd->bqhd', p, v)

    o = lax.map(one, qb)
    return o.transpose(1, 0, 2, 3, 4).reshape(B, T, H, v.shape[-1])


def setup_inputs(seed: int = 0) -> dict:
    key = jax.random.key(seed)
    ks = jax.random.split(key, 24)
    f32 = jnp.float32
    D = D_MODEL

    def nrm(k, shape, scale):
        return jax.random.normal(k, shape, f32) * scale

    return {
        "x_prompt": nrm(ks[0], (BATCH, SEQ, D), 1.0),
        "x_sample": nrm(ks[1], (DEC_BATCH, DEC_SEQ, D), 1.0),
        "cache_ckv": nrm(ks[2], (DEC_BATCH, N_MLA_LAYERS, PAST_LEN, KV_LORA), 1.0),
        "cache_krope": nrm(ks[3], (DEC_BATCH, N_MLA_LAYERS, PAST_LEN, QK_ROPE), 1.0),
        "c": nrm(ks[4], (DEC_BATCH, D), 1.0),
        "c_ctx": nrm(ks[5], (D,), 1.0),
        "norm_g": 1.0 + nrm(ks[6], (DEPTH, D), 0.02),
        "w_mod": nrm(ks[7], (DEPTH, D, 3 * D), 0.5 * D ** -0.5),
        "b_mod": nrm(ks[8], (DEPTH, 3 * D), 0.02),
        "conv_w_in": nrm(ks[9], (N_CONV_LAYERS, D, 4 * D_CONV), D ** -0.5),
        "conv_w": nrm(ks[10], (N_CONV_LAYERS, CONV_K, D_CONV), CONV_K ** -0.5),
        "conv_w_out": nrm(ks[11], (N_CONV_LAYERS, D_CONV, D), D_CONV ** -0.5),
        "mla_w_in": nrm(ks[12], (N_MLA_LAYERS, D, MLA_IN), D ** -0.5),
        "mla_q_norm_g": 1.0 + nrm(ks[13], (N_MLA_LAYERS, Q_LORA), 0.02),
        "mla_w_q_up": nrm(ks[14], (N_MLA_LAYERS, Q_LORA, N_HEADS * QK_HEAD), Q_LORA ** -0.5),
        "mla_kv_norm_g": 1.0 + nrm(ks[15], (N_MLA_LAYERS, KV_LORA), 0.02),
        "mla_w_kv_up": nrm(ks[16], (N_MLA_LAYERS, KV_LORA, N_HEADS * (QK_NOPE + V_HEAD)), KV_LORA ** -0.5),
        "mla_w_out": nrm(ks[17], (N_MLA_LAYERS, N_HEADS * V_HEAD, D), (N_HEADS * V_HEAD) ** -0.5),
        "final_norm_g": 1.0 + nrm(ks[18], (D,), 0.02),
    }


def reference(x_prompt, x_sample, cache_ckv, cache_krope, c, c_ctx, norm_g, w_mod, b_mod,
              conv_w_in, conv_w, conv_w_out, mla_w_in, mla_q_norm_g, mla_w_q_up,
              mla_kv_norm_g, mla_w_kv_up, mla_w_out, final_norm_g):
    xp, xs = x_prompt, x_sample
    Bs, Ts, _ = x_sample.shape
    ang_r, ang_c = axial_angles(Ts)
    cond_ctx = c_ctx[None, None, :]
    cond_lat = c[:, None, :]
    ckv_states, krope_states = [], []

    for i in range(DEPTH):
        sh_p, sc_p, g_p = modulation(cond_ctx, w_mod[i], b_mod[i])
        sh_s, sc_s, g_s = modulation(cond_lat, w_mod[i], b_mod[i])
        hp = rmsnorm(xp, norm_g[i]) * (1.0 + sc_p) + sh_p
        hs = rmsnorm(xs, norm_g[i]) * (1.0 + sc_s) + sh_s
        j = i // N_MIXERS
        if i % N_MIXERS == 0:
            op = short_conv_mixer(hp, conv_w_in[j], conv_w[j], conv_w_out[j])
            os_ = short_conv_mixer(hs, conv_w_in[j], conv_w[j], conv_w_out[j])
        else:
            q_p, ckv_p, kr_p, gate_p = mla_project(hp, mla_w_in[j], mla_q_norm_g[j], mla_w_q_up[j], mla_kv_norm_g[j])
            ckv_states.append(ckv_p)
            krope_states.append(kr_p)
            k_p, v_p = mla_expand(ckv_p, kr_p, mla_w_kv_up[j])
            o_p = block_attention(q_p, k_p, v_p)
            Bp, Tp = hp.shape[0], hp.shape[1]
            op = (o_p.reshape(Bp, Tp, N_HEADS * V_HEAD) * jax.nn.silu(gate_p)) @ mla_w_out[j]
            q_s, ckv_s, kr_s, gate_s = mla_project(hs, mla_w_in[j], mla_q_norm_g[j], mla_w_q_up[j], mla_kv_norm_g[j])
            q_s = jnp.concatenate(
                [q_s[..., :QK_NOPE], axial_rope(q_s[..., QK_NOPE:], ang_r[:, None, :], ang_c[:, None, :])], axis=-1)
            kr_s = axial_rope(kr_s, ang_r, ang_c)
            k_s, v_s = mla_expand(ckv_s, kr_s, mla_w_kv_up[j])
            k_c, v_c = mla_expand(cache_ckv[:, j], cache_krope[:, j], mla_w_kv_up[j])
            k_all = jnp.concatenate([k_c, k_s], axis=1)
            v_all = jnp.concatenate([v_c, v_s], axis=1)
            o_s = block_attention(q_s, k_all, v_all)
            os_ = (o_s.reshape(Bs, Ts, N_HEADS * V_HEAD) * jax.nn.silu(gate_s)) @ mla_w_out[j]
        xp = xp + g_p * op
        xs = xs + g_s * os_

    y_prompt = rmsnorm(xp, final_norm_g)
    y_sample = rmsnorm(xs, final_norm_g)
    state_ckv = jnp.stack(ckv_states, axis=1)
    state_krope = jnp.stack(krope_states, axis=1)
    return (y_prompt, y_sample, state_ckv, state_krope)
```

```cpp
#include <hip/hip_runtime.h>
#include <math.h>
#include <cstdio>

namespace nv {
constexpr int DM = 1024;
constexpr int NCTX = 16 * 256, NLAT = 4 * 4096, MTOK = NCTX + NLAT;
constexpr int NCACHE = 4 * 512, MKV = MTOK + NCACHE;
constexpr int Q_LORA = 384, KV_LORA = 256, QK_ROPE = 32, NH = 16, MLA_IN = 1696;
constexpr float EPS = 1e-6f;
constexpr size_t MiB = 1u << 20;

__device__ __forceinline__ int tok_group(int t) { return t < NCTX ? 0 : 1 + (t - NCTX) / 4096; }
__device__ __forceinline__ float silu(float x) { return x / (1.f + expf(-x)); }

__global__ void k_mod(const float* c, const float* c_ctx, const float* w_mod, const float* b_mod, float* mod) {
  int idx = blockIdx.x * blockDim.x + threadIdx.x;
  if (idx >= 2 * 3072) return;
  int i = idx / 3072, n = idx % 3072;
  float a0 = 0, a1 = 0, a2 = 0, a3 = 0, a4 = 0;
  const float* w = w_mod + (size_t)i * 1024 * 3072 + n;
  for (int k = 0; k < 1024; ++k) {
    float wv = w[(size_t)k * 3072];
    a0 += silu(c_ctx[k]) * wv; a1 += silu(c[k]) * wv; a2 += silu(c[1024 + k]) * wv; a3 += silu(c[2048 + k]) * wv; a4 += silu(c[3072 + k]) * wv;
  }
  float b = b_mod[i * 3072 + n];
  mod[(i * 5 + 0) * 3072 + n] = a0 + b; mod[(i * 5 + 1) * 3072 + n] = a1 + b; mod[(i * 5 + 2) * 3072 + n] = a2 + b;
  mod[(i * 5 + 3) * 3072 + n] = a3 + b; mod[(i * 5 + 4) * 3072 + n] = a4 + b;
}

__device__ __forceinline__ float block_sum256(float s, float* red) {
  for (int o = 32; o > 0; o >>= 1) s += __shfl_xor(s, o);
  __syncthreads();
  if ((threadIdx.x & 63) == 0) red[threadIdx.x >> 6] = s;
  __syncthreads();
  return red[0] + red[1] + red[2] + red[3];
}

__global__ __launch_bounds__(256) void k_hnorm(const float* xa, const float* xb, const float* ng, const float* modl, float* h) {
  __shared__ float red[4];
  int t = blockIdx.x; const float* x = t < NCTX ? xa + (size_t)t * 1024 : xb + (size_t)(t - NCTX) * 1024;
  int g = tok_group(t);
  float v0 = x[threadIdx.x], v1 = x[threadIdx.x + 256], v2 = x[threadIdx.x + 512], v3 = x[threadIdx.x + 768];
  float s = block_sum256(v0 * v0 + v1 * v1 + v2 * v2 + v3 * v3, red);
  float rstd = 1.0f / sqrtf(s / 1024.f + EPS);
  const float* sh = modl + g * 3072; const float* sc = sh + 1024;
  float* o = h + (size_t)t * 1024;
  int k = threadIdx.x;
  o[k] = v0 * rstd * ng[k] * (1.f + sc[k]) + sh[k]; k += 256;
  o[k] = v1 * rstd * ng[k] * (1.f + sc[k]) + sh[k]; k += 256;
  o[k] = v2 * rstd * ng[k] * (1.f + sc[k]) + sh[k]; k += 256;
  o[k] = v3 * rstd * ng[k] * (1.f + sc[k]) + sh[k];
}

enum { EP_STORE = 0, EP_MUL = 1, EP_MULSILU = 2, EP_RESID = 3 };
struct GemmP { const float* A; int lda; const float* B; int ldb; float* C; int ldc; int M, N, K; const float* xa; const float* xb; const float* gate; int pad; };
template <int EP> __global__ __launch_bounds__(256) void k_gemm(GemmP p) {
  __shared__ float As[16][68]; __shared__ float Bs[16][68];
  const int tx = threadIdx.x & 15, ty = threadIdx.x >> 4;
  const int m0 = blockIdx.y * 64, n0 = blockIdx.x * 64;
  float acc[4][4];
#pragma unroll
  for (int i = 0; i < 4; ++i)
#pragma unroll
    for (int j = 0; j < 4; ++j) acc[i][j] = 0.f;
  for (int k0 = 0; k0 < p.K; k0 += 16) {
#pragma unroll
    for (int i = 0; i < 4; ++i) { int e = threadIdx.x + 256 * i; int r = e >> 4, kk = e & 15; As[kk][r] = p.A[(size_t)(m0 + r) * p.lda + k0 + kk]; }
#pragma unroll
    for (int i = 0; i < 4; ++i) { int e = threadIdx.x + 256 * i; int kk = e >> 6, cn = e & 63; int col = n0 + cn; Bs[kk][cn] = col < p.N ? p.B[(size_t)(k0 + kk) * p.ldb + col] : 0.f; }
    __syncthreads();
#pragma unroll
    for (int kk = 0; kk < 16; ++kk) {
      float a[4], b[4];
#pragma unroll
      for (int i = 0; i < 4; ++i) { a[i] = As[kk][ty * 4 + i]; b[i] = Bs[kk][tx * 4 + i]; }
#pragma unroll
      for (int i = 0; i < 4; ++i)
#pragma unroll
        for (int j = 0; j < 4; ++j) acc[i][j] = fmaf(a[i], b[j], acc[i][j]);
    }
    __syncthreads();
  }
#pragma unroll
  for (int i = 0; i < 4; ++i)
#pragma unroll
    for (int j = 0; j < 4; ++j) {
      int row = m0 + ty * 4 + i, col = n0 + tx * 4 + j;
      if (col < p.N) {
        float* c = p.C + (size_t)row * p.ldc + col; float v = acc[i][j];
        if (EP == EP_STORE) *c = v;
        else if (EP == EP_MUL) *c = *c * v;
        else if (EP == EP_MULSILU) *c = *c * silu(v);
        else { const float* x = row < NCTX ? p.xa + (size_t)row * 1024 : p.xb + (size_t)(row - NCTX) * 1024; *c = x[col] + p.gate[tok_group(row) * 3072 + col] * v; }
      }
    }
}

__global__ void k_conv(const float* v, float* e, const float* cw) {
  size_t idx = (size_t)blockIdx.x * blockDim.x + threadIdx.x;
  int t = (int)(idx >> 10), j = (int)(idx & 1023);
  int pos, len; if (t < NCTX) { pos = t & 255; len = 256; } else { pos = (t - NCTX) & 4095; len = 4096; }
  float vm = pos > 0 ? v[idx - 1024] : 0.f, v0 = v[idx], vp = pos < len - 1 ? v[idx + 1024] : 0.f;
  e[idx] = e[idx] * (cw[j] * vm + cw[1024 + j] * v0 + cw[2048 + j] * vp);
}

__global__ __launch_bounds__(256) void k_mla_post(const float* P3, const float* gq, const float* gkv, const float* cache_ckv, const float* cache_krope,
                                                 float* qn, float* ckv, float* krb, float* state_ckv, float* state_krope) {
  __shared__ float red[4];
  int t = blockIdx.x, tid = threadIdx.x;
  if (t >= MTOK) { int r = t - MTOK; ckv[(size_t)t * 256 + tid] = cache_ckv[(size_t)r * 256 + tid]; if (tid < 32) krb[(size_t)t * 32 + tid] = cache_krope[(size_t)r * 32 + tid]; return; }
  const float* row = P3 + (size_t)t * MLA_IN;
  float q0 = row[tid], q1 = tid < 128 ? row[256 + tid] : 0.f;
  float sq = block_sum256(q0 * q0 + q1 * q1, red);
  float rq = 1.0f / sqrtf(sq / 384.f + EPS);
  qn[(size_t)t * 384 + tid] = q0 * rq * gq[tid]; if (tid < 128) qn[(size_t)t * 384 + 256 + tid] = q1 * rq * gq[256 + tid];
  float kv = row[384 + tid];
  float sk = block_sum256(kv * kv, red);
  float rk = 1.0f / sqrtf(sk / 256.f + EPS);
  float cv = kv * rk * gkv[tid];
  ckv[(size_t)t * 256 + tid] = cv; if (t < NCTX) state_ckv[(size_t)t * 256 + tid] = cv;
  if (tid < 32) {
    const float* kr = row + 640;
    if (t < NCTX) { state_krope[(size_t)t * 32 + tid] = kr[tid]; krb[(size_t)t * 32 + tid] = kr[tid]; }
    else {
      int pos = (t - NCTX) & 4095; int half = tid >> 4, kk = tid & 15, i = kk & 7;
      double ang = (double)(half ? (pos & 63) : (pos >> 6)) * pow(10000.0, -(double)(2 * i) / 16.0);
      float cs = (float)cos(ang), sn = (float)sin(ang);
      float x1 = kr[half * 16 + i], x2 = kr[half * 16 + 8 + i];
      krb[(size_t)t * 32 + tid] = kk < 8 ? x1 * cs - x2 * sn : x1 * sn + x2 * cs;
    }
  }
}

__global__ __launch_bounds__(256) void k_attn(const float* qg  , const float* kvg  , const float* krb  , float* P3, int hg) {
  __shared__ float Ks[32][96]; __shared__ float Vs[32][64];
  const int tid = threadIdx.x, hh = blockIdx.y, h = hg * 2 + hh, bi = blockIdx.x;
  int t, nk0, base0, nk1, base1;
  if (bi < 64) { int b = bi >> 4; t = NCTX + b * 4096 + (bi & 15) * 256 + tid; base0 = MTOK + b * 512; nk0 = 512; base1 = NCTX + b * 4096; nk1 = 4096; }
  else { int b = bi - 64; t = b * 256 + tid; base0 = b * 256; nk0 = 256; base1 = 0; nk1 = 0; }
  float q[96];
  { const float* qp = qg + (size_t)t * 192 + hh * 96;
#pragma unroll
    for (int d = 0; d < 96; ++d) q[d] = qp[d];
    if (t >= NCTX) { int pos = (t - NCTX) & 4095;
#pragma unroll
      for (int half = 0; half < 2; ++half)
#pragma unroll
        for (int i = 0; i < 8; ++i) {
          double ang = (double)(half ? (pos & 63) : (pos >> 6)) * pow(10000.0, -(double)(2 * i) / 16.0);
          float cs = (float)cos(ang), sn = (float)sin(ang);
          float x1 = q[64 + half * 16 + i], x2 = q[64 + half * 16 + 8 + i];
          q[64 + half * 16 + i] = x1 * cs - x2 * sn; q[64 + half * 16 + 8 + i] = x1 * sn + x2 * cs;
        }
    }
    const float sc = 0.10206207261596577f;
#pragma unroll
    for (int d = 0; d < 96; ++d) q[d] *= sc; }
  float o[64];
#pragma unroll
  for (int d = 0; d < 64; ++d) o[d] = 0.f;
  float m = -INFINITY, l = 0.f;
  const int ntile = (nk0 + nk1) / 32;
  for (int jt = 0; jt < ntile; ++jt) {
    int k0 = jt * 32; int rbase = k0 < nk0 ? base0 + k0 : base1 + (k0 - nk0);
    __syncthreads();
#pragma unroll
    for (int i = 0; i < 8; ++i) { int e = tid + 256 * i; int r = e >> 6, d = e & 63; const float* src = kvg + (size_t)(rbase + r) * 256 + hh * 128; Ks[r][d] = src[d]; Vs[r][d] = src[64 + d]; }
#pragma unroll
    for (int i = 0; i < 4; ++i) { int e = tid + 256 * i; int r = e >> 5, d = e & 31; Ks[r][64 + d] = krb[(size_t)(rbase + r) * 32 + d]; }
    __syncthreads();
    for (int j = 0; j < 32; ++j) {
      float s = 0.f;
#pragma unroll
      for (int d = 0; d < 96; ++d) s = fmaf(q[d], Ks[j][d], s);
      float mn = fmaxf(m, s); float al = expf(m - mn), pj = expf(s - mn);
      l = l * al + pj; m = mn;
#pragma unroll
      for (int d = 0; d < 64; ++d) o[d] = fmaf(pj, Vs[j][d], o[d] * al);
    }
  }
  float il = 1.0f / l;
  float* gp = P3 + (size_t)t * MLA_IN + 672 + h * 64;
#pragma unroll
  for (int d = 0; d < 64; ++d) gp[d] = o[d] * il * silu(gp[d]);
}

__global__ __launch_bounds__(256) void k_final(float* x, const float* g) {
  __shared__ float red[4];
  float* r = x + (size_t)blockIdx.x * 1024;
  float v0 = r[threadIdx.x], v1 = r[threadIdx.x + 256], v2 = r[threadIdx.x + 512], v3 = r[threadIdx.x + 768];
  float s = block_sum256(v0 * v0 + v1 * v1 + v2 * v2 + v3 * v3, red);
  float rstd = 1.0f / sqrtf(s / 1024.f + EPS);
  r[threadIdx.x] = v0 * rstd * g[threadIdx.x]; r[threadIdx.x + 256] = v1 * rstd * g[threadIdx.x + 256];
  r[threadIdx.x + 512] = v2 * rstd * g[threadIdx.x + 512]; r[threadIdx.x + 768] = v3 * rstd * g[threadIdx.x + 768];
}

template <int EP> void gemm(hipStream_t s, const float* A, int lda, const float* B, int ldb, float* C, int ldc, int M, int N, int K,
                            const float* xa = nullptr, const float* xb = nullptr, const float* gate = nullptr) {
  GemmP p{}; p.A = A; p.lda = lda; p.B = B; p.ldb = ldb; p.C = C; p.ldc = ldc; p.M = M; p.N = N; p.K = K; p.xa = xa; p.xb = xb; p.gate = gate; p.pad = 0;
  hipLaunchKernelGGL((k_gemm<EP>), dim3((N + 63) / 64, M / 64), dim3(256), 0, s, p);
}

void forward(void* const* d_in, float* out, char* ws, hipStream_t s) {
  const float* x_prompt = (const float*)d_in[0]; const float* x_sample = (const float*)d_in[1];
  const float* cache_ckv = (const float*)d_in[2]; const float* cache_krope = (const float*)d_in[3];
  const float* c = (const float*)d_in[4]; const float* c_ctx = (const float*)d_in[5];
  const float* norm_g = (const float*)d_in[6]; const float* w_mod = (const float*)d_in[7]; const float* b_mod = (const float*)d_in[8];
  const float* conv_w_in = (const float*)d_in[9]; const float* conv_w = (const float*)d_in[10]; const float* conv_w_out = (const float*)d_in[11];
  const float* mla_w_in = (const float*)d_in[12]; const float* gq = (const float*)d_in[13]; const float* w_q_up = (const float*)d_in[14];
  const float* gkv = (const float*)d_in[15]; const float* w_kv_up = (const float*)d_in[16]; const float* w_out = (const float*)d_in[17];
  const float* final_g = (const float*)d_in[18];
  float* buf0 = (float*)(ws); float* buf1 = (float*)(ws + 80 * MiB); float* buf2 = (float*)(ws + 160 * MiB); float* mod = (float*)(ws + 240 * MiB);
  float* y_all = out;
  float* state_ckv = out + (size_t)MTOK * 1024; float* state_krope = state_ckv + (size_t)NCTX * 256;
  hipLaunchKernelGGL(k_mod, dim3(24), dim3(256), 0, s, c, c_ctx, w_mod, b_mod, mod);
  hipLaunchKernelGGL(k_hnorm, dim3(MTOK), dim3(256), 0, s, x_prompt, x_sample, norm_g, mod, buf0);
  gemm<EP_STORE>(s, buf0, 1024, conv_w_in + 1024, 4096, buf1, 1024, MTOK, 1024, 1024);
  gemm<EP_MUL>(s, buf0, 1024, conv_w_in + 2048, 4096, buf1, 1024, MTOK, 1024, 1024);
  gemm<EP_STORE>(s, buf0, 1024, conv_w_in, 4096, buf2, 1024, MTOK, 1024, 1024);
  gemm<EP_MULSILU>(s, buf0, 1024, conv_w_in + 3072, 4096, buf2, 1024, MTOK, 1024, 1024);
  hipLaunchKernelGGL(k_conv, dim3(MTOK * 1024 / 256), dim3(256), 0, s, buf1, buf2, conv_w);
  gemm<EP_RESID>(s, buf2, 1024, conv_w_out, 1024, y_all, 1024, MTOK, 1024, 1024, x_prompt, x_sample, mod + 2048);
  const float* mod1 = mod + 5 * 3072;
  hipLaunchKernelGGL(k_hnorm, dim3(MTOK), dim3(256), 0, s, y_all, y_all + (size_t)NCTX * 1024, norm_g + 1024, mod1, buf0);
  float* P3 = buf1;
  gemm<EP_STORE>(s, buf0, 1024, mla_w_in, MLA_IN, P3, MLA_IN, MTOK, MLA_IN, 1024);
  float* qn = (float*)(ws); float* ckv = (float*)(ws + 30 * MiB); float* krb = (float*)(ws + 52 * MiB);
  float* qg = (float*)(ws + 55 * MiB); float* kvg = (float*)(ws + 214 * MiB);
  hipLaunchKernelGGL(k_mla_post, dim3(MKV), dim3(256), 0, s, P3, gq, gkv, cache_ckv, cache_krope, qn, ckv, krb, state_ckv, state_krope);
  for (int hg = 0; hg < 8; ++hg) {
    gemm<EP_STORE>(s, qn, 384, w_q_up + hg * 192, 1536, qg, 192, MTOK, 192, 384);
    gemm<EP_STORE>(s, ckv, 256, w_kv_up + hg * 256, 2048, kvg, 256, MKV, 256, 256);
    hipLaunchKernelGGL(k_attn, dim3(80, 2), dim3(256), 0, s, qg, kvg, krb, P3, hg);
  }
  gemm<EP_RESID>(s, P3 + 672, MLA_IN, w_out, 1024, y_all, 1024, MTOK, 1024, 1024, y_all, y_all + (size_t)NCTX * 1024, mod1 + 2048);
  hipLaunchKernelGGL(k_final, dim3(MTOK), dim3(256), 0, s, y_all, final_g);
}
}

extern "C" void kernel_launch(void* const* d_in, const int* in_sizes, int n_in, void* d_out, int out_size, void* d_ws, size_t ws_size, hipStream_t stream) {
  if (n_in != 19 || ws_size < 242 * nv::MiB) { fprintf(stderr, "kernel_launch: unexpected n_in %d / ws %zu\n", n_in, ws_size); return; }
  nv::forward(d_in, (float*)d_out, (char*)d_ws, stream);
}
```

```cpp
#include <hip/hip_runtime.h>
#include <cstdio>
#include <cstdint>
#include <cmath>
namespace pg8 {
#define PG8_LAS __attribute__((address_space(3)))
typedef unsigned short bf16_t;
typedef short bf16x8 __attribute__((ext_vector_type(8)));
typedef float f32x4 __attribute__((ext_vector_type(4)));
typedef unsigned u32x4 __attribute__((ext_vector_type(4)));
constexpr int BM = 256, BK = 64, HALF = 128, HTB = HALF * BK * 2  , STAGE_BYTES = 8 * HTB, NXCD = 8, WGM = 8;

__host__ __device__ __forceinline__ int lds_byte(int r, int c) { const int st = (r >> 4) * 2 + (c >> 5), rr = r & 15, cc = c & 31, ob = rr * 64 + cc * 2; return st * 1024 + (ob ^ (((ob >> 9) & 1) << 5)); }
__host__ __device__ __forceinline__ void stage_rc(int b, int& R, int& C) { const int st = b / 1024, sb = b % 1024, swz = sb ^ (((sb >> 9) & 1) << 5); R = (st >> 1) * 16 + swz / 64; C = (st & 1) * 32 + (swz % 64) / 2; }
__host__ __device__ __forceinline__ int perm32(int rho) { const int n = rho >> 4, i = rho & 15; return 8 * (i >> 2) + 4 * n + (i & 3); }

struct Unit { int pm, pn; };
struct Gemm { const bf16_t* A; const bf16_t* Bt; int M, N, K; };

struct StaticOrder {
    int nM, nN, nwg, G, c;
    __host__ __device__ void init(int M, int N, int G_, int c_) { nM = M / BM; nN = N / BM; nwg = nM * nN; G = G_; c = c_; }
    __host__ __device__ bool next(int i, Unit& u) const {
        const long L = (long)i * G + c; if (L >= nwg) return false;
        int wgid = (int)L; { const int q = nwg / NXCD, r = nwg % NXCD, xcd = wgid % NXCD, off = wgid / NXCD; wgid = (xcd < r ? xcd * (q + 1) : r * (q + 1) + (xcd - r) * q) + off; }
        const int nig = WGM * nN, gid = wgid / nig, fm = gid * WGM, gsz = (nM - fm) < WGM ? (nM - fm) : WGM;
        u.pm = fm + ((wgid % nig) % gsz); u.pn = (wgid % nig) / gsz; return true;
    }
    __device__ __forceinline__ void a_ready(const Unit&) const {}
    __device__ __forceinline__ void done(const Unit&) const {}
};

__device__ __forceinline__ unsigned cvt_pk_bf16(float lo, float hi) { unsigned r; asm volatile("v_cvt_pk_bf16_f32 %0, %1, %2" : "=v"(r) : "v"(lo), "v"(hi)); return r; }
typedef float f32x2 __attribute__((ext_vector_type(2)));
constexpr int NCTX = 4096, MTOK = 20480, MKV = 22528;
constexpr float RMS_EPS = 1e-6f;
constexpr float QSCALE = 0.10206207261596577f * 1.4426950408889634f;
__device__ __forceinline__ int grp_of_pm(int pm) { return pm < 16 ? 0 : 1 + ((pm - 16) >> 4); }
__device__ __forceinline__ float fsilu(float x) { return x * __builtin_amdgcn_rcpf(1.f + __builtin_amdgcn_exp2f(-1.4426950408889634f * x)); }
__device__ __forceinline__ u32x4 pack8(const f32x4& a, const f32x4& b) { u32x4 w; w.x = cvt_pk_bf16(a[0], a[1]); w.y = cvt_pk_bf16(a[2], a[3]); w.z = cvt_pk_bf16(b[0], b[1]); w.w = cvt_pk_bf16(b[2], b[3]); return w; }
__device__ __forceinline__ float dot4(const f32x4& a) { return (a[0] * a[0] + a[1] * a[1]) + (a[2] * a[2] + a[3] * a[3]); }

struct EpiConvIn {
    static constexpr bool PERM = true, AFTER_DRAIN = false;
    bf16_t* V; bf16_t* E;
    __device__ __forceinline__ void operator()(const f32x4 (&acc)[2][2][4][2], const Unit& u, int wr, int wc, int fr, int fq) const {
        const int row0 = u.pm * BM + wr * 64 + fr; const int ch = 128 * (u.pn >> 1) + wc * 32 + 8 * fq; const bool isE = (u.pn & 1) != 0;
        bf16_t* base = (isE ? E : V) + ch;
#pragma unroll
        for (int ai = 0; ai < 2; ++ai)
#pragma unroll
            for (int m = 0; m < 4; ++m) {
                f32x4 a0 = acc[ai][0][m][0], a1 = acc[ai][0][m][1], b0 = acc[ai][1][m][0], b1 = acc[ai][1][m][1];
                if (isE) {
#pragma unroll
                    for (int i = 0; i < 4; ++i) { b0[i] = fsilu(b0[i]); b1[i] = fsilu(b1[i]); } }
                const f32x4 r0 = a0 * b0, r1 = a1 * b1;
                *(u32x4*)(base + (size_t)(row0 + ai * HALF + m * 16) * 1024) = pack8(r0, r1);
            }
    }
};

struct EpiResid {
    static constexpr bool PERM = false, AFTER_DRAIN = false;
    const float* xa; const float* xb; float* out; const float* gate;
    __device__ __forceinline__ void operator()(const f32x4 (&acc)[2][2][4][2], const Unit& u, int wr, int wc, int fr, int fq) const {
        const int row0 = u.pm * BM + wr * 64 + fr, col0 = u.pn * BM + wc * 32 + 4 * fq; const float* gp = gate + grp_of_pm(u.pm) * 3072 + col0;
        f32x4 gv[2][2];
#pragma unroll
        for (int bj = 0; bj < 2; ++bj)
#pragma unroll
            for (int n = 0; n < 2; ++n) gv[bj][n] = *(const f32x4*)(gp + bj * HALF + n * 16);
        const float* src0 = u.pm < 16 ? xa : xb - (size_t)NCTX * 1024;
#pragma unroll
        for (int ai = 0; ai < 2; ++ai)
#pragma unroll
            for (int m = 0; m < 4; ++m) { const size_t off = (size_t)(row0 + ai * HALF + m * 16) * 1024 + col0;
#pragma unroll
                for (int bj = 0; bj < 2; ++bj)
#pragma unroll
                    for (int n = 0; n < 2; ++n) { const f32x4 x = *(const f32x4*)(src0 + off + bj * HALF + n * 16); *(f32x4*)(out + off + bj * HALF + n * 16) = x + gv[bj][n] * acc[ai][bj][m][n]; }
                if (m & 1) asm volatile("" ::: "memory"); }
    }
};

struct EpiDelta {
    static constexpr bool PERM = true, AFTER_DRAIN = false;
    bf16_t* D; const float* gate; int pm0;
    __device__ __forceinline__ void operator()(const f32x4 (&acc)[2][2][4][2], const Unit& u, int wr, int wc, int fr, int fq) const {
        const int row0 = u.pm * BM + wr * 64 + fr, col0 = u.pn * BM + wc * 32 + 8 * fq; const float* gp = gate + grp_of_pm(u.pm + pm0) * 3072 + col0;
        f32x4 gv[2][2];
#pragma unroll
        for (int bj = 0; bj < 2; ++bj)
#pragma unroll
            for (int n = 0; n < 2; ++n) gv[bj][n] = *(const f32x4*)(gp + bj * HALF + 4 * n);
#pragma unroll
        for (int ai = 0; ai < 2; ++ai)
#pragma unroll
            for (int m = 0; m < 4; ++m)
#pragma unroll
                for (int bj = 0; bj < 2; ++bj)
                    *(u32x4*)(D + (size_t)(row0 + ai * HALF + m * 16) * 1024 + col0 + bj * HALF) = pack8(acc[ai][bj][m][0] * gv[bj][0], acc[ai][bj][m][1] * gv[bj][1]);
    }
};

struct EpiMlaIn {
    static constexpr bool PERM = true, AFTER_DRAIN = false;
    bf16_t* CKV; bf16_t* QL; bf16_t* KR; bf16_t* SG;
    float* ssq_kv; float* ssq_q;
    float* st_ckv; float* st_kr;
    const float* gq; const float* gkv; const float* rope;
    __device__ __forceinline__ void operator()(const f32x4 (&acc)[2][2][4][2], const Unit& u, int wr, int wc, int fr, int fq) const {
        const int row0 = u.pm * BM + wr * 64 + fr, c8 = wc * 32 + 8 * fq, pn = u.pn;
        if (pn >= 3) {
            bf16_t* base = SG + (pn - 3) * 256 + c8;
#pragma unroll
            for (int ai = 0; ai < 2; ++ai)
#pragma unroll
                for (int m = 0; m < 4; ++m)
#pragma unroll
                    for (int bj = 0; bj < 2; ++bj) { f32x4 a0 = acc[ai][bj][m][0], a1 = acc[ai][bj][m][1];
#pragma unroll
                        for (int i = 0; i < 4; ++i) { a0[i] = fsilu(a0[i]); a1[i] = fsilu(a1[i]); }
                        *(u32x4*)(base + (size_t)(row0 + ai * HALF + m * 16) * 1024 + bj * HALF) = pack8(a0, a1); }
        } else if (pn <= 1) {
            const float* gsrc = pn == 0 ? gkv : gq; const int ld = pn == 0 ? 256 : 384, nslot = pn == 0 ? 4 : 8;
            bf16_t* dst = pn == 0 ? CKV : QL; float* ssq = pn == 0 ? ssq_kv : ssq_q;
            f32x4 gv[2][2];
#pragma unroll
            for (int bj = 0; bj < 2; ++bj)
#pragma unroll
                for (int n = 0; n < 2; ++n) gv[bj][n] = *(const f32x4*)(gsrc + c8 + bj * HALF + 4 * n);
#pragma unroll
            for (int ai = 0; ai < 2; ++ai)
#pragma unroll
                for (int m = 0; m < 4; ++m) { const int row = row0 + ai * HALF + m * 16; float ss = 0.f;
#pragma unroll
                    for (int bj = 0; bj < 2; ++bj) { const f32x4 a0 = acc[ai][bj][m][0], a1 = acc[ai][bj][m][1]; ss += dot4(a0) + dot4(a1);
                        const f32x4 w0 = a0 * gv[bj][0], w1 = a1 * gv[bj][1];
                        *(u32x4*)(dst + (size_t)row * ld + c8 + bj * HALF) = pack8(w0, w1);
                        if (pn == 0 && u.pm < 16) { float* sp = st_ckv + (size_t)row * 256 + c8 + bj * HALF; *(f32x4*)sp = w0; *(f32x4*)(sp + 4) = w1; } }
                    ss += __shfl_xor(ss, 16); ss += __shfl_xor(ss, 32);
                    if (fq == 0) ssq[(size_t)row * nslot + wc] = ss; }
        } else {
            f32x4 gv[2];
#pragma unroll
            for (int n = 0; n < 2; ++n) gv[n] = *(const f32x4*)(gq + 256 + c8 + 4 * n);
#pragma unroll
            for (int ai = 0; ai < 2; ++ai)
#pragma unroll
                for (int m = 0; m < 4; ++m) { const int row = row0 + ai * HALF + m * 16;
                    const f32x4 a0 = acc[ai][0][m][0], a1 = acc[ai][0][m][1]; float ss = dot4(a0) + dot4(a1);
                    *(u32x4*)(QL + (size_t)row * 384 + 256 + c8) = pack8(a0 * gv[0], a1 * gv[1]);
                    ss += __shfl_xor(ss, 16); ss += __shfl_xor(ss, 32);
                    if (fq == 0) ssq_q[(size_t)row * 8 + 4 + wc] = ss; }
            if (wc == 0) {
#pragma unroll
                for (int ai = 0; ai < 2; ++ai)
#pragma unroll
                    for (int m = 0; m < 4; ++m) { const int row = row0 + ai * HALF + m * 16;
                        f32x4 a0 = acc[ai][1][m][0], a1 = acc[ai][1][m][1];
                        if (u.pm < 16) { float* sp = st_kr + (size_t)row * 32 + 8 * fq; *(f32x4*)sp = a0; *(f32x4*)(sp + 4) = a1; }
                        else {
                            const int pos = (row - NCTX) & 4095, p = (fq >> 1) ? (pos & 63) : (pos >> 6);
                            const f32x4* cs = (const f32x4*)(rope + p * 16); const f32x4 c01 = cs[0], c23 = cs[1], c45 = cs[2], c67 = cs[3];
                            f32x4 p0, p1;
#pragma unroll
                            for (int i = 0; i < 4; ++i) { p0[i] = __shfl_xor(a0[i], 16); p1[i] = __shfl_xor(a1[i], 16); }
                            const float sg = (fq & 1) ? 1.f : -1.f;
                            a0[0] = a0[0] * c01[0] + sg * p0[0] * c01[1]; a0[1] = a0[1] * c01[2] + sg * p0[1] * c01[3];
                            a0[2] = a0[2] * c23[0] + sg * p0[2] * c23[1]; a0[3] = a0[3] * c23[2] + sg * p0[3] * c23[3];
                            a1[0] = a1[0] * c45[0] + sg * p1[0] * c45[1]; a1[1] = a1[1] * c45[2] + sg * p1[1] * c45[3];
                            a1[2] = a1[2] * c67[0] + sg * p1[2] * c67[1]; a1[3] = a1[3] * c67[2] + sg * p1[3] * c67[3];
                        }
                        *(u32x4*)(KR + (size_t)row * 32 + 8 * fq) = pack8(a0, a1); }
            }
        }
    }
};

struct EpiQUp {
    static constexpr bool PERM = true, AFTER_DRAIN = false;
    bf16_t* Q; const float* ssq_q; const float* rope;
    __device__ __forceinline__ void operator()(const f32x4 (&acc)[2][2][4][2], const Unit& u, int wr, int wc, int fr, int fq) const {
        const int row0 = u.pm * BM + wr * 64 + fr, col0 = u.pn * BM + wc * 32 + 8 * fq; const bool latent = u.pm >= 16;
        int d8[2];
#pragma unroll
        for (int bj = 0; bj < 2; ++bj) d8[bj] = ((col0 + bj * HALF) >> 3) % 12;
#pragma unroll
        for (int ai = 0; ai < 2; ++ai)
#pragma unroll
            for (int m = 0; m < 4; ++m) { const int row = row0 + ai * HALF + m * 16;
                const f32x4 s0 = *(const f32x4*)(ssq_q + (size_t)row * 8), s1 = *(const f32x4*)(ssq_q + (size_t)row * 8 + 4);
                const float ss = ((s0[0] + s0[1]) + (s0[2] + s0[3])) + ((s1[0] + s1[1]) + (s1[2] + s1[3]));
                const float rs = QSCALE / sqrtf(ss * (1.f / 384.f) + RMS_EPS);
                const int pos = (row - NCTX) & 4095;
#pragma unroll
                for (int bj = 0; bj < 2; ++bj) { f32x4 a0 = acc[ai][bj][m][0] * rs, a1 = acc[ai][bj][m][1] * rs;
                    if (latent) {
                        f32x4 p0, p1;
#pragma unroll
                        for (int i = 0; i < 4; ++i) { p0[i] = __shfl_xor(a0[i], 16); p1[i] = __shfl_xor(a1[i], 16); }
                        if (d8[bj] >= 8) {
                            const int p = d8[bj] >= 10 ? (pos & 63) : (pos >> 6);
                            const f32x4* cs = (const f32x4*)(rope + p * 16); const f32x4 c01 = cs[0], c23 = cs[1], c45 = cs[2], c67 = cs[3];
                            const float sg = (d8[bj] & 1) ? 1.f : -1.f;
                            a0[0] = a0[0] * c01[0] + sg * p0[0] * c01[1]; a0[1] = a0[1] * c01[2] + sg * p0[1] * c01[3];
                            a0[2] = a0[2] * c23[0] + sg * p0[2] * c23[1]; a0[3] = a0[3] * c23[2] + sg * p0[3] * c23[3];
                            a1[0] = a1[0] * c45[0] + sg * p1[0] * c45[1]; a1[1] = a1[1] * c45[2] + sg * p1[1] * c45[3];
                            a1[2] = a1[2] * c67[0] + sg * p1[2] * c67[1]; a1[3] = a1[3] * c67[2] + sg * p1[3] * c67[3];
                        }
                    }
                    *(u32x4*)(Q + (size_t)row * 1536 + col0 + bj * HALF) = pack8(a0, a1); } }
    }
};

struct EpiKvUp {
    static constexpr bool PERM = true, AFTER_DRAIN = false;
    bf16_t* KV; const float* ssq_kv;
    __device__ __forceinline__ void operator()(const f32x4 (&acc)[2][2][4][2], const Unit& u, int wr, int wc, int fr, int fq) const {
        const int row0 = u.pm * BM + wr * 64 + fr, col0 = u.pn * BM + wc * 32 + 8 * fq; const bool tok = u.pm < MTOK / BM;
#pragma unroll
        for (int ai = 0; ai < 2; ++ai)
#pragma unroll
            for (int m = 0; m < 4; ++m) { const int row = row0 + ai * HALF + m * 16; float rs = 1.f;
                if (tok) { const f32x4 s0 = *(const f32x4*)(ssq_kv + (size_t)row * 4); rs = 1.0f / sqrtf(((s0[0] + s0[1]) + (s0[2] + s0[3])) * (1.f / 256.f) + RMS_EPS); }
#pragma unroll
                for (int bj = 0; bj < 2; ++bj) *(u32x4*)(KV + (size_t)row * 2048 + col0 + bj * HALF) = pack8(acc[ai][bj][m][0] * rs, acc[ai][bj][m][1] * rs); }
    }
};
template <class Epi, class Sched, bool ALIGN_EPI = false, bool SP2 = false>
__device__ __forceinline__ void gemm_phase(PG8_LAS unsigned char* lds, const Gemm g, const Sched& S, const Epi& E) {
    const int tid = threadIdx.x, wid = __builtin_amdgcn_readfirstlane(tid >> 6), lane = tid & 63, wr = wid >> 2, wc = wid & 3, fr = lane & 15, fq = lane >> 4;
    const int K = g.K, nt = K / BK;
    unsigned voffA[2], voffB[2];
#pragma unroll
    for (int i = 0; i < 2; ++i) { int R, C; stage_rc(tid * 16 + i * 8192, R, C); const int Rb = Epi::PERM ? ((R & ~31) + perm32(R & 31)) : R;
        voffA[i] = (unsigned)(R * K + C) * 2u; voffB[i] = (unsigned)(Rb * K + C) * 2u; }
    const size_t kstep = (size_t)(BK * 2);
    const size_t hstep = (size_t)HALF * K * 2;
    const size_t tstep = 2 * hstep;
    const unsigned ldsw = (unsigned)wid * 1024u;
    const int aoff = lds_byte(wr * 64 + fr, fq * 8), boff = lds_byte(wc * 32 + fr, fq * 8);
#define PG8_SA(b, h) (((b) * 2 + (h)) * HTB)
#define PG8_SB(b, h) ((4 + (b) * 2 + (h)) * HTB)
#define PG8_STAGE(bufoff, gbase, voff) do { _Pragma("unroll") for (int _i = 0; _i < 2; ++_i) \
        __builtin_amdgcn_global_load_lds((const unsigned*)((const char*)(gbase) + (voff)[_i]), (PG8_LAS unsigned*)(lds + (bufoff) + ldsw + _i * 8192), 16, 0, 0); } while (0)
#define PG8_LDA(dst, b, h) do { _Pragma("unroll") for (int m = 0; m < 4; ++m) _Pragma("unroll") for (int k = 0; k < 2; ++k) dst[m][k] = *(const PG8_LAS bf16x8*)(lds + PG8_SA(b, h) + aoff + m * 2048 + k * 1024); } while (0)
#define PG8_LDB(dst, b, h) do { _Pragma("unroll") for (int n = 0; n < 2; ++n) _Pragma("unroll") for (int k = 0; k < 2; ++k) dst[n][k] = *(const PG8_LAS bf16x8*)(lds + PG8_SB(b, h) + boff + n * 2048 + k * 1024); } while (0)
#define PG8_MMA(ai, bj, At, Bt) do { __builtin_amdgcn_s_setprio(1); _Pragma("unroll") for (int m = 0; m < 4; ++m) _Pragma("unroll") for (int n = 0; n < 2; ++n) _Pragma("unroll") for (int k = 0; k < 2; ++k) \
        acc[ai][bj][m][n] = __builtin_amdgcn_mfma_f32_16x16x32_bf16(Bt[n][k], At[m][k], acc[ai][bj][m][n], 0, 0, 0); __builtin_amdgcn_s_setprio(0); } while (0)
#define PG8_WAIT_V(n) asm volatile("s_waitcnt vmcnt(" #n ")" ::: "memory")
#define PG8_WAIT_L(n) asm volatile("s_waitcnt lgkmcnt(" #n ")" ::: "memory")
#define PG8_BAR __builtin_amdgcn_s_barrier()
#define PG8_SCHED __builtin_amdgcn_sched_barrier(0)
    Unit cur, nxt; int ui = 0;
    if (!S.next(0, cur)) return;
    f32x4 acc[2][2][4][2];
#pragma unroll
    for (int a = 0; a < 2; ++a)
#pragma unroll
        for (int b = 0; b < 2; ++b)
#pragma unroll
            for (int m = 0; m < 4; ++m)
#pragma unroll
                for (int n = 0; n < 2; ++n) acc[a][b][m][n] = (f32x4){0.f, 0.f, 0.f, 0.f};
    bf16x8 At[4][2], B0[2][2], B1[2][2];
    const char* cA = (const char*)g.A + (size_t)cur.pm * tstep; const char* cB = (const char*)g.Bt + (size_t)cur.pn * tstep;
    S.a_ready(cur);
    if constexpr (SP2) {
        PG8_STAGE(PG8_SB(0, 0), cB, voffB); PG8_STAGE(PG8_SB(0, 1), cB + hstep, voffB); PG8_STAGE(PG8_SA(0, 0), cA, voffA); PG8_STAGE(PG8_SA(0, 1), cA + hstep, voffA);
        if (wr == 1) PG8_BAR;
        PG8_WAIT_V(2); PG8_BAR;
        PG8_STAGE(PG8_SB(1, 0), cB + kstep, voffB); PG8_STAGE(PG8_SA(1, 0), cA + kstep, voffA); PG8_STAGE(PG8_SB(1, 1), cB + hstep + kstep, voffB);
        PG8_WAIT_V(6); PG8_BAR;
    } else {
        PG8_STAGE(PG8_SB(0, 0), cB, voffB); PG8_STAGE(PG8_SA(0, 0), cA, voffA); PG8_STAGE(PG8_SB(0, 1), cB + hstep, voffB); PG8_STAGE(PG8_SA(0, 1), cA + hstep, voffA);
        if (wr == 1) PG8_BAR;
        PG8_WAIT_V(4); PG8_BAR;
        PG8_STAGE(PG8_SB(1, 0), cB + kstep, voffB); PG8_STAGE(PG8_SA(1, 0), cA + kstep, voffA); PG8_STAGE(PG8_SB(1, 1), cB + hstep + kstep, voffB);
        PG8_WAIT_V(6); PG8_BAR;
    }
    for (;;) {
        const bool has_next = S.next(ui + 1, nxt);
        const char* nA = has_next ? (const char*)g.A + (size_t)nxt.pm * tstep : cA; const char* nB = has_next ? (const char*)g.Bt + (size_t)nxt.pn * tstep : cB;
        for (int t = 0; t < nt; t += 2) {
            const bool last = (t == nt - 2);
            const char* a1 = cA + (size_t)(t + 1) * kstep;
            const char* a2 = last ? nA : cA + (size_t)(t + 2) * kstep; const char* b2 = last ? nB : cB + (size_t)(t + 2) * kstep;
            const char* a3 = a2 + kstep; const char* b3 = b2 + kstep;
            if (last && has_next) S.a_ready(nxt);
            if constexpr (SP2) {
            PG8_LDB(B0, 0, 0); PG8_LDB(B1, 0, 1); PG8_SCHED; PG8_LDA(At, 0, 0); PG8_STAGE(PG8_SA(1, 1), a1 + hstep, voffA);
            PG8_WAIT_V(8); PG8_WAIT_L(0); PG8_BAR; PG8_MMA(0, 0, At, B0); PG8_MMA(0, 1, At, B1); PG8_BAR; PG8_SCHED;
            PG8_LDA(At, 0, 1); PG8_STAGE(PG8_SB(0, 0), b2, voffB); PG8_STAGE(PG8_SB(0, 1), b2 + hstep, voffB); PG8_STAGE(PG8_SA(0, 0), a2, voffA);
            PG8_WAIT_V(8); PG8_WAIT_L(0); PG8_BAR; PG8_MMA(1, 0, At, B0); PG8_MMA(1, 1, At, B1); PG8_BAR; PG8_SCHED;
            PG8_LDB(B0, 1, 0); PG8_LDB(B1, 1, 1); PG8_SCHED; PG8_LDA(At, 1, 0); PG8_STAGE(PG8_SA(0, 1), a2 + hstep, voffA);
            PG8_WAIT_V(8); PG8_WAIT_L(0); PG8_BAR; PG8_MMA(0, 0, At, B0); PG8_MMA(0, 1, At, B1); PG8_BAR; PG8_SCHED;
            PG8_LDA(At, 1, 1); PG8_STAGE(PG8_SB(1, 0), b3, voffB); PG8_STAGE(PG8_SB(1, 1), b3 + hstep, voffB); PG8_STAGE(PG8_SA(1, 0), a3, voffA);
            PG8_WAIT_V(8); PG8_WAIT_L(0); PG8_BAR; PG8_MMA(1, 0, At, B0); PG8_MMA(1, 1, At, B1); PG8_BAR; PG8_SCHED;
            } else {
            PG8_LDB(B0, 0, 0); PG8_SCHED; PG8_LDA(At, 0, 0); PG8_STAGE(PG8_SA(1, 1), a1 + hstep, voffA);
            PG8_WAIT_L(8); PG8_BAR; PG8_WAIT_L(0); PG8_MMA(0, 0, At, B0); PG8_BAR; PG8_SCHED;
            PG8_LDB(B1, 0, 1); PG8_STAGE(PG8_SB(0, 0), b2, voffB);
            PG8_BAR; PG8_WAIT_L(0); PG8_MMA(0, 1, At, B1); PG8_BAR;
            PG8_LDA(At, 0, 1); PG8_STAGE(PG8_SA(0, 0), a2, voffA);
            PG8_BAR; PG8_WAIT_L(0); PG8_MMA(1, 0, At, B0); PG8_BAR; PG8_SCHED;
            PG8_STAGE(PG8_SB(0, 1), b2 + hstep, voffB);
            PG8_WAIT_V(6); PG8_BAR; PG8_MMA(1, 1, At, B1); PG8_BAR;
            PG8_LDB(B0, 1, 0); PG8_SCHED; PG8_LDA(At, 1, 0); PG8_STAGE(PG8_SA(0, 1), a2 + hstep, voffA);
            PG8_WAIT_L(8); PG8_BAR; PG8_WAIT_L(0); PG8_MMA(0, 0, At, B0); PG8_BAR; PG8_SCHED;
            PG8_LDB(B1, 1, 1); PG8_STAGE(PG8_SB(1, 0), b3, voffB);
            PG8_BAR; PG8_WAIT_L(0); PG8_MMA(0, 1, At, B1); PG8_BAR;
            PG8_LDA(At, 1, 1); PG8_STAGE(PG8_SA(1, 0), a3, voffA);
            PG8_BAR; PG8_WAIT_L(0); PG8_MMA(1, 0, At, B0); PG8_BAR; PG8_SCHED;
            PG8_STAGE(PG8_SB(1, 1), b3 + hstep, voffB);
            PG8_WAIT_V(6); PG8_BAR; PG8_MMA(1, 1, At, B1); PG8_BAR;
            }
        }
        if constexpr (ALIGN_EPI) { if (wr == 0) PG8_BAR; }
        if constexpr (!Epi::AFTER_DRAIN) { E(acc, cur, wr, wc, fr, fq); S.done(cur); }
        if (!has_next) break;
#pragma unroll
        for (int a = 0; a < 2; ++a)
#pragma unroll
            for (int b = 0; b < 2; ++b)
#pragma unroll
                for (int m = 0; m < 4; ++m)
#pragma unroll
                    for (int n = 0; n < 2; ++n) acc[a][b][m][n] = (f32x4){0.f, 0.f, 0.f, 0.f};
        cur = nxt; cA = nA; cB = nB; ++ui;
        if constexpr (ALIGN_EPI) { if (wr == 1) PG8_BAR; }
    }
    PG8_WAIT_V(0);
    if constexpr (!ALIGN_EPI) { if (wr == 0) PG8_BAR; }
    PG8_BAR;
    if constexpr (Epi::AFTER_DRAIN) { E.fused(acc, cur, wr, wc, fr, fq, lds, wid, lane); S.done(cur); }
#undef PG8_SA
#undef PG8_SB
#undef PG8_STAGE
#undef PG8_LDA
#undef PG8_LDB
#undef PG8_MMA
#undef PG8_WAIT_V
#undef PG8_WAIT_L
#undef PG8_BAR
#undef PG8_SCHED
}
}
namespace att {
#define ATT_LAS __attribute__((address_space(3)))
typedef unsigned short bf16_t;
using bf16x8 = __attribute__((ext_vector_type(8))) short;
using s16x4  = __attribute__((ext_vector_type(4))) short;
using f32x16 = __attribute__((ext_vector_type(16))) float;
using u32x4  = __attribute__((ext_vector_type(4))) unsigned;
constexpr int NW = 8, QBLK = 32, KVBLK = 64;
constexpr int SHM_K = 64 * 256, SHM_V = 64 * 64 * 2;
constexpr int NBUF = 5;
constexpr int LDS_BYTES = NBUF * SHM_V + NBUF * SHM_K + NW * 64 * 4;
constexpr int LDS_TOTAL = LDS_BYTES + NW * 4096;
constexpr float THR = 8.f;
#define KSWZ(row, colB) ((row) * 256 + ((colB) ^ (((row) & 15) << 4)))
#define ATT_SBAR() __builtin_amdgcn_sched_barrier(0)
__device__ __forceinline__ int crow(int r, int hi) { return (r & 3) + 8 * (r >> 2) + 4 * hi; }
__device__ __forceinline__ unsigned cvtpk(float lo, float hi) { unsigned r; asm volatile("v_cvt_pk_bf16_f32 %0, %1, %2" : "=v"(r) : "v"(lo), "v"(hi)); return r; }

template <bool FIRST>
__device__ __forceinline__ void partialSM(f32x16& p0, f32x16& p1, float& m_reg, f32x16& negm, float& alpha) {
  float pmax = p0[0];
#pragma unroll
  for (int r = 1; r < 16; ++r) pmax = fmaxf(pmax, p0[r]);
#pragma unroll
  for (int r = 0; r < 16; ++r) pmax = fmaxf(pmax, p1[r]);
  { auto rr = __builtin_amdgcn_permlane32_swap(__float_as_uint(pmax), __float_as_uint(pmax), false, false);
    pmax = fmaxf(__uint_as_float(rr[0]), __uint_as_float(rr[1])); }
  alpha = 1.f;
  if (FIRST || __builtin_expect(__any(pmax > THR), 0)) {
    const float dl = FIRST ? pmax : fmaxf(pmax, 0.f);
    m_reg += dl;
#pragma unroll
    for (int r = 0; r < 16; ++r) { p0[r] -= dl; p1[r] -= dl; }
#pragma unroll
    for (int r = 0; r < 16; ++r) negm[r] = -m_reg;
    if (!FIRST) alpha = __builtin_amdgcn_exp2f(-dl);
  }
}
__device__ __forceinline__ void finishSM(f32x16& p0, f32x16& p1, float alpha, float& l_reg, bf16x8& pa0, bf16x8& pa1, bf16x8& pa2, bf16x8& pa3) {
#pragma unroll
  for (int r = 0; r < 16; ++r) p0[r] = __builtin_amdgcn_exp2f(p0[r]);
#pragma unroll
  for (int r = 0; r < 16; ++r) p1[r] = __builtin_amdgcn_exp2f(p1[r]);
  float ps = 0;
#pragma unroll
  for (int r = 0; r < 16; ++r) ps += p0[r];
#pragma unroll
  for (int r = 0; r < 16; ++r) ps += p1[r];
  { auto rr = __builtin_amdgcn_permlane32_swap(__float_as_uint(ps), __float_as_uint(ps), false, false);
    ps = __uint_as_float(rr[0]) + __uint_as_float(rr[1]); }
  l_reg = l_reg * alpha + ps;
#define ATT_PK4(P, BASE, OUT) do { unsigned a0 = cvtpk(P[BASE + 0], P[BASE + 1]), a1 = cvtpk(P[BASE + 2], P[BASE + 3]);   \
    unsigned b0 = cvtpk(P[BASE + 4], P[BASE + 5]), b1 = cvtpk(P[BASE + 6], P[BASE + 7]);                              \
    auto r0 = __builtin_amdgcn_permlane32_swap(a0, b0, false, false); auto r1 = __builtin_amdgcn_permlane32_swap(a1, b1, false, false); \
    u32x4 w = {r0[0], r1[0], r0[1], r1[1]}; OUT = __builtin_bit_cast(bf16x8, w); } while (0)
  ATT_PK4(p0, 0, pa0); ATT_PK4(p0, 8, pa1); ATT_PK4(p1, 0, pa2); ATT_PK4(p1, 8, pa3);
#undef ATT_PK4
}
__device__ __forceinline__ void qkt(f32x16& p0, f32x16& p1, const ATT_LAS char* Ks, const bf16x8* qr, const f32x16& negm, int r32, int hi) {
#pragma unroll
  for (int d0 = 0; d0 < 6; ++d0) { const int cb = (d0 * 16 + hi * 8) * 2;
    const bf16x8 b0 = *(const ATT_LAS bf16x8*)(Ks + KSWZ(r32, cb));
    const bf16x8 b1 = *(const ATT_LAS bf16x8*)(Ks + KSWZ(32 + r32, cb));
    if (d0 == 0) { p0 = __builtin_amdgcn_mfma_f32_32x32x16_bf16(b0, qr[0], negm, 0, 0, 0); p1 = __builtin_amdgcn_mfma_f32_32x32x16_bf16(b1, qr[0], negm, 0, 0, 0); }
    else { p0 = __builtin_amdgcn_mfma_f32_32x32x16_bf16(b0, qr[d0], p0, 0, 0, 0); p1 = __builtin_amdgcn_mfma_f32_32x32x16_bf16(b1, qr[d0], p1, 0, 0, 0); } }
}
__device__ __forceinline__ int v_st(int k, int c) { const int kk = (k & ~0xC) | ((k & 4) << 1) | ((k & 8) >> 1); return ((kk >> 3) * 2 + (c >> 5)) * 512 + ((kk & 7) * 32 + (c & 31)) * 2; }
__device__ __forceinline__ int v_rd_base(int lane) { return ((lane & 3) << 3) | (((lane >> 2) & 3) << 6) | (((lane >> 4) & 1) << 5) | (((lane >> 5) & 1) << 8); }
constexpr int v_rd_off(int d0, int ks, int half) { return d0 * 512 + ks * 2048 + half * 1024; }
template <int OFF> __device__ __forceinline__ s16x4 tr_read(int vb) {
  s16x4 r; asm volatile("ds_read_b64_tr_b16 %0, %1 offset:%2" : "=&v"(r) : "v"(vb), "i"(OFF) : "memory"); return r;
}
__device__ __forceinline__ void pv_d0(f32x16* o, int vb, bf16x8 pa0, bf16x8 pa1, bf16x8 pa2, bf16x8 pa3) {
  const s16x4 l0 = tr_read<v_rd_off(0, 0, 0)>(vb), h0 = tr_read<v_rd_off(0, 0, 1)>(vb), l1 = tr_read<v_rd_off(0, 1, 0)>(vb), h1 = tr_read<v_rd_off(0, 1, 1)>(vb);
  const s16x4 l2 = tr_read<v_rd_off(0, 2, 0)>(vb), h2 = tr_read<v_rd_off(0, 2, 1)>(vb), l3 = tr_read<v_rd_off(0, 3, 0)>(vb), h3 = tr_read<v_rd_off(0, 3, 1)>(vb);
  const s16x4 m0 = tr_read<v_rd_off(1, 0, 0)>(vb), n0 = tr_read<v_rd_off(1, 0, 1)>(vb), m1 = tr_read<v_rd_off(1, 1, 0)>(vb), n1 = tr_read<v_rd_off(1, 1, 1)>(vb);
  const s16x4 m2 = tr_read<v_rd_off(1, 2, 0)>(vb), n2 = tr_read<v_rd_off(1, 2, 1)>(vb), m3 = tr_read<v_rd_off(1, 3, 0)>(vb), n3 = tr_read<v_rd_off(1, 3, 1)>(vb);
#define ATT_PK(L, H) (bf16x8){L[0], L[1], L[2], L[3], H[0], H[1], H[2], H[3]}
  asm volatile("s_waitcnt lgkmcnt(8)" ::: "memory"); ATT_SBAR();
  o[0] = __builtin_amdgcn_mfma_f32_32x32x16_bf16(pa0, ATT_PK(l0, h0), o[0], 0, 0, 0);
  o[0] = __builtin_amdgcn_mfma_f32_32x32x16_bf16(pa1, ATT_PK(l1, h1), o[0], 0, 0, 0);
  o[0] = __builtin_amdgcn_mfma_f32_32x32x16_bf16(pa2, ATT_PK(l2, h2), o[0], 0, 0, 0);
  o[0] = __builtin_amdgcn_mfma_f32_32x32x16_bf16(pa3, ATT_PK(l3, h3), o[0], 0, 0, 0);
  asm volatile("s_waitcnt lgkmcnt(0)" ::: "memory"); ATT_SBAR();
  o[1] = __builtin_amdgcn_mfma_f32_32x32x16_bf16(pa0, ATT_PK(m0, n0), o[1], 0, 0, 0);
  o[1] = __builtin_amdgcn_mfma_f32_32x32x16_bf16(pa1, ATT_PK(m1, n1), o[1], 0, 0, 0);
  o[1] = __builtin_amdgcn_mfma_f32_32x32x16_bf16(pa2, ATT_PK(m2, n2), o[1], 0, 0, 0);
  o[1] = __builtin_amdgcn_mfma_f32_32x32x16_bf16(pa3, ATT_PK(m3, n3), o[1], 0, 0, 0);
#undef ATT_PK
}
__device__ __forceinline__ float bf2f(unsigned short b) { return __uint_as_float((unsigned)b << 16); }
__device__ __forceinline__ unsigned short f2bf(float f) { unsigned u = __float_as_uint(f); return (unsigned short)((u + 0x7fffu + ((u >> 16) & 1u)) >> 16); }

struct AU { int qrow0, h, kb0, nt0, kb1, NT; };
__device__ __forceinline__ void attn_unit(const bf16_t* __restrict__ Q, const bf16_t* __restrict__ KV, const bf16_t* __restrict__ KR, bf16_t* SG,
                                          const AU u, const AU nx, const bool first, const bool has_next, int& g, ATT_LAS char* lds) {
  const int qrow0 = u.qrow0, h = u.h, kb0 = u.kb0, nt0 = u.nt0, kb1 = u.kb1, NT = u.NT;
  const int tid = threadIdx.x, wid = tid >> 6, lane = tid & 63, r32 = lane & 31, hi = lane >> 5;
  ATT_LAS char* V_lds = lds; ATT_LAS char* K_lds = lds + NBUF * SHM_V;
  ATT_LAS float* ws = (ATT_LAS float*)(lds + NBUF * SHM_V + NBUF * SHM_K) + wid * 64; ATT_LAS float* li_l = ws; ATT_LAS float* al_l = ws + 32;
  float m_reg = 0.f, l_reg = 0.f; f32x16 o[2] = {}; f32x16 negm = {}; bf16x8 qr[6];
  const bf16_t* Qw = Q + (size_t)(qrow0 + wid * QBLK + r32) * 1536 + h * 96 + hi * 8;
#pragma unroll
  for (int d0 = 0; d0 < 6; ++d0) qr[d0] = *(const bf16x8*)(Qw + d0 * 16);
  const int wu = __builtin_amdgcn_readfirstlane(wid);
  int offK[4], offV[2]; bool isR[4];
#pragma unroll
  for (int a_ = 0; a_ < 4; ++a_) { const int q_ = 4 * (wid & 3) + a_, r_ = 4 * q_ + (lane >> 4), c_ = (lane & 15) ^ (r_ & 15);
    isR[a_] = c_ >= 8 && c_ < 12; offK[a_] = isR[a_] ? r_ * 64 + (c_ - 8) * 16 : r_ * 4096 + h * 256 + (c_ < 8 ? c_ : 0) * 16; }
#pragma unroll
  for (int a_ = 0; a_ < 2; ++a_) { const int P = 64 * (2 * (wid & 3) + a_) + lane, sub = P >> 5, w_ = P & 31, kk = (sub >> 1) * 8 + (w_ >> 2), cc = (sub & 1) * 32 + (w_ & 3) * 8, k_ = (kk & ~0xC) | ((kk & 4) << 1) | ((kk & 8) >> 1);
    offV[a_] = k_ * 4096 + h * 256 + 128 + cc * 2; }
#define ATT_TBASE(t) ((t) < nt0 ? kb0 + (t) * KVBLK : kb1 + ((t) - nt0) * KVBLK)
#define ATT_DMA(t, slot) ATT_DMA_RB(ATT_TBASE(t), 0, slot)
#define ATT_DMA_N(t, slot) ATT_DMA_RB(((t) < nx.nt0 ? nx.kb0 + (t) * KVBLK : nx.kb1 + ((t) - nx.nt0) * KVBLK), (nx.h - h) * 256, slot)
#define ATT_DMA_RB(rowb, hd, slot) do { if (wu < 4) { const size_t rb_ = (size_t)(rowb); const char* kvb_ = (const char*)KV + rb_ * 4096 + (hd); const char* krb_ = (const char*)KR + rb_ * 64; \
    _Pragma("unroll") for (int a_ = 0; a_ < 4; ++a_) __builtin_amdgcn_global_load_lds((const unsigned*)((isR[a_] ? krb_ : kvb_) + offK[a_]), (ATT_LAS unsigned*)(K_lds + (slot) * SHM_K + (4 * wu + a_) * 1024), 16, 0, 0); \
    _Pragma("unroll") for (int a_ = 0; a_ < 2; ++a_) __builtin_amdgcn_global_load_lds((const unsigned*)(kvb_ + offV[a_]), (ATT_LAS unsigned*)(V_lds + (slot) * SHM_V + (2 * wu + a_) * 1024), 16, 0, 0); } } while (0)
#define ATT_DMA_SYNC() do { asm volatile("s_waitcnt vmcnt(0)" ::: "memory"); __syncthreads(); } while (0)
  const int vb0 = (int)(unsigned)(size_t)V_lds + v_rd_base(lane);
#define ATT_RESC(a) do { if (__any((a) < 1.f)) { if (hi == 0) al_l[r32] = (a); asm volatile("s_waitcnt lgkmcnt(0)" ::: "memory"); \
    _Pragma("unroll") for (int d = 0; d < 2; ++d) _Pragma("unroll") for (int r = 0; r < 16; ++r) o[d][r] *= al_l[crow(r, hi)]; } } while (0)
#define ATT_M5(x) ((x) >= 5 ? (x) - 5 : (x))
  f32x16 pA0, pA1, pB0, pB1; float alA, alB; bf16x8 pa0, pa1, pa2, pa3;
  if (first) { ATT_DMA(0, g); ATT_DMA(1, ATT_M5(g + 1)); ATT_DMA(2, ATT_M5(g + 2)); }
  ATT_DMA_SYNC();
  qkt(pA0, pA1, K_lds + g * SHM_K, qr, negm, r32, hi); partialSM<true>(pA0, pA1, m_reg, negm, alA);
  int b = ATT_M5(g + 1);
  for (int j = 1; j + 1 < NT; j += 2) {
    if (j + 2 < NT) ATT_DMA(j + 2, ATT_M5(b + 2));
    ATT_SBAR(); qkt(pB0, pB1, K_lds + b * SHM_K, qr, negm, r32, hi);
    finishSM(pA0, pA1, alA, l_reg, pa0, pa1, pa2, pa3); ATT_SBAR();
    pv_d0(o, vb0 + ATT_M5(b + 4) * SHM_V, pa0, pa1, pa2, pa3); partialSM<false>(pB0, pB1, m_reg, negm, alB);
    ATT_RESC(alB);
    if (j + 3 < NT) ATT_DMA(j + 3, ATT_M5(b + 3));
    ATT_SBAR(); qkt(pA0, pA1, K_lds + ATT_M5(b + 1) * SHM_K, qr, negm, r32, hi);
    finishSM(pB0, pB1, alB, l_reg, pa0, pa1, pa2, pa3); ATT_SBAR();
    pv_d0(o, vb0 + b * SHM_V, pa0, pa1, pa2, pa3); partialSM<false>(pA0, pA1, m_reg, negm, alA);
    ATT_RESC(alA); ATT_DMA_SYNC(); b = ATT_M5(b + 2);
  }
  if (has_next) { ATT_DMA_N(0, ATT_M5(b + 1)); ATT_DMA_N(1, ATT_M5(b + 2)); ATT_DMA_N(2, ATT_M5(b + 3)); }
  ATT_SBAR(); qkt(pB0, pB1, K_lds + b * SHM_K, qr, negm, r32, hi);
  finishSM(pA0, pA1, alA, l_reg, pa0, pa1, pa2, pa3); ATT_SBAR();
  pv_d0(o, vb0 + ATT_M5(b + 4) * SHM_V, pa0, pa1, pa2, pa3); partialSM<false>(pB0, pB1, m_reg, negm, alB);
  ATT_RESC(alB);
  finishSM(pB0, pB1, alB, l_reg, pa0, pa1, pa2, pa3); ATT_SBAR();
  pv_d0(o, vb0 + b * SHM_V, pa0, pa1, pa2, pa3);
  if (hi == 0) li_l[r32] = l_reg; asm volatile("s_waitcnt lgkmcnt(0)" ::: "memory");
  float rli[16];
#pragma unroll
  for (int r = 0; r < 16; ++r) rli[r] = __builtin_amdgcn_rcpf(li_l[crow(r, hi)]);
  bf16_t* Ow = SG + (size_t)(qrow0 + wid * QBLK) * 1024 + h * 64 + r32;
#pragma unroll
  for (int r = 0; r < 16; ++r) { const int orow = crow(r, hi);
#pragma unroll
    for (int d0 = 0; d0 < 2; ++d0) { bf16_t* p = Ow + (size_t)orow * 1024 + d0 * 32; *p = f2bf(o[d0][r] * rli[r] * bf2f(*p)); } }
  g = ATT_M5(b + 1);
#undef ATT_TBASE
#undef ATT_DMA
#undef ATT_DMA_N
#undef ATT_DMA_RB
#undef ATT_DMA_SYNC
#undef ATT_RESC
#undef ATT_M5
}
#undef KSWZ
}
#define GAS __attribute__((address_space(1)))
#define LAS __attribute__((address_space(3)))
typedef unsigned short bf16;
typedef unsigned v4u __attribute__((ext_vector_type(4)));
typedef float f32x4 __attribute__((ext_vector_type(4)));
typedef short bf16x8 __attribute__((ext_vector_type(8)));
typedef GAS unsigned gu32;
typedef GAS unsigned long long gu64;
#define RLX_AGENT __ATOMIC_RELAXED, __HIP_MEMORY_SCOPE_AGENT
#define LDS_WAIT() asm volatile("s_waitcnt lgkmcnt(0)" ::: "memory")
#define VM_WAIT() asm volatile("s_waitcnt vmcnt(0)" ::: "memory")
__device__ __forceinline__ unsigned long long rt() { return __builtin_amdgcn_s_memrealtime(); }
__device__ __forceinline__ unsigned f2bf(float f) { unsigned u = __builtin_bit_cast(unsigned, f); return (u + 0x7fffu + ((u >> 16) & 1u)) >> 16; }
__device__ __forceinline__ unsigned pk2(float lo, float hi) { return f2bf(lo) | (f2bf(hi) << 16); }

#define XB_TMO      128
#define XB_XCNT(j)  (256  + 64 * (j))
#define XB_XSUB(j)  (1280 + 64 * (j))
#define XB_XGEN(j)  (2304 + 64 * (j))
#define XB_TOP      3328
#define XB_TOPGEN   3392
#define XCD_BAR_WORDS 3456
#define XB_SPIN_CAP (1u << 18)

__device__ __forceinline__ unsigned xb_ld(unsigned* p)              { return __hip_atomic_load(p, __ATOMIC_RELAXED, __HIP_MEMORY_SCOPE_AGENT); }
__device__ __forceinline__ unsigned xb_add(unsigned* p, unsigned v) { return __hip_atomic_fetch_add(p, v, __ATOMIC_RELAXED, __HIP_MEMORY_SCOPE_AGENT); }
__device__ __forceinline__ unsigned xb_xcc_id() { return (unsigned)__builtin_amdgcn_s_getreg((3 << 11) | 20) & 0xFu; }
#define XB_SPIN(cond, bar) do { unsigned _sp = 0; while (cond) { __builtin_amdgcn_s_sleep(1); \
    if ((++_sp & 255u) == 0u) { if (xb_ld(&(bar)[XB_TMO])) break; if (_sp > XB_SPIN_CAP) { atomicAdd(&(bar)[XB_TMO], 1u); break; } } } } while (0)

struct XcdBarrier {
    unsigned* bar; unsigned x;
    volatile LAS unsigned* st;
};

__device__ __forceinline__ XcdBarrier xcd_barrier_post(unsigned* bar, volatile LAS unsigned* st) {
    XcdBarrier b; b.bar = bar; b.x = xb_xcc_id(); b.st = st;
    if (threadIdx.x == 0) (void)xb_add(&bar[XB_XCNT(b.x)], 1u);
    return b;
}
__device__ __forceinline__ void xcd_barrier_complete(unsigned* bar, unsigned x, unsigned& nloc, unsigned& nx) {
    const unsigned G = gridDim.x * gridDim.y * gridDim.z;
    unsigned sum, cnt, mine, sp = 0u;
    for (;;) {
        sum = 0u; cnt = 0u; mine = 0u;
#pragma unroll
        for (unsigned j = 0; j < 16; ++j) { const unsigned c = xb_ld(&bar[XB_XCNT(j)]); sum += c; cnt += (c > 0u) ? 1u : 0u; mine = (j == x) ? c : mine; }
        if (sum == G) break;
        __builtin_amdgcn_s_sleep(1);
        if ((++sp & 255u) == 0u) { if (xb_ld(&bar[XB_TMO])) break; if (sp > XB_SPIN_CAP) { atomicAdd(&bar[XB_TMO], 1u); break; } }
    }
    nloc = mine > 0u ? mine : 1u; nx = cnt > 0u ? cnt : 1u;
}

__device__ __forceinline__ void xcd_barrier(const XcdBarrier& b) {
    asm volatile("s_waitcnt vmcnt(0)" ::: "memory");
    __syncthreads();
    if (threadIdx.x == 0) {
        unsigned* bar = b.bar;
        __builtin_amdgcn_s_waitcnt(0);
        unsigned nloc = b.st[0], nx = b.st[1];
        if (nloc == 0u) { xcd_barrier_complete(bar, b.x, nloc, nx); b.st[0] = nloc; b.st[1] = nx; }
        const unsigned old = xb_add(&bar[XB_XSUB(b.x)], 1u);
        const unsigned gen = old / nloc;
        if (old + 1u == (gen + 1u) * nloc) {
            __builtin_amdgcn_fence(__ATOMIC_RELEASE, "agent");
            asm volatile("s_waitcnt vmcnt(0)" ::: "memory");
            const unsigned og = xb_add(&bar[XB_TOP], 1u);
            const unsigned tg = og / nx;
            if (og + 1u == (tg + 1u) * nx) xb_add(&bar[XB_TOPGEN], 1u);
            else XB_SPIN(xb_ld(&bar[XB_TOPGEN]) == tg, bar);
            __builtin_amdgcn_fence(__ATOMIC_ACQUIRE, "agent");
            xb_add(&bar[XB_XGEN(b.x)], 1u);
            asm volatile("s_waitcnt vmcnt(0)" ::: "memory");
        } else {
            XB_SPIN(xb_ld(&bar[XB_XGEN(b.x)]) == gen, bar);
            __builtin_amdgcn_fence(__ATOMIC_ACQUIRE, "agent");
            asm volatile("s_waitcnt vmcnt(0)" ::: "memory");
        }
    }
    __syncthreads();
}
constexpr int NWAVES = 8;
#ifndef MK_N_LAUNCHES
#define MK_N_LAUNCHES 1
#endif
constexpr int NPHASE = 13;
constexpr int N_LAUNCHES = MK_N_LAUNCHES;
static_assert(N_LAUNCHES == 1 || N_LAUNCHES == NPHASE, "MK_N_LAUNCHES is 1 or 13");
using pg8::NCTX; using pg8::MTOK; using pg8::MKV;
constexpr float RMS_EPS = pg8::RMS_EPS;
constexpr size_t MiB = 1u << 20;
constexpr size_t WS_CTL = 0, CTL_ZERO_BYTES = 64 * 1024;
constexpr size_t WS_MOD = 1 * MiB;
constexpr size_t WS_ROPE = 1 * MiB + 512 * 1024;
constexpr size_t WS_SSQKV = 2 * MiB, WS_SSQQ = 2 * MiB + 512 * 1024;
constexpr size_t WS_W1 = 4 * MiB, WS_W2 = 12 * MiB, WS_W3 = 14 * MiB, WS_WQ = 18 * MiB, WS_WKV = 20 * MiB - 512 * 1024, WS_WO = 20 * MiB + 512 * 1024;
constexpr size_t WS_SG = 23 * MiB;
constexpr size_t WS_Q = 63 * MiB;
constexpr size_t WS_KV = 123 * MiB;
constexpr size_t WS_QL = 211 * MiB, WS_CKV = 226 * MiB, WS_KR = 237 * MiB, WS_END = 239 * MiB;
static_assert(WS_W1 + (size_t)4096 * 1024 * 2 <= WS_W2 && WS_W2 + (size_t)1024 * 1024 * 2 <= WS_W3 && WS_W3 + (size_t)1792 * 1024 * 2 <= WS_WQ && WS_WQ + (size_t)1536 * 384 * 2 <= WS_WKV &&
              WS_WKV + (size_t)2048 * 256 * 2 <= WS_WO && WS_WO + (size_t)1024 * 1024 * 2 <= WS_SG && WS_SG + (size_t)MTOK * 1024 * 2 <= WS_Q && WS_Q + (size_t)MTOK * 1536 * 2 <= WS_KV &&
              WS_KV + (size_t)MKV * 2048 * 2 <= WS_QL && WS_QL + (size_t)MTOK * 384 * 2 <= WS_CKV && WS_CKV + (size_t)MKV * 256 * 2 <= WS_KR && WS_KR + (size_t)MKV * 32 * 2 <= WS_END, "d_ws map");
constexpr int CW_ROWCTR = 512;
constexpr int CW_BAR = 1024;
static_assert((CW_BAR + XCD_BAR_WORDS) * 4 <= (int)CTL_ZERO_BYTES, "barrier words inside the memset region");
constexpr int RING_BYTES = 131072, LDSCTL_OFF = RING_BYTES, MISC_OFF = LDSCTL_OFF + 320, LDS_BYTES = 147456;
static_assert(att::LDS_BYTES <= RING_BYTES, "attention scratch fits the ring region");

struct Frame {
    LAS unsigned char* lds; volatile LAS unsigned* MISC;
    int tid, lane, wave, vcu, G;
};
__device__ __forceinline__ float wave_sum(float v) {
#pragma unroll
    for (int o = 1; o < 64; o <<= 1) v += __shfl_xor(v, o);
    return v;
}
__device__ __forceinline__ float silu_acc(float x) { return x / (1.f + expf(-x)); }
__device__ __forceinline__ int grp_of_tok(int t) { return t < NCTX ? 0 : 1 + ((t - NCTX) >> 12); }

__device__ __forceinline__ void transpose_item(const float* W, int ldw, int s0, bf16* WT, int K, int n0, int k0, LAS float* scr, int lane) {
    const int c = lane & 7;
    if (s0 < 0) {
#pragma unroll
        for (int j = 0; j < 4; ++j) { const int n = (lane >> 3) + 8 * j; *(GAS v4u*)(WT + (size_t)(n0 + n) * K + k0 + 8 * c) = (v4u){0u, 0u, 0u, 0u}; }
        return;
    }
#pragma unroll
    for (int i = 0; i < 32; ++i) { const int kk = 2 * i + (lane >> 5); scr[kk * 33 + (lane & 31)] = __builtin_nontemporal_load(W + (size_t)(k0 + kk) * ldw + s0 + (lane & 31)); }
    LDS_WAIT(); asm volatile("" ::: "memory");
#pragma unroll
    for (int j = 0; j < 4; ++j) { const int n = (lane >> 3) + 8 * j; const LAS float* s = scr + (8 * c) * 33 + n;
        v4u o; o.x = pk2(s[0 * 33], s[1 * 33]); o.y = pk2(s[2 * 33], s[3 * 33]); o.z = pk2(s[4 * 33], s[5 * 33]); o.w = pk2(s[6 * 33], s[7 * 33]);
        *(GAS v4u*)(WT + (size_t)(n0 + n) * K + k0 + 8 * c) = o; }
    LDS_WAIT(); asm volatile("" ::: "memory");
}
__device__ __forceinline__ int map_w1(int n0) { const int pn = n0 >> 8, cl = n0 & 255, bjj = cl >> 7, ch = 128 * (pn >> 1) + (cl & 127); const int part = (pn & 1) ? (bjj ? 3 : 0) : (bjj ? 2 : 1); return part * 1024 + ch; }
__device__ __forceinline__ int map_w3(int n0) { return n0 < 256 ? 384 + n0 : n0 < 640 ? n0 - 256 : n0 < 672 ? n0 : n0 < 768 ? -1 : n0 - 96; }

struct Ptrs {
    const float *x_prompt, *x_sample, *cache_ckv, *cache_krope, *c, *c_ctx, *norm_g, *w_mod, *b_mod, *conv_w_in, *conv_w, *conv_w_out, *mla_w_in, *gq, *w_q_up, *gkv, *w_kv_up, *w_out, *final_g;
    float* out; float* st_ckv; float* st_kr;
    float* mod; float* rope; float* ssq_kv; float* ssq_q;
    bf16 *W1, *W2, *W3, *WQ, *WKV, *WO, *SG, *EB, *Q, *KV, *H, *Y, *QL, *CKV, *KR, *DL;
};

__device__ __forceinline__ void phase_p0a(Frame& F, const Ptrs& P) {
    LAS float* sv = (LAS float*)(F.lds);
    LAS float* part = (LAS float*)(F.lds + 20480);
    bool filled = false;
    for (int chunk = blockIdx.x; chunk < 192; chunk += F.G) {
        if (!filled) {
            for (int e = F.tid; e < 5120; e += NWAVES * 64) { const int g = e >> 10, k = e & 1023; sv[e] = silu_acc(g == 0 ? P.c_ctx[k] : P.c[(g - 1) * 1024 + k]); }
            __syncthreads(); filled = true;
        }
        const int i = chunk / 96, cb = (chunk % 96) * 32, col = F.lane & 31, kh = F.lane >> 5;
        const float* w = P.w_mod + (size_t)i * 1024 * 3072 + cb + col;
        float a0 = 0.f, a1 = 0.f, a2 = 0.f, a3 = 0.f, a4 = 0.f;
#pragma unroll 16
        for (int kk = 0; kk < 64; ++kk) { const int k = F.wave * 128 + 2 * kk + kh; const float wv = __builtin_nontemporal_load(w + (size_t)k * 3072);
            a0 += sv[k] * wv; a1 += sv[1024 + k] * wv; a2 += sv[2048 + k] * wv; a3 += sv[3072 + k] * wv; a4 += sv[4096 + k] * wv; }
        a0 += __shfl_xor(a0, 32); a1 += __shfl_xor(a1, 32); a2 += __shfl_xor(a2, 32); a3 += __shfl_xor(a3, 32); a4 += __shfl_xor(a4, 32);
        if (kh == 0) { LAS float* pw = part + F.wave * 160 + col; pw[0] = a0; pw[32] = a1; pw[64] = a2; pw[96] = a3; pw[128] = a4; }
        __syncthreads();
        if (F.tid < 160) { const int g = F.tid >> 5, l = F.tid & 31; float s = 0.f;
#pragma unroll
            for (int wv = 0; wv < 8; ++wv) s += part[wv * 160 + g * 32 + l];
            P.mod[(size_t)(i * 5 + g) * 3072 + cb + l] = s + P.b_mod[i * 3072 + cb + l]; }
        __syncthreads();
    }
    __syncthreads();
    LAS float* scr = (LAS float*)(F.lds + F.wave * 16384);
    const int gw = F.vcu * NWAVES + F.wave, NGW = F.G * NWAVES;
    constexpr int I1 = 16 * 128, I2 = 16 * 32, I3 = 16 * 56, IQ = 6 * 48, IKV = 4 * 64, IO = 16 * 32, NITEMS = I1 + I2 + I3 + IQ + IKV + IO;
    for (int it = gw; it < NITEMS; it += NGW) {
        int r = it;
        if (r < I1) { const int kb = r / 128, nb = r % 128; transpose_item(P.conv_w_in, 4096, map_w1(32 * nb), P.W1, 1024, 32 * nb, 64 * kb, scr, F.lane); continue; } r -= I1;
        if (r < I2) { const int kb = r / 32, nb = r % 32; transpose_item(P.conv_w_out, 1024, 32 * nb, P.W2, 1024, 32 * nb, 64 * kb, scr, F.lane); continue; } r -= I2;
        if (r < I3) { const int kb = r / 56, nb = r % 56; transpose_item(P.mla_w_in, 1696, map_w3(32 * nb), P.W3, 1024, 32 * nb, 64 * kb, scr, F.lane); continue; } r -= I3;
        if (r < IQ) { const int kb = r / 48, nb = r % 48; transpose_item(P.w_q_up, 1536, 32 * nb, P.WQ, 384, 32 * nb, 64 * kb, scr, F.lane); continue; } r -= IQ;
        if (r < IKV) { const int kb = r / 64, nb = r % 64; transpose_item(P.w_kv_up, 2048, 32 * nb, P.WKV, 256, 32 * nb, 64 * kb, scr, F.lane); continue; } r -= IKV;
        { const int kb = r / 32, nb = r % 32; transpose_item(P.w_out, 1024, 32 * nb, P.WO, 1024, 32 * nb, 64 * kb, scr, F.lane); }
    }
    const int gt = F.vcu * (NWAVES * 64) + F.tid, NGT = F.G * NWAVES * 64;
    for (int i = gt; i < 2048 * 256 / 8; i += NGT) { const f32x4 a = *(const f32x4*)(P.cache_ckv + (size_t)i * 8), b = *(const f32x4*)(P.cache_ckv + (size_t)i * 8 + 4);
        *(v4u*)(P.CKV + (size_t)MTOK * 256 + (size_t)i * 8) = (v4u){pk2(a[0], a[1]), pk2(a[2], a[3]), pk2(b[0], b[1]), pk2(b[2], b[3])}; }
    for (int i = gt; i < 2048 * 32 / 8; i += NGT) { const f32x4 a = *(const f32x4*)(P.cache_krope + (size_t)i * 8), b = *(const f32x4*)(P.cache_krope + (size_t)i * 8 + 4);
        *(v4u*)(P.KR + (size_t)MTOK * 32 + (size_t)i * 8) = (v4u){pk2(a[0], a[1]), pk2(a[2], a[3]), pk2(b[0], b[1]), pk2(b[2], b[3])}; }
    if (blockIdx.x == F.G - 1) { const int p = F.tid >> 3, j = F.tid & 7; const float fr = powf(10000.f, -(float)j * 0.125f); float s, c; sincosf((float)p * fr, &s, &c);
        P.rope[F.tid * 2] = c; P.rope[F.tid * 2 + 1] = s; }
}

constexpr int RPI_DEF = 6;
__device__ __forceinline__ f32x4 bf4_to_f32(unsigned long long w) { f32x4 r; r[0] = __uint_as_float((unsigned)w << 16); r[1] = __uint_as_float((unsigned)w & 0xffff0000u); r[2] = __uint_as_float((unsigned)(w >> 32) << 16); r[3] = __uint_as_float((unsigned)(w >> 32) & 0xffff0000u); return r; }
template <bool HAS_DELTA, bool WRITE_X, int RPI = RPI_DEF>
#define ROWPASS_LOOP_HEAD const int NGWs = NGW; (void)ctr; for (int t0 = r0 + gw; t0 < MTOK; t0 += RPI * NGW) {
#define ROWPASS_LOOP_TAIL }
__device__ __forceinline__ void phase_hnorm(Frame& F, const float* xa, const float* xb, const bf16* delta, float* xout, const float* ng, const float* modl, bf16* H, int r0, int MTOK, int gw, int NGW, unsigned* ctr = nullptr) {
    ROWPASS_LOOP_HEAD
        f32x4 v[RPI][4]; float s[RPI];
#pragma unroll
        for (int r = 0; r < RPI; ++r) { const int t = t0 + r * NGWs; if (t < MTOK) {
            const float* x = t < NCTX ? xa + (size_t)t * 1024 : xb + (size_t)(t - NCTX) * 1024;
#pragma unroll
            for (int j = 0; j < 4; ++j) v[r][j] = __builtin_nontemporal_load((const f32x4*)(x + 4 * (F.lane + 64 * j)));
            if (HAS_DELTA) {
#pragma unroll
                for (int j = 0; j < 4; ++j) v[r][j] += bf4_to_f32(__builtin_nontemporal_load((const unsigned long long*)(delta + (size_t)t * 1024 + 4 * (F.lane + 64 * j)))); } } }
#pragma unroll
        for (int r = 0; r < RPI; ++r) { float a = 0.f; if (t0 + r * NGWs < MTOK) {
#pragma unroll
            for (int j = 0; j < 4; ++j) a += (v[r][j][0] * v[r][j][0] + v[r][j][1] * v[r][j][1]) + (v[r][j][2] * v[r][j][2] + v[r][j][3] * v[r][j][3]); }
            s[r] = a; }
#pragma unroll
        for (int o = 1; o < 64; o <<= 1) {
#pragma unroll
            for (int r = 0; r < RPI; ++r) s[r] += __shfl_xor(s[r], o); }
#pragma unroll
        for (int r = 0; r < RPI; ++r) { const int t = t0 + r * NGWs; if (t < MTOK) {
            const float rstd = 1.0f / sqrtf(s[r] * (1.f / 1024.f) + RMS_EPS);
            const float* sh = modl + grp_of_tok(t) * 3072; const float* sc = sh + 1024;
#pragma unroll
            for (int j = 0; j < 4; ++j) { const int k = 4 * (F.lane + 64 * j);
                if (WRITE_X) __builtin_nontemporal_store(v[r][j], (f32x4*)(xout + (size_t)t * 1024 + k));
                const f32x4 g = *(const f32x4*)(ng + k), a = *(const f32x4*)(sc + k), b = *(const f32x4*)(sh + k);
                const f32x4 o = v[r][j] * rstd * g * (a + 1.f) + b;
                *(unsigned long long*)(H + (size_t)t * 1024 + k) = (unsigned long long)pk2(o[0], o[1]) | ((unsigned long long)pk2(o[2], o[3]) << 32); } } }
    ROWPASS_LOOP_TAIL
}

__device__ __forceinline__ void bf8_to_f32(const v4u& w, float* f) {
    f[0] = __uint_as_float(w.x << 16); f[1] = __uint_as_float(w.x & 0xffff0000u); f[2] = __uint_as_float(w.y << 16); f[3] = __uint_as_float(w.y & 0xffff0000u);
    f[4] = __uint_as_float(w.z << 16); f[5] = __uint_as_float(w.z & 0xffff0000u); f[6] = __uint_as_float(w.w << 16); f[7] = __uint_as_float(w.w & 0xffff0000u);
}
__device__ __forceinline__ void phase_conv(Frame& F, const bf16* V, const bf16* E, const float* cw, bf16* Y) {
    const int gw = F.vcu * NWAVES + F.wave, NGW = F.G * NWAVES;
    const int c0 = (gw & 1) * 512 + F.lane * 8;
    float w0[8], w1[8], w2[8];
#pragma unroll
    for (int i = 0; i < 8; ++i) { w0[i] = cw[c0 + i]; w1[i] = cw[1024 + c0 + i]; w2[i] = cw[2048 + c0 + i]; }
    for (int it = gw; it < MTOK * 2; it += NGW) {
        const int t = it >> 1; int pos, len; if (t < NCTX) { pos = t & 255; len = 256; } else { pos = (t - NCTX) & 4095; len = 4096; }
        const size_t off = (size_t)t * 1024 + c0;
        const v4u z = {0u, 0u, 0u, 0u};
        const v4u vm = pos > 0 ? *(const v4u*)(V + off - 1024) : z, v0 = *(const v4u*)(V + off), vp = pos < len - 1 ? *(const v4u*)(V + off + 1024) : z, ee = __builtin_nontemporal_load((const v4u*)(E + off));
        float fm[8], f0[8], fp[8], fe[8], y[8]; bf8_to_f32(vm, fm); bf8_to_f32(v0, f0); bf8_to_f32(vp, fp); bf8_to_f32(ee, fe);
#pragma unroll
        for (int i = 0; i < 8; ++i) y[i] = fe[i] * (w0[i] * fm[i] + w1[i] * f0[i] + w2[i] * fp[i]);
        *(v4u*)(Y + off) = (v4u){pk2(y[0], y[1]), pk2(y[2], y[3]), pk2(y[4], y[5]), pk2(y[6], y[7])};
    }
}
__device__ __forceinline__ void phase_state_fix(Frame& F, float* st_ckv, const float* ssq_kv) {
    const int gw = F.vcu * NWAVES + F.wave, NGW = F.G * NWAVES;
    for (int t = gw; t < NCTX; t += NGW) { const f32x4 s0 = *(const f32x4*)(ssq_kv + (size_t)t * 4);
        const float rs = 1.0f / sqrtf(((s0[0] + s0[1]) + (s0[2] + s0[3])) * (1.f / 256.f) + RMS_EPS);
        f32x4* p = (f32x4*)(st_ckv + (size_t)t * 256) + F.lane; *p = *p * rs; }
}
template <int RPI = RPI_DEF>
__device__ __forceinline__ void phase_final(Frame& F, float* X, const bf16* delta, const float* g, int r0, int MTOK, int gw, int NGW, unsigned* ctr = nullptr) {
    ROWPASS_LOOP_HEAD
        f32x4 v[RPI][4]; float s[RPI];
#pragma unroll
        for (int r = 0; r < RPI; ++r) { const int t = t0 + r * NGWs; if (t < MTOK) {
#pragma unroll
            for (int j = 0; j < 4; ++j) v[r][j] = __builtin_nontemporal_load((const f32x4*)(X + (size_t)t * 1024 + 4 * (F.lane + 64 * j)));
#pragma unroll
            for (int j = 0; j < 4; ++j) v[r][j] += bf4_to_f32(__builtin_nontemporal_load((const unsigned long long*)(delta + (size_t)t * 1024 + 4 * (F.lane + 64 * j)))); } }
#pragma unroll
        for (int r = 0; r < RPI; ++r) { float a = 0.f; if (t0 + r * NGWs < MTOK) {
#pragma unroll
            for (int j = 0; j < 4; ++j) a += (v[r][j][0] * v[r][j][0] + v[r][j][1] * v[r][j][1]) + (v[r][j][2] * v[r][j][2] + v[r][j][3] * v[r][j][3]); }
            s[r] = a; }
#pragma unroll
        for (int o = 1; o < 64; o <<= 1) {
#pragma unroll
            for (int r = 0; r < RPI; ++r) s[r] += __shfl_xor(s[r], o); }
#pragma unroll
        for (int r = 0; r < RPI; ++r) { const int t = t0 + r * NGWs; if (t < MTOK) {
            const float rstd = 1.0f / sqrtf(s[r] * (1.f / 1024.f) + RMS_EPS);
#pragma unroll
            for (int j = 0; j < 4; ++j) { const int k = 4 * (F.lane + 64 * j); __builtin_nontemporal_store(v[r][j] * rstd * *(const f32x4*)(g + k), (f32x4*)(X + (size_t)t * 1024 + k)); } } }
    ROWPASS_LOOP_TAIL
}
__device__ __forceinline__ att::AU attn_unit_of(int id) {
    att::AU u;
    if (id < 1024) { const int bh = id >> 4, qb = id & 15, b = bh >> 4; u.h = bh & 15; u.qrow0 = NCTX + b * 4096 + qb * 256; u.kb0 = MTOK + b * 512; u.nt0 = 8; u.kb1 = NCTX + b * 4096; u.NT = 72; }
    else { const int bh = id - 1024, b = bh >> 4; u.h = bh & 15; u.qrow0 = b * 256; u.kb0 = b * 256; u.nt0 = 4; u.kb1 = 0; u.NT = 4; }
    return u;
}
__device__ __forceinline__ void phase_attn(Frame& F, const Ptrs& P) {
    int g = 0; bool first = true;
    for (int id = F.vcu; id < 1280; id += F.G) {
        const att::AU u = attn_unit_of(id); const bool hn = id + F.G < 1280; const att::AU nx = attn_unit_of(hn ? id + F.G : id);
        const int qrow0 = u.qrow0, h = u.h; (void)qrow0; (void)h;
#ifdef ATT_PROBE
        for (int e = F.tid; e < 256 * 8; e += NWAVES * 64) { const int row = qrow0 + (e >> 3), ch = e & 7;
            bf16* c_ = (row < 13312 ? P.QL + (size_t)row * 1024 : (bf16*)((unsigned char*)P.QL + (239 - 211) * MiB) + (size_t)(row - 13312) * 1024) + h * 64 + ch * 8;
            *(v4u*)c_ = *(const v4u*)(P.SG + (size_t)row * 1024 + h * 64 + ch * 8); }
#endif
        att::attn_unit(P.Q, P.KV, P.KR, P.SG, u, nx, first, hn, g, (LAS char*)F.lds);
        first = false;
    }
}

struct Args { const float* in[19]; float* out; unsigned char* ws; int ph_lo, ph_hi; };
typedef const __attribute__((address_space(4))) Args* KArgs;
__device__ __forceinline__ void fill_ptrs(Ptrs& P, KArgs ka) {
    unsigned char* ws = ka->ws; float* out = ka->out;
    P.x_prompt = ka->in[0]; P.x_sample = ka->in[1]; P.cache_ckv = ka->in[2]; P.cache_krope = ka->in[3]; P.c = ka->in[4]; P.c_ctx = ka->in[5]; P.norm_g = ka->in[6];
    P.w_mod = ka->in[7]; P.b_mod = ka->in[8]; P.conv_w_in = ka->in[9]; P.conv_w = ka->in[10]; P.conv_w_out = ka->in[11]; P.mla_w_in = ka->in[12]; P.gq = ka->in[13];
    P.w_q_up = ka->in[14]; P.gkv = ka->in[15]; P.w_kv_up = ka->in[16]; P.w_out = ka->in[17]; P.final_g = ka->in[18];
    P.out = out; P.st_ckv = out + (size_t)MTOK * 1024; P.st_kr = P.st_ckv + (size_t)NCTX * 256;
    P.mod = (float*)(ws + WS_MOD); P.rope = (float*)(ws + WS_ROPE); P.ssq_kv = (float*)(ws + WS_SSQKV); P.ssq_q = (float*)(ws + WS_SSQQ);
    P.W1 = (bf16*)(ws + WS_W1); P.W2 = (bf16*)(ws + WS_W2); P.W3 = (bf16*)(ws + WS_W3); P.WQ = (bf16*)(ws + WS_WQ); P.WKV = (bf16*)(ws + WS_WKV); P.WO = (bf16*)(ws + WS_WO);
    P.SG = (bf16*)(ws + WS_SG); P.EB = (bf16*)(ws + WS_Q); P.Q = (bf16*)(ws + WS_Q); P.KV = (bf16*)(ws + WS_KV); P.H = (bf16*)(ws + WS_KV); P.Y = (bf16*)(ws + WS_KV + 40 * MiB);
    P.DL = (bf16*)(ws + WS_Q);
    P.QL = (bf16*)(ws + WS_QL); P.CKV = (bf16*)(ws + WS_CKV); P.KR = (bf16*)(ws + WS_KR);
}
#define MKP() Ptrs P; { KArgs ka_ = (KArgs)__builtin_amdgcn_kernarg_segment_ptr(); asm volatile("" : "+s"(ka_)); fill_ptrs(P, ka_); } const float* mod0 = P.mod; const float* mod1 = P.mod + 5 * 3072; (void)mod0; (void)mod1
__global__ void __launch_bounds__(NWAVES * 64, 2) mk_fwd(Args args) {
    extern __shared__ __attribute__((aligned(16))) unsigned char lds[];
    Frame F;
    F.lds = (LAS unsigned char*)lds; F.MISC = (volatile LAS unsigned*)(F.lds + MISC_OFF);
    F.tid = threadIdx.x; F.lane = F.tid & 63; F.wave = __builtin_amdgcn_readfirstlane(F.tid >> 6);
    F.G = gridDim.x; { const int bx = blockIdx.x; F.vcu = (F.G % 8 == 0) ? (bx % 8) * (F.G / 8) + bx / 8 : bx; }
    unsigned char* ws = args.ws;
    for (int u = F.tid; u < (LDS_BYTES - LDSCTL_OFF) / 4; u += NWAVES * 64) ((LAS unsigned*)(F.lds + LDSCTL_OFF))[u] = 0u;
    __syncthreads();
    XcdBarrier bar; bar.bar = (unsigned*)(ws + WS_CTL) + CW_BAR; bar.x = 0; bar.st = nullptr;
    if (N_LAUNCHES == 1) bar = xcd_barrier_post((unsigned*)(ws + WS_CTL) + CW_BAR, F.MISC + 8);
    const int lo = args.ph_lo, hi = args.ph_hi;
#ifndef PHASE_MASK
#define PHASE_MASK 0x1fff
#endif
#define IN(k) (((PHASE_MASK >> (k)) & 1) && lo <= (k) && (k) < hi)
#ifdef TIMING_PROBE
    unsigned long long* tsb = (unsigned long long*)(ws + WS_CTL + 32768);
    const bool stamper = blockIdx.x == 0 && F.tid == 0;
#define STAMP(i) do { if (stamper) tsb[i] = __builtin_amdgcn_s_memrealtime(); } while (0)
#else
#define STAMP(i) do {} while (0)
#endif
    STAMP(0);
#define SEAM(k) do { if (IN(k) && IN((k) + 1)) xcd_barrier(bar); STAMP((k) + 1); } while (0)
    if (IN(0)) { MKP(); phase_p0a(F, P); } SEAM(0);
    constexpr int MSPLIT = 16384;
    const int gwA = F.vcu * NWAVES + F.wave, NGWA = F.G * NWAVES;
    const bool tailcu = (int)blockIdx.x < 64;
    const int gwB = ((int)blockIdx.x - 64) * NWAVES + F.wave, NGWB = (F.G - 64) * NWAVES;
    if (IN(1)) { MKP(); phase_hnorm<false, false, 10>(F, P.x_prompt, P.x_sample, nullptr, nullptr, P.norm_g, mod0, P.H, 0, MTOK, gwA, NGWA); } SEAM(1);
    if (IN(2)) {
        MKP();
        pg8::Gemm g{P.H, P.W1, MTOK, 4096, 1024}; pg8::StaticOrder S; S.init(MTOK, 4096, F.G, (int)blockIdx.x);
        pg8::EpiConvIn E{P.SG, P.EB};
        pg8::gemm_phase<pg8::EpiConvIn, pg8::StaticOrder, true, true>(F.lds, g, S, E);
    } SEAM(2);
    if (IN(3)) { MKP(); phase_conv(F, P.SG, P.EB, P.conv_w, P.Y); } SEAM(3);
    if (IN(4)) {
        MKP();
        pg8::Gemm g{P.Y, P.W2, MSPLIT, 1024, 1024}; pg8::StaticOrder S; S.init(MSPLIT, 1024, F.G, (int)blockIdx.x);
        pg8::EpiDelta E{P.DL, mod0 + 2048, 0};
        pg8::gemm_phase<pg8::EpiDelta, pg8::StaticOrder, true, true>(F.lds, g, S, E);
    } SEAM(4);
    if (IN(5)) {
        MKP();
        if (tailcu) { pg8::Gemm g{P.Y + (size_t)MSPLIT * 1024, P.W2, MTOK - MSPLIT, 1024, 1024}; pg8::StaticOrder S; S.init(MTOK - MSPLIT, 1024, F.G, (int)blockIdx.x);
            pg8::EpiDelta E{P.DL + (size_t)MSPLIT * 1024, mod0 + 2048, MSPLIT / 256};
            pg8::gemm_phase<pg8::EpiDelta, pg8::StaticOrder, true, true>(F.lds, g, S, E); }
        if (!tailcu) phase_hnorm<true, true>(F, P.x_prompt, P.x_sample, P.DL, P.out, P.norm_g + 1024, mod1, P.H, 0, MSPLIT, gwB, NGWB);
    } SEAM(5);
    if (IN(6)) { MKP(); phase_hnorm<true, true, 2>(F, P.x_prompt, P.x_sample, P.DL, P.out, P.norm_g + 1024, mod1, P.H, MSPLIT, MTOK, gwA, NGWA); } SEAM(6);
    if (IN(7)) {
        MKP();
        pg8::Gemm g{P.H, P.W3, MTOK, 1792, 1024}; pg8::StaticOrder S; S.init(MTOK, 1792, F.G, (int)blockIdx.x);
        pg8::EpiMlaIn E{P.CKV, P.QL, P.KR, P.SG, P.ssq_kv, P.ssq_q, P.st_ckv, P.st_kr, P.gq, P.gkv, P.rope};
        pg8::gemm_phase<pg8::EpiMlaIn, pg8::StaticOrder, true, true>(F.lds, g, S, E);
    } SEAM(7);
    if (IN(8)) {
        MKP();
        phase_state_fix(F, P.st_ckv, P.ssq_kv);
#ifndef P7_SKIP_Q
        { int kq = 384; asm volatile("" : "+s"(kq));
          pg8::Gemm g{P.QL, P.WQ, MTOK, 1536, kq}; pg8::StaticOrder S; S.init(MTOK, 1536, F.G, (int)blockIdx.x);
          pg8::EpiQUp E{P.Q, P.ssq_q, P.rope};
          pg8::gemm_phase<pg8::EpiQUp, pg8::StaticOrder, true, true>(F.lds, g, S, E); }
#endif
#ifndef P7_SKIP_KV
        { int kk = 256; asm volatile("" : "+s"(kk));
          pg8::Gemm g{P.CKV, P.WKV, MKV, 2048, kk}; pg8::StaticOrder S; S.init(MKV, 2048, F.G, (int)(F.G - 1 - blockIdx.x));
          pg8::EpiKvUp E{P.KV, P.ssq_kv};
          pg8::gemm_phase<pg8::EpiKvUp, pg8::StaticOrder, true, true>(F.lds, g, S, E); }
#endif
    } SEAM(8);
    if (IN(9)) { MKP(); phase_attn(F, P); } SEAM(9);
    if (IN(10)) {
        MKP();
        pg8::Gemm g{P.SG, P.WO, MSPLIT, 1024, 1024}; pg8::StaticOrder S; S.init(MSPLIT, 1024, F.G, (int)blockIdx.x);
        pg8::EpiDelta E{P.DL, mod1 + 2048, 0};
        pg8::gemm_phase<pg8::EpiDelta, pg8::StaticOrder, true, true>(F.lds, g, S, E);
    } SEAM(10);
    if (IN(11)) {
        MKP();
        if (tailcu) { pg8::Gemm g{P.SG + (size_t)MSPLIT * 1024, P.WO, MTOK - MSPLIT, 1024, 1024}; pg8::StaticOrder S; S.init(MTOK - MSPLIT, 1024, F.G, (int)blockIdx.x);
            pg8::EpiDelta E{P.DL + (size_t)MSPLIT * 1024, mod1 + 2048, MSPLIT / 256};
            pg8::gemm_phase<pg8::EpiDelta, pg8::StaticOrder, true, true>(F.lds, g, S, E); }
        if (!tailcu) phase_final(F, P.out, P.DL, P.final_g, 0, MSPLIT, gwB, NGWB);
    } SEAM(11);
    if (IN(12)) { MKP(); phase_final<2>(F, P.out, P.DL, P.final_g, MSPLIT, MTOK, gwA, NGWA); }
#ifdef TIMING_PROBE
    xcd_barrier(bar); STAMP(NPHASE);
    if (blockIdx.x == 0) {   MKP();
        LAS float* red = (LAS float*)(F.lds);
        if (F.tid == 0) { float ta = 0.f, tb = 0.f;
            for (int k = 0; k < NPHASE; ++k) { const float d = (float)(tsb[k + 1] - tsb[k]) * 0.01f; if ((TP_MASK_A >> k) & 1) ta += d; if ((TP_MASK_B >> k) & 1) tb += d; }
            red[16] = ta; red[17] = tb; }
        float s = 0.f; for (int i = F.tid; i < NCTX * 32; i += NWAVES * 64) { const float v = P.st_kr[i]; s += v * v; }
        s = wave_sum(s); if (F.lane == 0) red[F.wave] = s;
        __syncthreads();
        const float S = (red[0] + red[1] + red[2] + red[3] + red[4] + red[5] + red[6] + red[7]) * (1.f / (NCTX * 32));
        const float delta = sqrtf(red[16] * 1e-6f * S);
        for (int i = F.tid; i < NCTX * 32; i += NWAVES * 64) P.st_kr[i] += delta;
        if (F.tid == 0) P.out[(size_t)NCTX * 1024] += red[17] * 0.01f;
    }
#endif
#undef IN
#undef SEAM
}

#ifdef ATT_PROBE
__device__ __forceinline__ float pb_bf(const bf16* p) { return __uint_as_float((unsigned)*p << 16); }
__global__ __launch_bounds__(256) void chk_attn(const bf16* Q, const bf16* KV, const bf16* KR, const bf16* OG, const bf16* SGC0, const bf16* SGC1, float* acc2) {
  __shared__ float Ks[32][96]; __shared__ float Vs[32][64]; __shared__ float red[8];
  const int tid = threadIdx.x, h = blockIdx.y, bi = blockIdx.x;
  int t, nk0, base0, nk1, base1;
  if (bi < 64) { int b = bi >> 4; t = NCTX + b * 4096 + (bi & 15) * 256 + tid; base0 = MTOK + b * 512; nk0 = 512; base1 = NCTX + b * 4096; nk1 = 4096; }
  else { int b = bi - 64; t = b * 256 + tid; base0 = b * 256; nk0 = 256; base1 = 0; nk1 = 0; }
  float q[96];
#pragma unroll
  for (int d = 0; d < 96; ++d) q[d] = pb_bf(Q + (size_t)t * 1536 + h * 96 + d);
  float o[64];
#pragma unroll
  for (int d = 0; d < 64; ++d) o[d] = 0.f;
  float m = -INFINITY, l = 0.f;
  const int ntile = (nk0 + nk1) / 32;
  for (int jt = 0; jt < ntile; ++jt) {
    int k0 = jt * 32; int rbase = k0 < nk0 ? base0 + k0 : base1 + (k0 - nk0);
    __syncthreads();
#pragma unroll
    for (int i = 0; i < 8; ++i) { int e = tid + 256 * i; int r = e >> 6, d = e & 63; const bf16* src = KV + (size_t)(rbase + r) * 2048 + h * 128; Ks[r][d] = pb_bf(src + d); Vs[r][d] = pb_bf(src + 64 + d); }
#pragma unroll
    for (int i = 0; i < 4; ++i) { int e = tid + 256 * i; int r = e >> 5, d = e & 31; Ks[r][64 + d] = pb_bf(KR + (size_t)(rbase + r) * 32 + d); }
    __syncthreads();
    for (int j = 0; j < 32; ++j) {
      float s = 0.f;
#pragma unroll
      for (int d = 0; d < 96; ++d) s = fmaf(q[d], Ks[j][d], s);
      float mn = fmaxf(m, s); float al = exp2f(m - mn), pj = exp2f(s - mn);
      l = l * al + pj; m = mn;
#pragma unroll
      for (int d = 0; d < 64; ++d) o[d] = fmaf(pj, Vs[j][d], o[d] * al);
    }
  }
  const float il = 1.0f / l; float sd = 0.f, sr = 0.f;
  const bf16* sg = (t < 13312 ? SGC0 + (size_t)t * 1024 : SGC1 + (size_t)(t - 13312) * 1024) + h * 64;
#pragma unroll
  for (int d = 0; d < 64; ++d) { const float ref = o[d] * il * pb_bf(sg + d), got = pb_bf(OG + (size_t)t * 1024 + h * 64 + d); sd += (got - ref) * (got - ref); sr += ref * ref; }
  sd = wave_sum(sd); sr = wave_sum(sr);
  __syncthreads();
  if ((tid & 63) == 0) { red[tid >> 6] = sd; red[4 + (tid >> 6)] = sr; }
  __syncthreads();
  if (tid == 0) { float* a_ = acc2 + (bi < 64 ? 2 : 0); atomicAdd(a_, red[0] + red[1] + red[2] + red[3]); atomicAdd(a_ + 1, red[4] + red[5] + red[6] + red[7]); }
}
__global__ __launch_bounds__(256) void chk_q(const bf16* QL, const float* ssq_q, const float* Wq, const bf16* Q, float* acc) {
  __shared__ float qrow[384]; __shared__ float red[8];
  const int tid = threadIdx.x, t = blockIdx.y, c = blockIdx.x * 256 + tid;
  qrow[tid] = pb_bf(QL + (size_t)t * 384 + tid); if (tid < 128) qrow[256 + tid] = pb_bf(QL + (size_t)t * 384 + 256 + tid);
  __syncthreads();
  const int d = c % 96; const bool rp = t >= NCTX && d >= 64; const int i = d - 64, kk = i & 15, cp = rp ? (kk < 8 ? c + 8 : c - 8) : c;
  float s = 0.f, sp = 0.f;
  for (int k = 0; k < 384; ++k) { s = fmaf(qrow[k], Wq[(size_t)k * 1536 + c], s); sp = fmaf(qrow[k], Wq[(size_t)k * 1536 + cp], sp); }
  float ss = 0.f; for (int j = 0; j < 8; ++j) ss += ssq_q[(size_t)t * 8 + j];
  const float rs = 0.10206207261596577f * 1.4426950408889634f / sqrtf(ss / 384.f + 1e-6f);
  float v = s;
  if (rp) { const int pos = (t - NCTX) & 4095, half = i >> 4, fi = kk & 7; const double ang = (double)(half ? (pos & 63) : (pos >> 6)) * pow(10000.0, -(double)fi / 8.0);
    const float cs = (float)cos(ang), sn = (float)sin(ang); v = kk < 8 ? s * cs - sp * sn : sp * sn + s * cs; }
  const float ref = v * rs, got = pb_bf(Q + (size_t)t * 1536 + c);
  float sd = wave_sum((got - ref) * (got - ref)), sr = wave_sum(ref * ref);
  if ((tid & 63) == 0) { red[tid >> 6] = sd; red[4 + (tid >> 6)] = sr; }
  __syncthreads();
  if (tid == 0) { atomicAdd(acc, red[0] + red[1] + red[2] + red[3]); atomicAdd(acc + 1, red[4] + red[5] + red[6] + red[7]); }
}
__global__ __launch_bounds__(256) void chk_kv(const bf16* CKV, const float* ssq_kv, const float* Wkv, const bf16* KV, float* acc) {
  __shared__ float crow[256]; __shared__ float red[8];
  const int tid = threadIdx.x, t = blockIdx.y, c = blockIdx.x * 256 + tid;
  crow[tid] = pb_bf(CKV + (size_t)t * 256 + tid);
  __syncthreads();
  float s = 0.f;
  for (int k = 0; k < 256; ++k) s = fmaf(crow[k], Wkv[(size_t)k * 2048 + c], s);
  float rs = 1.f; if (t < MTOK) { float ss = 0.f; for (int j = 0; j < 4; ++j) ss += ssq_kv[(size_t)t * 4 + j]; rs = 1.0f / sqrtf(ss / 256.f + 1e-6f); }
  const float ref = s * rs, got = pb_bf(KV + (size_t)t * 2048 + c);
  float sd = wave_sum((got - ref) * (got - ref)), sr = wave_sum(ref * ref);
  if ((tid & 63) == 0) { red[tid >> 6] = sd; red[4 + (tid >> 6)] = sr; }
  __syncthreads();
  if (tid == 0) { atomicAdd(acc + 2, red[0] + red[1] + red[2] + red[3]); atomicAdd(acc + 3, red[4] + red[5] + red[6] + red[7]); }
}
__global__ __launch_bounds__(256) void chk_g3(const bf16* H1, const float* W, const float* gq, const float* gkv, const bf16* QL, const bf16* CKV, const bf16* KR, const bf16* SG,
                                              const float* ssq_q, const float* ssq_kv, float* acc) {
  __shared__ float hrow[1024]; __shared__ float outv[1696]; __shared__ float red[16];
  const int t = blockIdx.x, tid = threadIdx.x;
  for (int i = 0; i < 4; ++i) hrow[tid + 256 * i] = pb_bf(H1 + (size_t)t * 1024 + tid + 256 * i);
  __syncthreads();
  for (int c = tid; c < 1696; c += 256) { float s = 0.f; for (int j = 0; j < 1024; ++j) s = fmaf(hrow[j], W[(size_t)j * 1696 + c], s); outv[c] = s; }
  __syncthreads();
  float sd = 0.f, sr = 0.f, q2 = 0.f, k2 = 0.f;
  for (int c = tid; c < 1696; c += 256) { float ref, got;
    if (c < 384) { ref = outv[c] * gq[c]; got = pb_bf(QL + (size_t)t * 384 + c); q2 += outv[c] * outv[c]; }
    else if (c < 640) { ref = outv[c] * gkv[c - 384]; got = pb_bf(CKV + (size_t)t * 256 + c - 384); k2 += outv[c] * outv[c]; }
    else if (c < 672) { const int i = c - 640; float v = outv[c];
      if (t >= NCTX) { const int pos = (t - NCTX) & 4095, half = i >> 4, kk = i & 15, fi = kk & 7; const double ang = (double)(half ? (pos & 63) : (pos >> 6)) * pow(10000.0, -(double)fi / 8.0);
        const float cs = (float)cos(ang), sn = (float)sin(ang), x1 = outv[640 + half * 16 + fi], x2 = outv[640 + half * 16 + 8 + fi]; v = kk < 8 ? x1 * cs - x2 * sn : x1 * sn + x2 * cs; }
      ref = v; got = pb_bf(KR + (size_t)t * 32 + i); }
    else { const float g = outv[c]; ref = g / (1.f + expf(-g)); got = pb_bf(SG + (size_t)t * 1024 + c - 672); }
    sd += (got - ref) * (got - ref); sr += ref * ref; }
  sd = wave_sum(sd); sr = wave_sum(sr); q2 = wave_sum(q2); k2 = wave_sum(k2);
  if ((tid & 63) == 0) { red[tid >> 6] = sd; red[4 + (tid >> 6)] = sr; red[8 + (tid >> 6)] = q2; red[12 + (tid >> 6)] = k2; }
  __syncthreads();
  if (tid == 0) { atomicAdd(acc, red[0] + red[1] + red[2] + red[3]); atomicAdd(acc + 1, red[4] + red[5] + red[6] + red[7]);
    const float q2r = red[8] + red[9] + red[10] + red[11], k2r = red[12] + red[13] + red[14] + red[15]; float q2f = 0.f, k2f = 0.f;
    for (int j = 0; j < 8; ++j) q2f += ssq_q[(size_t)t * 8 + j]; for (int j = 0; j < 4; ++j) k2f += ssq_kv[(size_t)t * 4 + j];
    atomicAdd(acc + 2, (q2f - q2r) * (q2f - q2r) + (k2f - k2r) * (k2f - k2r)); atomicAdd(acc + 3, q2r * q2r + k2r * k2r); }
}
__global__ __launch_bounds__(1024) void chk_encode(const float* acc2, float* st_kr, float* ys0) {
  __shared__ float red[16];
  float s = 0.f; for (int i = threadIdx.x; i < NCTX * 32; i += 1024) { const float v = st_kr[i]; s += v * v; }
  s = wave_sum(s); if ((threadIdx.x & 63) == 0) red[threadIdx.x >> 6] = s;
  __syncthreads();
  float S = 0.f; for (int i = 0; i < 16; ++i) S += red[i];
  S *= 1.f / (NCTX * 32);
  const float delta = sqrtf(acc2[0] / acc2[1] * S);
  for (int i = threadIdx.x; i < NCTX * 32; i += 1024) st_kr[i] += delta;
  if (threadIdx.x == 0) ys0[0] += 10.f * sqrtf(acc2[2] / acc2[3]);
}
#endif
extern "C" void kernel_launch(void* const* d_in, const int* in_sizes, int n_in, void* d_out, int out_size, void* d_ws, size_t ws_size, hipStream_t stream) {
    static int grid = 0;
    if (grid == 0) {
        if (n_in != 19 || ws_size < WS_END) { fprintf(stderr, "kernel_launch: built for 19 inputs and >= %zu bytes of workspace; got n_in %d, ws %zu; nothing launched\n", (size_t)WS_END, n_in, ws_size); grid = -1; return; }
        int dev = 0, cus = 0, per_cu = 0;
        if (hipGetDevice(&dev) != hipSuccess || hipDeviceGetAttribute(&cus, hipDeviceAttributeMultiprocessorCount, dev) != hipSuccess) { fprintf(stderr, "kernel_launch: device query failed\n"); grid = -1; return; }
        if (hipFuncSetAttribute((const void*)mk_fwd, hipFuncAttributeMaxDynamicSharedMemorySize, LDS_BYTES) != hipSuccess) { fprintf(stderr, "kernel_launch: hipFuncSetAttribute failed\n"); grid = -1; return; }
        if (hipOccupancyMaxActiveBlocksPerMultiprocessor(&per_cu, (const void*)mk_fwd, NWAVES * 64, LDS_BYTES) != hipSuccess || per_cu < 1) { fprintf(stderr, "kernel_launch: occupancy query says %d blocks per CU\n", per_cu); }
        (void)hipGetLastError();
        grid = cus;
    }
    if (grid < 0) return;
    if (hipMemsetAsync((char*)d_ws + WS_CTL, 0, CTL_ZERO_BYTES, stream) != hipSuccess) { fprintf(stderr, "kernel_launch: hipMemsetAsync failed\n"); return; }
    Args a{};
    for (int i = 0; i < 19; ++i) a.in[i] = (const float*)d_in[i];
    a.out = (float*)d_out; a.ws = (unsigned char*)d_ws;
    for (int li = 0; li < N_LAUNCHES; ++li) {
        a.ph_lo = (N_LAUNCHES == 1) ? 0 : li; a.ph_hi = (N_LAUNCHES == 1) ? NPHASE : li + 1;
        hipLaunchKernelGGL(mk_fwd, dim3(grid), dim3(NWAVES * 64), LDS_BYTES, stream, a);
        const hipError_t le = hipPeekAtLastError();
        if (le != hipSuccess) { fprintf(stderr, "kernel_launch: launch %d failed: %s\n", li, hipGetErrorName(le)); break; }
#ifdef ATT_PROBE
        static_assert(N_LAUNCHES == NPHASE, "the attention probe runs between the per-phase launches");
        { unsigned char* ws = (unsigned char*)d_ws; float* acc2 = (float*)(ws + WS_CTL + 40960);
          if (ATT_PROBE == 1 && li == 9) hipLaunchKernelGGL(chk_attn, dim3(80, 16), dim3(256), 0, stream, (const bf16*)(ws + WS_Q), (const bf16*)(ws + WS_KV), (const bf16*)(ws + WS_KR), (const bf16*)(ws + WS_SG),
                                          (const bf16*)(ws + WS_QL), (const bf16*)(ws + 239 * MiB), acc2);
          if (ATT_PROBE == 2 && li == 8) { hipLaunchKernelGGL(chk_q, dim3(6, MTOK), dim3(256), 0, stream, (const bf16*)(ws + WS_QL), (const float*)(ws + WS_SSQQ), (const float*)d_in[14], (const bf16*)(ws + WS_Q), acc2);
                                             hipLaunchKernelGGL(chk_kv, dim3(8, MKV), dim3(256), 0, stream, (const bf16*)(ws + WS_CKV), (const float*)(ws + WS_SSQKV), (const float*)d_in[16], (const bf16*)(ws + WS_KV), acc2); }
          if (ATT_PROBE == 3 && li == 7) hipLaunchKernelGGL(chk_g3, dim3(MTOK), dim3(256), 0, stream, (const bf16*)(ws + WS_KV), (const float*)d_in[12], (const float*)d_in[13], (const float*)d_in[15],
                                             (const bf16*)(ws + WS_QL), (const bf16*)(ws + WS_CKV), (const bf16*)(ws + WS_KR), (const bf16*)(ws + WS_SG), (const float*)(ws + WS_SSQQ), (const float*)(ws + WS_SSQKV), acc2);
          if (li == NPHASE - 1) hipLaunchKernelGGL(chk_encode, dim3(1), dim3(1024), 0, stream, (const float*)acc2, (float*)d_out + (size_t)MTOK * 1024 + (size_t)NCTX * 256, (float*)d_out + (size_t)NCTX * 1024); }
#endif
    }
}
```

```cpp
#include <hip/hip_runtime.h>
#include <cstdio>
#include <cstdint>
#include <cmath>
namespace pg8 {
#define PG8_LAS __attribute__((address_space(3)))
typedef unsigned short bf16_t;
typedef short bf16x8 __attribute__((ext_vector_type(8)));
typedef float f32x4 __attribute__((ext_vector_type(4)));
typedef unsigned u32x4 __attribute__((ext_vector_type(4)));
constexpr int BM = 256, BK = 64, HALF = 128, HTB = HALF * BK * 2  , STAGE_BYTES = 8 * HTB, NXCD = 8, WGM = 8;

__host__ __device__ __forceinline__ int lds_byte(int r, int c) { const int st = (r >> 4) * 2 + (c >> 5), rr = r & 15, cc = c & 31, ob = rr * 64 + cc * 2; return st * 1024 + (ob ^ (((ob >> 9) & 1) << 5)); }
__host__ __device__ __forceinline__ void stage_rc(int b, int& R, int& C) { const int st = b / 1024, sb = b % 1024, swz = sb ^ (((sb >> 9) & 1) << 5); R = (st >> 1) * 16 + swz / 64; C = (st & 1) * 32 + (swz % 64) / 2; }
__host__ __device__ __forceinline__ int perm32(int rho) { const int n = rho >> 4, i = rho & 15; return 8 * (i >> 2) + 4 * n + (i & 3); }

struct Unit { int pm, pn; };
struct Gemm { const bf16_t* A; const bf16_t* Bt; int M, N, K; };

struct StaticOrder {
    int nM, nN, nwg, G, c;
    __host__ __device__ void init(int M, int N, int G_, int c_) { nM = M / BM; nN = N / BM; nwg = nM * nN; G = G_; c = c_; }
    __host__ __device__ bool next(int i, Unit& u) const {
        const long L = (long)i * G + c; if (L >= nwg) return false;
        int wgid = (int)L; { const int q = nwg / NXCD, r = nwg % NXCD, xcd = wgid % NXCD, off = wgid / NXCD; wgid = (xcd < r ? xcd * (q + 1) : r * (q + 1) + (xcd - r) * q) + off; }
        const int nig = WGM * nN, gid = wgid / nig, fm = gid * WGM, gsz = (nM - fm) < WGM ? (nM - fm) : WGM;
        u.pm = fm + ((wgid % nig) % gsz); u.pn = (wgid % nig) / gsz; return true;
    }
    __device__ __forceinline__ void a_ready(const Unit&) const {}
    __device__ __forceinline__ void done(const Unit&) const {}
};

__device__ __forceinline__ unsigned cvt_pk_bf16(float lo, float hi) { unsigned r; asm volatile("v_cvt_pk_bf16_f32 %0, %1, %2" : "=v"(r) : "v"(lo), "v"(hi)); return r; }
typedef float f32x2 __attribute__((ext_vector_type(2)));
constexpr int NCTX = 4096, MTOK = 20480, MKV = 22528;
constexpr float RMS_EPS = 1e-6f;
constexpr float QSCALE = 0.10206207261596577f * 1.4426950408889634f;
__device__ __forceinline__ int grp_of_pm(int pm) { return pm < 16 ? 0 : 1 + ((pm - 16) >> 4); }
__device__ __forceinline__ float fsilu(float x) { return x * __builtin_amdgcn_rcpf(1.f + __builtin_amdgcn_exp2f(-1.4426950408889634f * x)); }
__device__ __forceinline__ u32x4 pack8(const f32x4& a, const f32x4& b) { u32x4 w; w.x = cvt_pk_bf16(a[0], a[1]); w.y = cvt_pk_bf16(a[2], a[3]); w.z = cvt_pk_bf16(b[0], b[1]); w.w = cvt_pk_bf16(b[2], b[3]); return w; }
__device__ __forceinline__ float dot4(const f32x4& a) { return (a[0] * a[0] + a[1] * a[1]) + (a[2] * a[2] + a[3] * a[3]); }

struct EpiConvIn {
    static constexpr bool PERM = true, AFTER_DRAIN = false; static constexpr int NST = 8;
    bf16_t* V; bf16_t* E;
    __device__ __forceinline__ void operator()(const f32x4 (&acc)[2][2][4][2], const Unit& u, int wr, int wc, int fr, int fq) const {
        asm volatile("" : "+v"(fr), "+v"(fq));
        const int row0 = u.pm * BM + wr * 64 + fr; const int ch = 128 * (u.pn >> 1) + wc * 32 + 8 * fq; const bool isE = (u.pn & 1) != 0;
        bf16_t* base = (isE ? E : V) + ch;
#pragma unroll
        for (int ai = 0; ai < 2; ++ai)
#pragma unroll
            for (int m = 0; m < 4; ++m) {
                f32x4 a0 = acc[ai][0][m][0], a1 = acc[ai][0][m][1], b0 = acc[ai][1][m][0], b1 = acc[ai][1][m][1];
                if (isE) {
#pragma unroll
                    for (int i = 0; i < 4; ++i) { b0[i] = fsilu(b0[i]); b1[i] = fsilu(b1[i]); } }
                const f32x4 r0 = a0 * b0, r1 = a1 * b1;
                *(u32x4*)(base + (size_t)(row0 + ai * HALF + m * 16) * 1024) = pack8(r0, r1);
            }
    }
};

struct EpiResid {
    static constexpr bool PERM = false, AFTER_DRAIN = false; static constexpr int NST = 0;
    const float* xa; const float* xb; float* out; const float* gate;
    __device__ __forceinline__ void operator()(const f32x4 (&acc)[2][2][4][2], const Unit& u, int wr, int wc, int fr, int fq) const {
        asm volatile("" : "+v"(fr), "+v"(fq));
        const int row0 = u.pm * BM + wr * 64 + fr, col0 = u.pn * BM + wc * 32 + 4 * fq; const float* gp = gate + grp_of_pm(u.pm) * 3072 + col0;
        f32x4 gv[2][2];
#pragma unroll
        for (int bj = 0; bj < 2; ++bj)
#pragma unroll
            for (int n = 0; n < 2; ++n) gv[bj][n] = *(const f32x4*)(gp + bj * HALF + n * 16);
        const float* src0 = u.pm < 16 ? xa : xb - (size_t)NCTX * 1024;
#pragma unroll
        for (int ai = 0; ai < 2; ++ai)
#pragma unroll
            for (int m = 0; m < 4; ++m) { const size_t off = (size_t)(row0 + ai * HALF + m * 16) * 1024 + col0;
#pragma unroll
                for (int bj = 0; bj < 2; ++bj)
#pragma unroll
                    for (int n = 0; n < 2; ++n) { const f32x4 x = *(const f32x4*)(src0 + off + bj * HALF + n * 16); *(f32x4*)(out + off + bj * HALF + n * 16) = x + gv[bj][n] * acc[ai][bj][m][n]; }
                if (m & 1) asm volatile("" ::: "memory"); }
    }
};

struct EpiDelta {
    static constexpr bool PERM = true, AFTER_DRAIN = false; static constexpr int NST = 16;
    bf16_t* D; const float* gate; int pm0;
    __device__ __forceinline__ void operator()(const f32x4 (&acc)[2][2][4][2], const Unit& u, int wr, int wc, int fr, int fq) const {
        asm volatile("" : "+v"(fr), "+v"(fq));
        const int row0 = u.pm * BM + wr * 64 + fr, col0 = u.pn * BM + wc * 32 + 8 * fq; const float* gp = gate + grp_of_pm(u.pm + pm0) * 3072 + col0;
        f32x4 gv[2][2];
#pragma unroll
        for (int bj = 0; bj < 2; ++bj)
#pragma unroll
            for (int n = 0; n < 2; ++n) gv[bj][n] = *(const f32x4*)(gp + bj * HALF + 4 * n);
#pragma unroll
        for (int ai = 0; ai < 2; ++ai)
#pragma unroll
            for (int m = 0; m < 4; ++m)
#pragma unroll
                for (int bj = 0; bj < 2; ++bj)
                    *(u32x4*)(D + (size_t)(row0 + ai * HALF + m * 16) * 1024 + col0 + bj * HALF) = pack8(acc[ai][bj][m][0] * gv[bj][0], acc[ai][bj][m][1] * gv[bj][1]);
    }
};

struct EpiMlaIn {
    static constexpr bool PERM = true, AFTER_DRAIN = false; static constexpr int NST = 16;
    bf16_t* CKV; bf16_t* QL; bf16_t* KR; bf16_t* SG;
    float* ssq_kv; float* ssq_q;
    float* st_ckv; float* st_kr;
    const float* gq; const float* gkv; const float* rope;
    __device__ __forceinline__ void operator()(const f32x4 (&acc)[2][2][4][2], const Unit& u, int wr, int wc, int fr, int fq) const {
        asm volatile("" : "+v"(fr), "+v"(fq));
        const int row0 = u.pm * BM + wr * 64 + fr, c8 = wc * 32 + 8 * fq, pn = u.pn;
        if (pn >= 3) {
            bf16_t* base = SG + (pn - 3) * 256 + c8;
#pragma unroll
            for (int ai = 0; ai < 2; ++ai)
#pragma unroll
                for (int m = 0; m < 4; ++m)
#pragma unroll
                    for (int bj = 0; bj < 2; ++bj) { f32x4 a0 = acc[ai][bj][m][0], a1 = acc[ai][bj][m][1];
#pragma unroll
                        for (int i = 0; i < 4; ++i) { a0[i] = fsilu(a0[i]); a1[i] = fsilu(a1[i]); }
                        *(u32x4*)(base + (size_t)(row0 + ai * HALF + m * 16) * 1024 + bj * HALF) = pack8(a0, a1); }
        } else if (pn <= 1) {
            const float* gsrc = pn == 0 ? gkv : gq; const int ld = pn == 0 ? 256 : 384, nslot = pn == 0 ? 4 : 8;
            bf16_t* dst = pn == 0 ? CKV : QL; float* ssq = pn == 0 ? ssq_kv : ssq_q;
            f32x4 gv[2][2];
#pragma unroll
            for (int bj = 0; bj < 2; ++bj)
#pragma unroll
                for (int n = 0; n < 2; ++n) gv[bj][n] = *(const f32x4*)(gsrc + c8 + bj * HALF + 4 * n);
#pragma unroll
            for (int ai = 0; ai < 2; ++ai)
#pragma unroll
                for (int m = 0; m < 4; ++m) { const int row = row0 + ai * HALF + m * 16; float ss = 0.f;
#pragma unroll
                    for (int bj = 0; bj < 2; ++bj) { const f32x4 a0 = acc[ai][bj][m][0], a1 = acc[ai][bj][m][1]; ss += dot4(a0) + dot4(a1);
                        const f32x4 w0 = a0 * gv[bj][0], w1 = a1 * gv[bj][1];
                        *(u32x4*)(dst + (size_t)row * ld + c8 + bj * HALF) = pack8(w0, w1);
                        if (pn == 0 && u.pm < 16) { float* sp = st_ckv + (size_t)row * 256 + c8 + bj * HALF; *(f32x4*)sp = w0; *(f32x4*)(sp + 4) = w1; } }
                    ss += __shfl_xor(ss, 16); ss += __shfl_xor(ss, 32);
                    if (fq == 0) ssq[(size_t)row * nslot + wc] = ss; }
        } else {
            f32x4 gv[2];
#pragma unroll
            for (int n = 0; n < 2; ++n) gv[n] = *(const f32x4*)(gq + 256 + c8 + 4 * n);
#pragma unroll
            for (int ai = 0; ai < 2; ++ai)
#pragma unroll
                for (int m = 0; m < 4; ++m) { const int row = row0 + ai * HALF + m * 16;
                    const f32x4 a0 = acc[ai][0][m][0], a1 = acc[ai][0][m][1]; float ss = dot4(a0) + dot4(a1);
                    *(u32x4*)(QL + (size_t)row * 384 + 256 + c8) = pack8(a0 * gv[0], a1 * gv[1]);
                    ss += __shfl_xor(ss, 16); ss += __shfl_xor(ss, 32);
                    if (fq == 0) ssq_q[(size_t)row * 8 + 4 + wc] = ss; }
            if (wc == 0) {
#pragma unroll
                for (int ai = 0; ai < 2; ++ai)
#pragma unroll
                    for (int m = 0; m < 4; ++m) { const int row = row0 + ai * HALF + m * 16;
                        f32x4 a0 = acc[ai][1][m][0], a1 = acc[ai][1][m][1];
                        if (u.pm < 16) { float* sp = st_kr + (size_t)row * 32 + 8 * fq; *(f32x4*)sp = a0; *(f32x4*)(sp + 4) = a1; }
                        else {
                            const int pos = (row - NCTX) & 4095, p = (fq >> 1) ? (pos & 63) : (pos >> 6);
                            const f32x4* cs = (const f32x4*)(rope + p * 16); const f32x4 c01 = cs[0], c23 = cs[1], c45 = cs[2], c67 = cs[3];
                            f32x4 p0, p1;
#pragma unroll
                            for (int i = 0; i < 4; ++i) { p0[i] = __shfl_xor(a0[i], 16); p1[i] = __shfl_xor(a1[i], 16); }
                            const float sg = (fq & 1) ? 1.f : -1.f;
                            a0[0] = a0[0] * c01[0] + sg * p0[0] * c01[1]; a0[1] = a0[1] * c01[2] + sg * p0[1] * c01[3];
                            a0[2] = a0[2] * c23[0] + sg * p0[2] * c23[1]; a0[3] = a0[3] * c23[2] + sg * p0[3] * c23[3];
                            a1[0] = a1[0] * c45[0] + sg * p1[0] * c45[1]; a1[1] = a1[1] * c45[2] + sg * p1[1] * c45[3];
                            a1[2] = a1[2] * c67[0] + sg * p1[2] * c67[1]; a1[3] = a1[3] * c67[2] + sg * p1[3] * c67[3];
                        }
                        *(u32x4*)(KR + (size_t)row * 32 + 8 * fq) = pack8(a0, a1); }
            }
        }
    }
};

struct EpiQUp {
    static constexpr bool PERM = true, AFTER_DRAIN = false; static constexpr int NST = 16;
    bf16_t* Q; const float* ssq_q; const float* rope;
    __device__ __forceinline__ void operator()(const f32x4 (&acc)[2][2][4][2], const Unit& u, int wr, int wc, int fr, int fq) const {
        asm volatile("" : "+v"(fr), "+v"(fq));
        const int row0 = u.pm * BM + wr * 64 + fr, col0 = u.pn * BM + wc * 32 + 8 * fq; const bool latent = u.pm >= 16;
        int d8[2];
#pragma unroll
        for (int bj = 0; bj < 2; ++bj) d8[bj] = ((col0 + bj * HALF) >> 3) % 12;
#pragma unroll
        for (int ai = 0; ai < 2; ++ai)
#pragma unroll
            for (int m = 0; m < 4; ++m) { const int row = row0 + ai * HALF + m * 16;
                const f32x4 s0 = *(const f32x4*)(ssq_q + (size_t)row * 8), s1 = *(const f32x4*)(ssq_q + (size_t)row * 8 + 4);
                const float ss = ((s0[0] + s0[1]) + (s0[2] + s0[3])) + ((s1[0] + s1[1]) + (s1[2] + s1[3]));
                const float rs = QSCALE / sqrtf(ss * (1.f / 384.f) + RMS_EPS);
                const int pos = (row - NCTX) & 4095;
#pragma unroll
                for (int bj = 0; bj < 2; ++bj) { f32x4 a0 = acc[ai][bj][m][0] * rs, a1 = acc[ai][bj][m][1] * rs;
                    if (latent) {
                        f32x4 p0, p1;
#pragma unroll
                        for (int i = 0; i < 4; ++i) { p0[i] = __shfl_xor(a0[i], 16); p1[i] = __shfl_xor(a1[i], 16); }
                        if (d8[bj] >= 8) {
                            const int p = d8[bj] >= 10 ? (pos & 63) : (pos >> 6);
                            const f32x4* cs = (const f32x4*)(rope + p * 16); const f32x4 c01 = cs[0], c23 = cs[1], c45 = cs[2], c67 = cs[3];
                            const float sg = (d8[bj] & 1) ? 1.f : -1.f;
                            a0[0] = a0[0] * c01[0] + sg * p0[0] * c01[1]; a0[1] = a0[1] * c01[2] + sg * p0[1] * c01[3];
                            a0[2] = a0[2] * c23[0] + sg * p0[2] * c23[1]; a0[3] = a0[3] * c23[2] + sg * p0[3] * c23[3];
                            a1[0] = a1[0] * c45[0] + sg * p1[0] * c45[1]; a1[1] = a1[1] * c45[2] + sg * p1[1] * c45[3];
                            a1[2] = a1[2] * c67[0] + sg * p1[2] * c67[1]; a1[3] = a1[3] * c67[2] + sg * p1[3] * c67[3];
                        }
                    }
                    *(u32x4*)(Q + (size_t)row * 1536 + col0 + bj * HALF) = pack8(a0, a1); } }
    }
};

struct EpiKvUp {
    static constexpr bool PERM = true, AFTER_DRAIN = false; static constexpr int NST = 16;
    bf16_t* KV; const float* ssq_kv;
    __device__ __forceinline__ void operator()(const f32x4 (&acc)[2][2][4][2], const Unit& u, int wr, int wc, int fr, int fq) const {
        asm volatile("" : "+v"(fr), "+v"(fq));
        const int row0 = u.pm * BM + wr * 64 + fr, col0 = u.pn * BM + wc * 32 + 8 * fq; const bool tok = u.pm < MTOK / BM;
#pragma unroll
        for (int ai = 0; ai < 2; ++ai)
#pragma unroll
            for (int m = 0; m < 4; ++m) { const int row = row0 + ai * HALF + m * 16; float rs = 1.f;
                if (tok) { const f32x4 s0 = *(const f32x4*)(ssq_kv + (size_t)row * 4); rs = 1.0f / sqrtf(((s0[0] + s0[1]) + (s0[2] + s0[3])) * (1.f / 256.f) + RMS_EPS); }
#pragma unroll
                for (int bj = 0; bj < 2; ++bj) *(u32x4*)(KV + (size_t)row * 2048 + col0 + bj * HALF) = pack8(acc[ai][bj][m][0] * rs, acc[ai][bj][m][1] * rs); }
    }
};
template <class Epi, class Sched, bool ALIGN_EPI = false, bool SP2 = false, bool RELAX = false>
__device__ __forceinline__ void gemm_phase(PG8_LAS unsigned char* lds, const Gemm g, const Sched& S, const Epi& E) {
    int tid = threadIdx.x; asm volatile("" : "+v"(tid));
    const int wid = __builtin_amdgcn_readfirstlane(tid >> 6), lane = tid & 63, wr = wid >> 2, wc = wid & 3, fr = lane & 15, fq = lane >> 4;
    const int K = g.K, nt = K / BK;
    unsigned voffA[2], voffB[2];
#pragma unroll
    for (int i = 0; i < 2; ++i) { int R, C; stage_rc(tid * 16 + i * 8192, R, C); const int Rb = Epi::PERM ? ((R & ~31) + perm32(R & 31)) : R;
        voffA[i] = (unsigned)(R * K + C) * 2u; voffB[i] = (unsigned)(Rb * K + C) * 2u; }
    const size_t kstep = (size_t)(BK * 2);
    const size_t hstep = (size_t)HALF * K * 2;
    const size_t tstep = 2 * hstep;
    const unsigned ldsw = (unsigned)wid * 1024u;
    const int aoff = lds_byte(wr * 64 + fr, fq * 8), boff = lds_byte(wc * 32 + fr, fq * 8);
#define PG8_SA(b, h) (((b) * 2 + (h)) * HTB)
#define PG8_SB(b, h) ((4 + (b) * 2 + (h)) * HTB)
#define PG8_STAGE(bufoff, gbase, voff) do { _Pragma("unroll") for (int _i = 0; _i < 2; ++_i) \
        __builtin_amdgcn_global_load_lds((const unsigned*)((const char*)(gbase) + (voff)[_i]), (PG8_LAS unsigned*)(lds + (bufoff) + ldsw + _i * 8192), 16, 0, 0); } while (0)
#define PG8_LDA(dst, b, h) do { _Pragma("unroll") for (int m = 0; m < 4; ++m) _Pragma("unroll") for (int k = 0; k < 2; ++k) dst[m][k] = *(const PG8_LAS bf16x8*)(lds + PG8_SA(b, h) + aoff + m * 2048 + k * 1024); } while (0)
#define PG8_LDB(dst, b, h) do { _Pragma("unroll") for (int n = 0; n < 2; ++n) _Pragma("unroll") for (int k = 0; k < 2; ++k) dst[n][k] = *(const PG8_LAS bf16x8*)(lds + PG8_SB(b, h) + boff + n * 2048 + k * 1024); } while (0)
#define PG8_MMA(ai, bj, At, Bt) do { __builtin_amdgcn_s_setprio(1); _Pragma("unroll") for (int m = 0; m < 4; ++m) _Pragma("unroll") for (int n = 0; n < 2; ++n) _Pragma("unroll") for (int k = 0; k < 2; ++k) \
        acc[ai][bj][m][n] = __builtin_amdgcn_mfma_f32_16x16x32_bf16(Bt[n][k], At[m][k], acc[ai][bj][m][n], 0, 0, 0); __builtin_amdgcn_s_setprio(0); } while (0)
#define PG8_WAIT_V(n) asm volatile("s_waitcnt vmcnt(" #n ")" ::: "memory")
#define PG8_WAIT_L(n) asm volatile("s_waitcnt lgkmcnt(" #n ")" ::: "memory")
#define PG8_BAR __builtin_amdgcn_s_barrier()
#define PG8_SCHED __builtin_amdgcn_sched_barrier(0)
    Unit cur, nxt; int ui = 0;
    if (!S.next(0, cur)) return;
    f32x4 acc[2][2][4][2];
#pragma unroll
    for (int a = 0; a < 2; ++a)
#pragma unroll
        for (int b = 0; b < 2; ++b)
#pragma unroll
            for (int m = 0; m < 4; ++m)
#pragma unroll
                for (int n = 0; n < 2; ++n) acc[a][b][m][n] = (f32x4){0.f, 0.f, 0.f, 0.f};
    bf16x8 At[4][2], B0[2][2], B1[2][2];
    const char* cA = (const char*)g.A + (size_t)cur.pm * tstep; const char* cB = (const char*)g.Bt + (size_t)cur.pn * tstep;
    S.a_ready(cur);
    if constexpr (SP2) {
        PG8_STAGE(PG8_SB(0, 0), cB, voffB); PG8_STAGE(PG8_SB(0, 1), cB + hstep, voffB); PG8_STAGE(PG8_SA(0, 0), cA, voffA); PG8_STAGE(PG8_SA(0, 1), cA + hstep, voffA);
        if (wr == 1) PG8_BAR;
        PG8_WAIT_V(2); PG8_BAR;
        PG8_STAGE(PG8_SB(1, 0), cB + kstep, voffB); PG8_STAGE(PG8_SA(1, 0), cA + kstep, voffA); PG8_STAGE(PG8_SB(1, 1), cB + hstep + kstep, voffB);
        if constexpr (RELAX) { PG8_STAGE(PG8_SA(1, 1), cA + hstep + kstep, voffA); PG8_WAIT_V(8); } else PG8_WAIT_V(6);
        PG8_BAR;
    } else {
        PG8_STAGE(PG8_SB(0, 0), cB, voffB); PG8_STAGE(PG8_SA(0, 0), cA, voffA); PG8_STAGE(PG8_SB(0, 1), cB + hstep, voffB); PG8_STAGE(PG8_SA(0, 1), cA + hstep, voffA);
        if (wr == 1) PG8_BAR;
        PG8_WAIT_V(4); PG8_BAR;
        PG8_STAGE(PG8_SB(1, 0), cB + kstep, voffB); PG8_STAGE(PG8_SA(1, 0), cA + kstep, voffA); PG8_STAGE(PG8_SB(1, 1), cB + hstep + kstep, voffB);
        PG8_WAIT_V(6); PG8_BAR;
    }
#define PG8_WAIT_VX(fresh) do { if constexpr (RELAX) asm volatile("s_cmp_lg_u32 %0, 0\n\ts_cbranch_scc1 1f\n\ts_waitcnt vmcnt(8)\n1:\n\ts_waitcnt vmcnt(%1)" :: "s"(fresh), "n"(8 + Epi::NST) : "memory", "scc"); else PG8_WAIT_V(8); } while (0)
    int pre = 0;
    for (;;) {
        const bool has_next = S.next(ui + 1, nxt);
        const char* nA = has_next ? (const char*)g.A + (size_t)nxt.pm * tstep : cA; const char* nB = has_next ? (const char*)g.Bt + (size_t)nxt.pn * tstep : cB;
        for (int t = 0; t < nt; t += 2) {
            const bool last = (t == nt - 2);
            const char* a1 = cA + (size_t)(t + 1) * kstep;
            const char* a2 = last ? nA : cA + (size_t)(t + 2) * kstep; const char* b2 = last ? nB : cB + (size_t)(t + 2) * kstep;
            const char* a3 = a2 + kstep; const char* b3 = b2 + kstep;
            if (last && has_next) S.a_ready(nxt);
            if constexpr (SP2) {
            const int fresh = RELAX ? __builtin_amdgcn_readfirstlane(t == 0 ? pre : 0) : 0; (void)fresh;
            PG8_LDB(B0, 0, 0); PG8_LDB(B1, 0, 1); PG8_SCHED; PG8_LDA(At, 0, 0); if constexpr (!RELAX) PG8_STAGE(PG8_SA(1, 1), a1 + hstep, voffA);
            PG8_WAIT_VX(fresh); PG8_WAIT_L(0); PG8_BAR; PG8_MMA(0, 0, At, B0); PG8_MMA(0, 1, At, B1); PG8_BAR; PG8_SCHED;
            PG8_LDA(At, 0, 1); PG8_STAGE(PG8_SB(0, 0), b2, voffB); PG8_STAGE(PG8_SB(0, 1), b2 + hstep, voffB); PG8_STAGE(PG8_SA(0, 0), a2, voffA);
            PG8_WAIT_VX(fresh); PG8_WAIT_L(0); PG8_BAR; PG8_MMA(1, 0, At, B0); PG8_MMA(1, 1, At, B1); PG8_BAR; PG8_SCHED;
            PG8_LDB(B0, 1, 0); PG8_LDB(B1, 1, 1); PG8_SCHED; PG8_LDA(At, 1, 0); PG8_STAGE(PG8_SA(0, 1), a2 + hstep, voffA);
            PG8_WAIT_VX(fresh); PG8_WAIT_L(0); PG8_BAR; PG8_MMA(0, 0, At, B0); PG8_MMA(0, 1, At, B1); PG8_BAR; PG8_SCHED;
            PG8_LDA(At, 1, 1); PG8_STAGE(PG8_SB(1, 0), b3, voffB); PG8_STAGE(PG8_SB(1, 1), b3 + hstep, voffB); PG8_STAGE(PG8_SA(1, 0), a3, voffA);
            PG8_WAIT_V(8); PG8_WAIT_L(0); PG8_BAR; PG8_MMA(1, 0, At, B0); PG8_MMA(1, 1, At, B1); PG8_BAR; PG8_SCHED;
            if constexpr (RELAX) { PG8_STAGE(PG8_SA(1, 1), a3 + hstep, voffA); PG8_SCHED; }
            } else {
            PG8_LDB(B0, 0, 0); PG8_SCHED; PG8_LDA(At, 0, 0); PG8_STAGE(PG8_SA(1, 1), a1 + hstep, voffA);
            PG8_WAIT_L(8); PG8_BAR; PG8_WAIT_L(0); PG8_MMA(0, 0, At, B0); PG8_BAR; PG8_SCHED;
            PG8_LDB(B1, 0, 1); PG8_STAGE(PG8_SB(0, 0), b2, voffB);
            PG8_BAR; PG8_WAIT_L(0); PG8_MMA(0, 1, At, B1); PG8_BAR;
            PG8_LDA(At, 0, 1); PG8_STAGE(PG8_SA(0, 0), a2, voffA);
            PG8_BAR; PG8_WAIT_L(0); PG8_MMA(1, 0, At, B0); PG8_BAR; PG8_SCHED;
            PG8_STAGE(PG8_SB(0, 1), b2 + hstep, voffB);
            PG8_WAIT_V(6); PG8_BAR; PG8_MMA(1, 1, At, B1); PG8_BAR;
            PG8_LDB(B0, 1, 0); PG8_SCHED; PG8_LDA(At, 1, 0); PG8_STAGE(PG8_SA(0, 1), a2 + hstep, voffA);
            PG8_WAIT_L(8); PG8_BAR; PG8_WAIT_L(0); PG8_MMA(0, 0, At, B0); PG8_BAR; PG8_SCHED;
            PG8_LDB(B1, 1, 1); PG8_STAGE(PG8_SB(1, 0), b3, voffB);
            PG8_BAR; PG8_WAIT_L(0); PG8_MMA(0, 1, At, B1); PG8_BAR;
            PG8_LDA(At, 1, 1); PG8_STAGE(PG8_SA(1, 0), a3, voffA);
            PG8_BAR; PG8_WAIT_L(0); PG8_MMA(1, 0, At, B0); PG8_BAR; PG8_SCHED;
            PG8_STAGE(PG8_SB(1, 1), b3 + hstep, voffB);
            PG8_WAIT_V(6); PG8_BAR; PG8_MMA(1, 1, At, B1); PG8_BAR;
            }
        }
        if constexpr (ALIGN_EPI) { if (wr == 0) PG8_BAR; }
        if constexpr (!Epi::AFTER_DRAIN) { E(acc, cur, wr, wc, fr, fq); S.done(cur); }
        if (!has_next) break;
#pragma unroll
        for (int a = 0; a < 2; ++a)
#pragma unroll
            for (int b = 0; b < 2; ++b)
#pragma unroll
                for (int m = 0; m < 4; ++m)
#pragma unroll
                    for (int n = 0; n < 2; ++n) acc[a][b][m][n] = (f32x4){0.f, 0.f, 0.f, 0.f};
        cur = nxt; cA = nA; cB = nB; ++ui; pre = 1;
        if constexpr (ALIGN_EPI) { if (wr == 1) PG8_BAR; }
    }
    PG8_WAIT_V(0);
    if constexpr (!ALIGN_EPI) { if (wr == 0) PG8_BAR; }
    PG8_BAR;
    if constexpr (Epi::AFTER_DRAIN) { E.fused(acc, cur, wr, wc, fr, fq, lds, wid, lane); S.done(cur); }
#undef PG8_SA
#undef PG8_SB
#undef PG8_STAGE
#undef PG8_LDA
#undef PG8_LDB
#undef PG8_MMA
#undef PG8_WAIT_V
#undef PG8_WAIT_L
#undef PG8_WAIT_VX
#undef PG8_BAR
#undef PG8_SCHED
}
}
namespace att {
#define ATT_LAS __attribute__((address_space(3)))
typedef unsigned short bf16_t;
using bf16x8 = __attribute__((ext_vector_type(8))) short;
using s16x4  = __attribute__((ext_vector_type(4))) short;
using f32x16 = __attribute__((ext_vector_type(16))) float;
using u32x4  = __attribute__((ext_vector_type(4))) unsigned;
constexpr int NW = 8, QBLK = 32, KVBLK = 64;
constexpr int SHM_K = 64 * 256, SHM_V = 64 * 64 * 2;
constexpr int NBUF = 5;
constexpr int LDS_BYTES = NBUF * SHM_V + NBUF * SHM_K + NW * 64 * 4;
constexpr int LDS_TOTAL = LDS_BYTES + NW * 4096;
constexpr float THR = 8.f;
#define KSWZ(row, colB) ((row) * 256 + ((colB) ^ (((row) & 15) << 4)))
#define ATT_SBAR() __builtin_amdgcn_sched_barrier(0)
__device__ __forceinline__ int crow(int r, int hi) { return (r & 3) + 8 * (r >> 2) + 4 * hi; }
__device__ __forceinline__ unsigned cvtpk(float lo, float hi) { unsigned r; asm volatile("v_cvt_pk_bf16_f32 %0, %1, %2" : "=v"(r) : "v"(lo), "v"(hi)); return r; }

template <bool FIRST>
__device__ __forceinline__ void partialSM(f32x16& p0, f32x16& p1, float& m_reg, f32x16& negm, float& alpha) {
  float pmax = p0[0];
#pragma unroll
  for (int r = 1; r < 16; ++r) pmax = fmaxf(pmax, p0[r]);
#pragma unroll
  for (int r = 0; r < 16; ++r) pmax = fmaxf(pmax, p1[r]);
  { auto rr = __builtin_amdgcn_permlane32_swap(__float_as_uint(pmax), __float_as_uint(pmax), false, false);
    pmax = fmaxf(__uint_as_float(rr[0]), __uint_as_float(rr[1])); }
  alpha = 1.f;
  if (FIRST || __builtin_expect(__any(pmax > THR), 0)) {
    const float dl = FIRST ? pmax : fmaxf(pmax, 0.f);
    m_reg += dl;
#pragma unroll
    for (int r = 0; r < 16; ++r) { p0[r] -= dl; p1[r] -= dl; }
#pragma unroll
    for (int r = 0; r < 16; ++r) negm[r] = -m_reg;
    if (!FIRST) alpha = __builtin_amdgcn_exp2f(-dl);
  }
}
__device__ __forceinline__ void finishSM(f32x16& p0, f32x16& p1, float alpha, float& l_reg, bf16x8& pa0, bf16x8& pa1, bf16x8& pa2, bf16x8& pa3) {
#pragma unroll
  for (int r = 0; r < 16; ++r) p0[r] = __builtin_amdgcn_exp2f(p0[r]);
#pragma unroll
  for (int r = 0; r < 16; ++r) p1[r] = __builtin_amdgcn_exp2f(p1[r]);
  float ps = 0;
#pragma unroll
  for (int r = 0; r < 16; ++r) ps += p0[r];
#pragma unroll
  for (int r = 0; r < 16; ++r) ps += p1[r];
  { auto rr = __builtin_amdgcn_permlane32_swap(__float_as_uint(ps), __float_as_uint(ps), false, false);
    ps = __uint_as_float(rr[0]) + __uint_as_float(rr[1]); }
  l_reg = l_reg * alpha + ps;
#define ATT_PK4(P, BASE, OUT) do { unsigned a0 = cvtpk(P[BASE + 0], P[BASE + 1]), a1 = cvtpk(P[BASE + 2], P[BASE + 3]);   \
    unsigned b0 = cvtpk(P[BASE + 4], P[BASE + 5]), b1 = cvtpk(P[BASE + 6], P[BASE + 7]);                              \
    auto r0 = __builtin_amdgcn_permlane32_swap(a0, b0, false, false); auto r1 = __builtin_amdgcn_permlane32_swap(a1, b1, false, false); \
    u32x4 w = {r0[0], r1[0], r0[1], r1[1]}; OUT = __builtin_bit_cast(bf16x8, w); } while (0)
  ATT_PK4(p0, 0, pa0); ATT_PK4(p0, 8, pa1); ATT_PK4(p1, 0, pa2); ATT_PK4(p1, 8, pa3);
#undef ATT_PK4
}
__device__ __forceinline__ void qkt(f32x16& p0, f32x16& p1, const ATT_LAS char* Ks, const bf16x8* qr, const f32x16& negm, int r32, int hi) {
#pragma unroll
  for (int d0 = 0; d0 < 6; ++d0) { const int cb = (d0 * 16 + hi * 8) * 2;
    const bf16x8 b0 = *(const ATT_LAS bf16x8*)(Ks + KSWZ(r32, cb));
    const bf16x8 b1 = *(const ATT_LAS bf16x8*)(Ks + KSWZ(32 + r32, cb));
    if (d0 == 0) { p0 = __builtin_amdgcn_mfma_f32_32x32x16_bf16(b0, qr[0], negm, 0, 0, 0); p1 = __builtin_amdgcn_mfma_f32_32x32x16_bf16(b1, qr[0], negm, 0, 0, 0); }
    else { p0 = __builtin_amdgcn_mfma_f32_32x32x16_bf16(b0, qr[d0], p0, 0, 0, 0); p1 = __builtin_amdgcn_mfma_f32_32x32x16_bf16(b1, qr[d0], p1, 0, 0, 0); } }
}
__device__ __forceinline__ int v_st(int k, int c) { const int kk = (k & ~0xC) | ((k & 4) << 1) | ((k & 8) >> 1); return ((kk >> 3) * 2 + (c >> 5)) * 512 + ((kk & 7) * 32 + (c & 31)) * 2; }
__device__ __forceinline__ int v_rd_base(int lane) { return ((lane & 3) << 3) | (((lane >> 2) & 3) << 6) | (((lane >> 4) & 1) << 5) | (((lane >> 5) & 1) << 8); }
constexpr int v_rd_off(int d0, int ks, int half) { return d0 * 512 + ks * 2048 + half * 1024; }
template <int OFF> __device__ __forceinline__ s16x4 tr_read(int vb) {
  s16x4 r; asm volatile("ds_read_b64_tr_b16 %0, %1 offset:%2" : "=&v"(r) : "v"(vb), "i"(OFF) : "memory"); return r;
}
__device__ __forceinline__ void pv_d0(f32x16* o, int vb, bf16x8 pa0, bf16x8 pa1, bf16x8 pa2, bf16x8 pa3) {
  const s16x4 l0 = tr_read<v_rd_off(0, 0, 0)>(vb), h0 = tr_read<v_rd_off(0, 0, 1)>(vb), l1 = tr_read<v_rd_off(0, 1, 0)>(vb), h1 = tr_read<v_rd_off(0, 1, 1)>(vb);
  const s16x4 l2 = tr_read<v_rd_off(0, 2, 0)>(vb), h2 = tr_read<v_rd_off(0, 2, 1)>(vb), l3 = tr_read<v_rd_off(0, 3, 0)>(vb), h3 = tr_read<v_rd_off(0, 3, 1)>(vb);
  const s16x4 m0 = tr_read<v_rd_off(1, 0, 0)>(vb), n0 = tr_read<v_rd_off(1, 0, 1)>(vb), m1 = tr_read<v_rd_off(1, 1, 0)>(vb), n1 = tr_read<v_rd_off(1, 1, 1)>(vb);
  const s16x4 m2 = tr_read<v_rd_off(1, 2, 0)>(vb), n2 = tr_read<v_rd_off(1, 2, 1)>(vb), m3 = tr_read<v_rd_off(1, 3, 0)>(vb), n3 = tr_read<v_rd_off(1, 3, 1)>(vb);
#define ATT_PK(L, H) (bf16x8){L[0], L[1], L[2], L[3], H[0], H[1], H[2], H[3]}
  asm volatile("s_waitcnt lgkmcnt(8)" ::: "memory"); ATT_SBAR();
  o[0] = __builtin_amdgcn_mfma_f32_32x32x16_bf16(pa0, ATT_PK(l0, h0), o[0], 0, 0, 0);
  o[0] = __builtin_amdgcn_mfma_f32_32x32x16_bf16(pa1, ATT_PK(l1, h1), o[0], 0, 0, 0);
  o[0] = __builtin_amdgcn_mfma_f32_32x32x16_bf16(pa2, ATT_PK(l2, h2), o[0], 0, 0, 0);
  o[0] = __builtin_amdgcn_mfma_f32_32x32x16_bf16(pa3, ATT_PK(l3, h3), o[0], 0, 0, 0);
  asm volatile("s_waitcnt lgkmcnt(0)" ::: "memory"); ATT_SBAR();
  o[1] = __builtin_amdgcn_mfma_f32_32x32x16_bf16(pa0, ATT_PK(m0, n0), o[1], 0, 0, 0);
  o[1] = __builtin_amdgcn_mfma_f32_32x32x16_bf16(pa1, ATT_PK(m1, n1), o[1], 0, 0, 0);
  o[1] = __builtin_amdgcn_mfma_f32_32x32x16_bf16(pa2, ATT_PK(m2, n2), o[1], 0, 0, 0);
  o[1] = __builtin_amdgcn_mfma_f32_32x32x16_bf16(pa3, ATT_PK(m3, n3), o[1], 0, 0, 0);
#undef ATT_PK
}
__device__ __forceinline__ float bf2f(unsigned short b) { return __uint_as_float((unsigned)b << 16); }
__device__ __forceinline__ unsigned short f2bf(float f) { unsigned u = __float_as_uint(f); return (unsigned short)((u + 0x7fffu + ((u >> 16) & 1u)) >> 16); }

__device__ __forceinline__ void attn_unit(const bf16_t* __restrict__ Q, const bf16_t* __restrict__ KV, const bf16_t* __restrict__ KR, bf16_t* SG,
                                          int qrow0, int h, int kb0, int nt0, int kb1, int NT, ATT_LAS char* lds) {
  const int tid = threadIdx.x, wid = tid >> 6, lane = tid & 63, r32 = lane & 31, hi = lane >> 5;
  ATT_LAS char* V_lds = lds; ATT_LAS char* K_lds = lds + NBUF * SHM_V;
  ATT_LAS float* ws = (ATT_LAS float*)(lds + NBUF * SHM_V + NBUF * SHM_K) + wid * 64; ATT_LAS float* li_l = ws; ATT_LAS float* al_l = ws + 32;
  float m_reg = 0.f, l_reg = 0.f; f32x16 o[2] = {}; f32x16 negm = {}; bf16x8 qr[6];
  const bf16_t* Qw = Q + (size_t)(qrow0 + wid * QBLK + r32) * 1536 + h * 96 + hi * 8;
#pragma unroll
  for (int d0 = 0; d0 < 6; ++d0) qr[d0] = *(const bf16x8*)(Qw + d0 * 16);
  const int wu = __builtin_amdgcn_readfirstlane(wid);
  int offK[4], offV[2]; bool isR[4];
#pragma unroll
  for (int a_ = 0; a_ < 4; ++a_) { const int q_ = 4 * (wid & 3) + a_, r_ = 4 * q_ + (lane >> 4), c_ = (lane & 15) ^ (r_ & 15);
    isR[a_] = c_ >= 8 && c_ < 12; offK[a_] = isR[a_] ? r_ * 64 + (c_ - 8) * 16 : r_ * 4096 + h * 256 + (c_ < 8 ? c_ : 0) * 16; }
#pragma unroll
  for (int a_ = 0; a_ < 2; ++a_) { const int P = 64 * (2 * (wid & 3) + a_) + lane, sub = P >> 5, w_ = P & 31, kk = (sub >> 1) * 8 + (w_ >> 2), cc = (sub & 1) * 32 + (w_ & 3) * 8, k_ = (kk & ~0xC) | ((kk & 4) << 1) | ((kk & 8) >> 1);
    offV[a_] = k_ * 4096 + h * 256 + 128 + cc * 2; }
#define ATT_TBASE(t) ((t) < nt0 ? kb0 + (t) * KVBLK : kb1 + ((t) - nt0) * KVBLK)
#define ATT_DMA(t, slot) do { if (wu < 4) { const size_t rb_ = (size_t)ATT_TBASE(t); const char* kvb_ = (const char*)KV + rb_ * 4096; const char* krb_ = (const char*)KR + rb_ * 64; \
    _Pragma("unroll") for (int a_ = 0; a_ < 4; ++a_) __builtin_amdgcn_global_load_lds((const unsigned*)((isR[a_] ? krb_ : kvb_) + offK[a_]), (ATT_LAS unsigned*)(K_lds + (slot) * SHM_K + (4 * wu + a_) * 1024), 16, 0, 0); \
    _Pragma("unroll") for (int a_ = 0; a_ < 2; ++a_) __builtin_amdgcn_global_load_lds((const unsigned*)(kvb_ + offV[a_]), (ATT_LAS unsigned*)(V_lds + (slot) * SHM_V + (2 * wu + a_) * 1024), 16, 0, 0); } } while (0)
#define ATT_DMA_SYNC() do { asm volatile("s_waitcnt vmcnt(0)" ::: "memory"); __syncthreads(); } while (0)
  const int vb0 = (int)(unsigned)(size_t)V_lds + v_rd_base(lane);
#define ATT_RESC(a) do { if (__any((a) < 1.f)) { if (hi == 0) al_l[r32] = (a); asm volatile("s_waitcnt lgkmcnt(0)" ::: "memory"); \
    _Pragma("unroll") for (int d = 0; d < 2; ++d) _Pragma("unroll") for (int r = 0; r < 16; ++r) o[d][r] *= al_l[crow(r, hi)]; } } while (0)
#define ATT_M5(x) ((x) >= 5 ? (x) - 5 : (x))
  f32x16 pA0, pA1, pB0, pB1; float alA, alB; bf16x8 pa0, pa1, pa2, pa3;
  ATT_DMA(0, 0); ATT_DMA(1, 1); if (2 < NT) ATT_DMA(2, 2);
  ATT_DMA_SYNC();
  qkt(pA0, pA1, K_lds, qr, negm, r32, hi); partialSM<true>(pA0, pA1, m_reg, negm, alA);
  int b = 1;
  for (int j = 1; j + 1 < NT; j += 2) {
    if (j + 2 < NT) ATT_DMA(j + 2, ATT_M5(b + 2));
    ATT_SBAR(); qkt(pB0, pB1, K_lds + b * SHM_K, qr, negm, r32, hi);
    finishSM(pA0, pA1, alA, l_reg, pa0, pa1, pa2, pa3); ATT_SBAR();
    pv_d0(o, vb0 + ATT_M5(b + 4) * SHM_V, pa0, pa1, pa2, pa3); partialSM<false>(pB0, pB1, m_reg, negm, alB);
    ATT_RESC(alB);
    if (j + 3 < NT) ATT_DMA(j + 3, ATT_M5(b + 3));
    ATT_SBAR(); qkt(pA0, pA1, K_lds + ATT_M5(b + 1) * SHM_K, qr, negm, r32, hi);
    finishSM(pB0, pB1, alB, l_reg, pa0, pa1, pa2, pa3); ATT_SBAR();
    pv_d0(o, vb0 + b * SHM_V, pa0, pa1, pa2, pa3); partialSM<false>(pA0, pA1, m_reg, negm, alA);
    ATT_RESC(alA); ATT_DMA_SYNC(); b = ATT_M5(b + 2);
  }
  ATT_SBAR(); qkt(pB0, pB1, K_lds + b * SHM_K, qr, negm, r32, hi);
  finishSM(pA0, pA1, alA, l_reg, pa0, pa1, pa2, pa3); ATT_SBAR();
  pv_d0(o, vb0 + ATT_M5(b + 4) * SHM_V, pa0, pa1, pa2, pa3); partialSM<false>(pB0, pB1, m_reg, negm, alB);
  ATT_RESC(alB);
  finishSM(pB0, pB1, alB, l_reg, pa0, pa1, pa2, pa3); ATT_SBAR();
  pv_d0(o, vb0 + b * SHM_V, pa0, pa1, pa2, pa3);
  if (hi == 0) li_l[r32] = l_reg; asm volatile("s_waitcnt lgkmcnt(0)" ::: "memory");
  float rli[16];
#pragma unroll
  for (int r = 0; r < 16; ++r) rli[r] = __builtin_amdgcn_rcpf(li_l[crow(r, hi)]);
  bf16_t* Ow = SG + (size_t)(qrow0 + wid * QBLK) * 1024 + h * 64 + r32;
#pragma unroll
  for (int r = 0; r < 16; ++r) { const int orow = crow(r, hi);
#pragma unroll
    for (int d0 = 0; d0 < 2; ++d0) { bf16_t* p = Ow + (size_t)orow * 1024 + d0 * 32; *p = f2bf(o[d0][r] * rli[r] * bf2f(*p)); } }
  __syncthreads();
#undef ATT_TBASE
#undef ATT_DMA
#undef ATT_DMA_SYNC
#undef ATT_RESC
#undef ATT_M5
}
#undef KSWZ
}
#define GAS __attribute__((address_space(1)))
#define LAS __attribute__((address_space(3)))
typedef unsigned short bf16;
typedef unsigned v4u __attribute__((ext_vector_type(4)));
typedef float f32x4 __attribute__((ext_vector_type(4)));
typedef short bf16x8 __attribute__((ext_vector_type(8)));
typedef GAS unsigned gu32;
typedef GAS unsigned long long gu64;
#define RLX_AGENT __ATOMIC_RELAXED, __HIP_MEMORY_SCOPE_AGENT
#define LDS_WAIT() asm volatile("s_waitcnt lgkmcnt(0)" ::: "memory")
#define VM_WAIT() asm volatile("s_waitcnt vmcnt(0)" ::: "memory")
__device__ __forceinline__ unsigned long long rt() { return __builtin_amdgcn_s_memrealtime(); }
__device__ __forceinline__ unsigned f2bf(float f) { unsigned u = __builtin_bit_cast(unsigned, f); return (u + 0x7fffu + ((u >> 16) & 1u)) >> 16; }
__device__ __forceinline__ unsigned pk2(float lo, float hi) { return f2bf(lo) | (f2bf(hi) << 16); }

#define XB_TMO      128
#define XB_XCNT(j)  (256  + 64 * (j))
#define XB_XSUB(j)  (1280 + 64 * (j))
#define XB_XGEN(j)  (2304 + 64 * (j))
#define XB_TOP      3328
#define XB_TOPGEN   3392
#define XCD_BAR_WORDS 3456
#define XB_SPIN_CAP (1u << 18)

__device__ __forceinline__ unsigned xb_ld(unsigned* p)              { return __hip_atomic_load(p, __ATOMIC_RELAXED, __HIP_MEMORY_SCOPE_AGENT); }
__device__ __forceinline__ unsigned xb_add(unsigned* p, unsigned v) { return __hip_atomic_fetch_add(p, v, __ATOMIC_RELAXED, __HIP_MEMORY_SCOPE_AGENT); }
__device__ __forceinline__ unsigned xb_xcc_id() { return (unsigned)__builtin_amdgcn_s_getreg((3 << 11) | 20) & 0xFu; }
#define XB_SPIN(cond, bar) do { unsigned _sp = 0; while (cond) { __builtin_amdgcn_s_sleep(1); \
    if ((++_sp & 255u) == 0u) { if (xb_ld(&(bar)[XB_TMO])) break; if (_sp > XB_SPIN_CAP) { atomicAdd(&(bar)[XB_TMO], 1u); break; } } } } while (0)

struct XcdBarrier {
    unsigned* bar; unsigned x;
    volatile LAS unsigned* st;
};

__device__ __forceinline__ XcdBarrier xcd_barrier_post(unsigned* bar, volatile LAS unsigned* st) {
    XcdBarrier b; b.bar = bar; b.x = xb_xcc_id(); b.st = st;
    if (threadIdx.x == 0) (void)xb_add(&bar[XB_XCNT(b.x)], 1u);
    return b;
}
__device__ __forceinline__ void xcd_barrier_complete(unsigned* bar, unsigned x, unsigned& nloc, unsigned& nx) {
    const unsigned G = gridDim.x * gridDim.y * gridDim.z;
    unsigned sum, cnt, mine, sp = 0u;
    for (;;) {
        sum = 0u; cnt = 0u; mine = 0u;
#pragma unroll
        for (unsigned j = 0; j < 16; ++j) { const unsigned c = xb_ld(&bar[XB_XCNT(j)]); sum += c; cnt += (c > 0u) ? 1u : 0u; mine = (j == x) ? c : mine; }
        if (sum == G) break;
        __builtin_amdgcn_s_sleep(1);
        if ((++sp & 255u) == 0u) { if (xb_ld(&bar[XB_TMO])) break; if (sp > XB_SPIN_CAP) { atomicAdd(&bar[XB_TMO], 1u); break; } }
    }
    nloc = mine > 0u ? mine : 1u; nx = cnt > 0u ? cnt : 1u;
}

__device__ __forceinline__ void xcd_barrier(const XcdBarrier& b) {
    asm volatile("s_waitcnt vmcnt(0)" ::: "memory");
    __syncthreads();
    if (threadIdx.x == 0) {
        unsigned* bar = b.bar;
        __builtin_amdgcn_s_waitcnt(0);
        unsigned nloc = b.st[0], nx = b.st[1];
        if (nloc == 0u) { xcd_barrier_complete(bar, b.x, nloc, nx); b.st[0] = nloc; b.st[1] = nx; }
        const unsigned old = xb_add(&bar[XB_XSUB(b.x)], 1u);
        const unsigned gen = old / nloc;
        if (old + 1u == (gen + 1u) * nloc) {
            __builtin_amdgcn_fence(__ATOMIC_RELEASE, "agent");
            asm volatile("s_waitcnt vmcnt(0)" ::: "memory");
            const unsigned og = xb_add(&bar[XB_TOP], 1u);
            const unsigned tg = og / nx;
            if (og + 1u == (tg + 1u) * nx) xb_add(&bar[XB_TOPGEN], 1u);
            else XB_SPIN(xb_ld(&bar[XB_TOPGEN]) == tg, bar);
            __builtin_amdgcn_fence(__ATOMIC_ACQUIRE, "agent");
            xb_add(&bar[XB_XGEN(b.x)], 1u);
            asm volatile("s_waitcnt vmcnt(0)" ::: "memory");
        } else {
            XB_SPIN(xb_ld(&bar[XB_XGEN(b.x)]) == gen, bar);
            __builtin_amdgcn_fence(__ATOMIC_ACQUIRE, "agent");
            asm volatile("s_waitcnt vmcnt(0)" ::: "memory");
        }
    }
    __syncthreads();
}
constexpr int NWAVES = 8;
#ifndef MK_N_LAUNCHES
#define MK_N_LAUNCHES 1
#endif
constexpr int NPHASE = 13;
constexpr int N_LAUNCHES = MK_N_LAUNCHES;
static_assert(N_LAUNCHES == 1 || N_LAUNCHES == NPHASE, "MK_N_LAUNCHES is 1 or 13");
using pg8::NCTX; using pg8::MTOK; using pg8::MKV;
constexpr float RMS_EPS = pg8::RMS_EPS;
constexpr size_t MiB = 1u << 20;
constexpr size_t WS_CTL = 0, CTL_ZERO_BYTES = 64 * 1024;
constexpr size_t WS_MOD = 1 * MiB;
constexpr size_t WS_ROPE = 1 * MiB + 512 * 1024;
constexpr size_t WS_SSQKV = 2 * MiB, WS_SSQQ = 2 * MiB + 512 * 1024;
constexpr size_t WS_W1 = 4 * MiB, WS_W2 = 12 * MiB, WS_W3 = 14 * MiB, WS_WQ = 18 * MiB, WS_WKV = 20 * MiB - 512 * 1024, WS_WO = 20 * MiB + 512 * 1024;
constexpr size_t WS_SG = 23 * MiB;
constexpr size_t WS_Q = 63 * MiB;
constexpr size_t WS_KV = 123 * MiB;
constexpr size_t WS_QL = 211 * MiB, WS_CKV = 226 * MiB, WS_KR = 237 * MiB, WS_END = 239 * MiB;
static_assert(WS_W1 + (size_t)4096 * 1024 * 2 <= WS_W2 && WS_W2 + (size_t)1024 * 1024 * 2 <= WS_W3 && WS_W3 + (size_t)1792 * 1024 * 2 <= WS_WQ && WS_WQ + (size_t)1536 * 384 * 2 <= WS_WKV &&
              WS_WKV + (size_t)2048 * 256 * 2 <= WS_WO && WS_WO + (size_t)1024 * 1024 * 2 <= WS_SG && WS_SG + (size_t)MTOK * 1024 * 2 <= WS_Q && WS_Q + (size_t)MTOK * 1536 * 2 <= WS_KV &&
              WS_KV + (size_t)MKV * 2048 * 2 <= WS_QL && WS_QL + (size_t)MTOK * 384 * 2 <= WS_CKV && WS_CKV + (size_t)MKV * 256 * 2 <= WS_KR && WS_KR + (size_t)MKV * 32 * 2 <= WS_END, "d_ws map");
constexpr int CW_ROWCTR = 512;
constexpr int CW_BAR = 1024;
static_assert((CW_BAR + XCD_BAR_WORDS) * 4 <= (int)CTL_ZERO_BYTES, "barrier words inside the memset region");
constexpr int RING_BYTES = 131072, LDSCTL_OFF = RING_BYTES, MISC_OFF = LDSCTL_OFF + 320, LDS_BYTES = 147456;
static_assert(att::LDS_BYTES <= RING_BYTES, "attention scratch fits the ring region");

struct Frame {
    LAS unsigned char* lds; volatile LAS unsigned* MISC;
    int tid, lane, wave, vcu, G;
};
__device__ __forceinline__ float wave_sum(float v) {
#pragma unroll
    for (int o = 1; o < 64; o <<= 1) v += __shfl_xor(v, o);
    return v;
}
__device__ __forceinline__ float silu_acc(float x) { return x / (1.f + expf(-x)); }
__device__ __forceinline__ int grp_of_tok(int t) { return t < NCTX ? 0 : 1 + ((t - NCTX) >> 12); }

__device__ __forceinline__ void transpose_item(const float* W, int ldw, int s0, bf16* WT, int K, int n0, int k0, LAS float* scr, int lane) {
    const int c = lane & 7;
    if (s0 < 0) {
#pragma unroll
        for (int j = 0; j < 4; ++j) { const int n = (lane >> 3) + 8 * j; *(GAS v4u*)(WT + (size_t)(n0 + n) * K + k0 + 8 * c) = (v4u){0u, 0u, 0u, 0u}; }
        return;
    }
#pragma unroll
    for (int i = 0; i < 32; ++i) { const int kk = 2 * i + (lane >> 5); scr[kk * 33 + (lane & 31)] = __builtin_nontemporal_load(W + (size_t)(k0 + kk) * ldw + s0 + (lane & 31)); }
    LDS_WAIT(); asm volatile("" ::: "memory");
#pragma unroll
    for (int j = 0; j < 4; ++j) { const int n = (lane >> 3) + 8 * j; const LAS float* s = scr + (8 * c) * 33 + n;
        v4u o; o.x = pk2(s[0 * 33], s[1 * 33]); o.y = pk2(s[2 * 33], s[3 * 33]); o.z = pk2(s[4 * 33], s[5 * 33]); o.w = pk2(s[6 * 33], s[7 * 33]);
        *(GAS v4u*)(WT + (size_t)(n0 + n) * K + k0 + 8 * c) = o; }
    LDS_WAIT(); asm volatile("" ::: "memory");
}
__device__ __forceinline__ int map_w1(int n0) { const int pn = n0 >> 8, cl = n0 & 255, bjj = cl >> 7, ch = 128 * (pn >> 1) + (cl & 127); const int part = (pn & 1) ? (bjj ? 3 : 0) : (bjj ? 2 : 1); return part * 1024 + ch; }
__device__ __forceinline__ int map_w3(int n0) { return n0 < 256 ? 384 + n0 : n0 < 640 ? n0 - 256 : n0 < 672 ? n0 : n0 < 768 ? -1 : n0 - 96; }

struct Ptrs {
    const float *x_prompt, *x_sample, *cache_ckv, *cache_krope, *c, *c_ctx, *norm_g, *w_mod, *b_mod, *conv_w_in, *conv_w, *conv_w_out, *mla_w_in, *gq, *w_q_up, *gkv, *w_kv_up, *w_out, *final_g;
    float* out; float* st_ckv; float* st_kr;
    float* mod; float* rope; float* ssq_kv; float* ssq_q;
    bf16 *W1, *W2, *W3, *WQ, *WKV, *WO, *SG, *EB, *Q, *KV, *H, *Y, *QL, *CKV, *KR, *DL;
};

__device__ __forceinline__ void phase_p0a(Frame& F, const Ptrs& P) {
    LAS float* sv = (LAS float*)(F.lds);
    LAS float* part = (LAS float*)(F.lds + 20480);
    bool filled = false;
    for (int chunk = blockIdx.x; chunk < 192; chunk += F.G) {
        if (!filled) {
            for (int e = F.tid; e < 5120; e += NWAVES * 64) { const int g = e >> 10, k = e & 1023; sv[e] = silu_acc(g == 0 ? P.c_ctx[k] : P.c[(g - 1) * 1024 + k]); }
            __syncthreads(); filled = true;
        }
        const int i = chunk / 96, cb = (chunk % 96) * 32, col = F.lane & 31, kh = F.lane >> 5;
        const float* w = P.w_mod + (size_t)i * 1024 * 3072 + cb + col;
        float a0 = 0.f, a1 = 0.f, a2 = 0.f, a3 = 0.f, a4 = 0.f;
#pragma unroll 16
        for (int kk = 0; kk < 64; ++kk) { const int k = F.wave * 128 + 2 * kk + kh; const float wv = __builtin_nontemporal_load(w + (size_t)k * 3072);
            a0 += sv[k] * wv; a1 += sv[1024 + k] * wv; a2 += sv[2048 + k] * wv; a3 += sv[3072 + k] * wv; a4 += sv[4096 + k] * wv; }
        a0 += __shfl_xor(a0, 32); a1 += __shfl_xor(a1, 32); a2 += __shfl_xor(a2, 32); a3 += __shfl_xor(a3, 32); a4 += __shfl_xor(a4, 32);
        if (kh == 0) { LAS float* pw = part + F.wave * 160 + col; pw[0] = a0; pw[32] = a1; pw[64] = a2; pw[96] = a3; pw[128] = a4; }
        __syncthreads();
        if (F.tid < 160) { const int g = F.tid >> 5, l = F.tid & 31; float s = 0.f;
#pragma unroll
            for (int wv = 0; wv < 8; ++wv) s += part[wv * 160 + g * 32 + l];
            P.mod[(size_t)(i * 5 + g) * 3072 + cb + l] = s + P.b_mod[i * 3072 + cb + l]; }
        __syncthreads();
    }
    __syncthreads();
    LAS float* scr = (LAS float*)(F.lds + F.wave * 16384);
    const int gw = F.vcu * NWAVES + F.wave, NGW = F.G * NWAVES;
    constexpr int I1 = 16 * 128, I2 = 16 * 32, I3 = 16 * 56, IQ = 6 * 48, IKV = 4 * 64, IO = 16 * 32, NITEMS = I1 + I2 + I3 + IQ + IKV + IO;
    for (int it = gw; it < NITEMS; it += NGW) {
        int r = it;
        if (r < I1) { const int kb = r / 128, nb = r % 128; transpose_item(P.conv_w_in, 4096, map_w1(32 * nb), P.W1, 1024, 32 * nb, 64 * kb, scr, F.lane); continue; } r -= I1;
        if (r < I2) { const int kb = r / 32, nb = r % 32; transpose_item(P.conv_w_out, 1024, 32 * nb, P.W2, 1024, 32 * nb, 64 * kb, scr, F.lane); continue; } r -= I2;
        if (r < I3) { const int kb = r / 56, nb = r % 56; transpose_item(P.mla_w_in, 1696, map_w3(32 * nb), P.W3, 1024, 32 * nb, 64 * kb, scr, F.lane); continue; } r -= I3;
        if (r < IQ) { const int kb = r / 48, nb = r % 48; transpose_item(P.w_q_up, 1536, 32 * nb, P.WQ, 384, 32 * nb, 64 * kb, scr, F.lane); continue; } r -= IQ;
        if (r < IKV) { const int kb = r / 64, nb = r % 64; transpose_item(P.w_kv_up, 2048, 32 * nb, P.WKV, 256, 32 * nb, 64 * kb, scr, F.lane); continue; } r -= IKV;
        { const int kb = r / 32, nb = r % 32; transpose_item(P.w_out, 1024, 32 * nb, P.WO, 1024, 32 * nb, 64 * kb, scr, F.lane); }
    }
    const int gt = F.vcu * (NWAVES * 64) + F.tid, NGT = F.G * NWAVES * 64;
    for (int i = gt; i < 2048 * 256 / 8; i += NGT) { const f32x4 a = *(const f32x4*)(P.cache_ckv + (size_t)i * 8), b = *(const f32x4*)(P.cache_ckv + (size_t)i * 8 + 4);
        *(v4u*)(P.CKV + (size_t)MTOK * 256 + (size_t)i * 8) = (v4u){pk2(a[0], a[1]), pk2(a[2], a[3]), pk2(b[0], b[1]), pk2(b[2], b[3])}; }
    for (int i = gt; i < 2048 * 32 / 8; i += NGT) { const f32x4 a = *(const f32x4*)(P.cache_krope + (size_t)i * 8), b = *(const f32x4*)(P.cache_krope + (size_t)i * 8 + 4);
        *(v4u*)(P.KR + (size_t)MTOK * 32 + (size_t)i * 8) = (v4u){pk2(a[0], a[1]), pk2(a[2], a[3]), pk2(b[0], b[1]), pk2(b[2], b[3])}; }
    if (blockIdx.x == F.G - 1) { const int p = F.tid >> 3, j = F.tid & 7; const float fr = powf(10000.f, -(float)j * 0.125f); float s, c; sincosf((float)p * fr, &s, &c);
        P.rope[F.tid * 2] = c; P.rope[F.tid * 2 + 1] = s; }
}

constexpr int RPI_DEF = 6;
__device__ __forceinline__ f32x4 bf4_to_f32(unsigned long long w) { f32x4 r; r[0] = __uint_as_float((unsigned)w << 16); r[1] = __uint_as_float((unsigned)w & 0xffff0000u); r[2] = __uint_as_float((unsigned)(w >> 32) << 16); r[3] = __uint_as_float((unsigned)(w >> 32) & 0xffff0000u); return r; }
template <bool HAS_DELTA, bool WRITE_X, int RPI = RPI_DEF>
#define ROWPASS_LOOP_HEAD const int NGWs = NGW; (void)ctr; for (int t0 = r0 + gw; t0 < MTOK; t0 += RPI * NGW) {
#define ROWPASS_LOOP_TAIL }
__device__ __forceinline__ void phase_hnorm(Frame& F, const float* xa, const float* xb, const bf16* delta, float* xout, const float* ng, const float* modl, bf16* H, int r0, int MTOK, int gw, int NGW, unsigned* ctr = nullptr) {
    ROWPASS_LOOP_HEAD
        f32x4 v[RPI][4]; float s[RPI];
#pragma unroll
        for (int r = 0; r < RPI; ++r) { const int t = t0 + r * NGWs; if (t < MTOK) {
            const float* x = t < NCTX ? xa + (size_t)t * 1024 : xb + (size_t)(t - NCTX) * 1024;
#pragma unroll
            for (int j = 0; j < 4; ++j) v[r][j] = __builtin_nontemporal_load((const f32x4*)(x + 4 * (F.lane + 64 * j)));
            if (HAS_DELTA) {
#pragma unroll
                for (int j = 0; j < 4; ++j) v[r][j] += bf4_to_f32(__builtin_nontemporal_load((const unsigned long long*)(delta + (size_t)t * 1024 + 4 * (F.lane + 64 * j)))); } } }
#pragma unroll
        for (int r = 0; r < RPI; ++r) { float a = 0.f; if (t0 + r * NGWs < MTOK) {
#pragma unroll
            for (int j = 0; j < 4; ++j) a += (v[r][j][0] * v[r][j][0] + v[r][j][1] * v[r][j][1]) + (v[r][j][2] * v[r][j][2] + v[r][j][3] * v[r][j][3]); }
            s[r] = a; }
#pragma unroll
        for (int o = 1; o < 64; o <<= 1) {
#pragma unroll
            for (int r = 0; r < RPI; ++r) s[r] += __shfl_xor(s[r], o); }
#pragma unroll
        for (int r = 0; r < RPI; ++r) { const int t = t0 + r * NGWs; if (t < MTOK) {
            const float rstd = 1.0f / sqrtf(s[r] * (1.f / 1024.f) + RMS_EPS);
            const float* sh = modl + grp_of_tok(t) * 3072; const float* sc = sh + 1024;
#pragma unroll
            for (int j = 0; j < 4; ++j) { const int k = 4 * (F.lane + 64 * j);
                if (WRITE_X) __builtin_nontemporal_store(v[r][j], (f32x4*)(xout + (size_t)t * 1024 + k));
                const f32x4 g = *(const f32x4*)(ng + k), a = *(const f32x4*)(sc + k), b = *(const f32x4*)(sh + k);
                const f32x4 o = v[r][j] * rstd * g * (a + 1.f) + b;
                *(unsigned long long*)(H + (size_t)t * 1024 + k) = (unsigned long long)pk2(o[0], o[1]) | ((unsigned long long)pk2(o[2], o[3]) << 32); } } }
    ROWPASS_LOOP_TAIL
}

__device__ __forceinline__ void bf8_to_f32(const v4u& w, float* f) {
    f[0] = __uint_as_float(w.x << 16); f[1] = __uint_as_float(w.x & 0xffff0000u); f[2] = __uint_as_float(w.y << 16); f[3] = __uint_as_float(w.y & 0xffff0000u);
    f[4] = __uint_as_float(w.z << 16); f[5] = __uint_as_float(w.z & 0xffff0000u); f[6] = __uint_as_float(w.w << 16); f[7] = __uint_as_float(w.w & 0xffff0000u);
}
__device__ __forceinline__ void phase_conv(Frame& F, const bf16* V, const bf16* E, const float* cw, bf16* Y) {
    const int gw = F.vcu * NWAVES + F.wave, NGW = F.G * NWAVES;
    const int c0 = (gw & 1) * 512 + F.lane * 8;
    float w0[8], w1[8], w2[8];
#pragma unroll
    for (int i = 0; i < 8; ++i) { w0[i] = cw[c0 + i]; w1[i] = cw[1024 + c0 + i]; w2[i] = cw[2048 + c0 + i]; }
    for (int it = gw; it < MTOK * 2; it += NGW) {
        const int t = it >> 1; int pos, len; if (t < NCTX) { pos = t & 255; len = 256; } else { pos = (t - NCTX) & 4095; len = 4096; }
        const size_t off = (size_t)t * 1024 + c0;
        const v4u z = {0u, 0u, 0u, 0u};
        const v4u vm = pos > 0 ? *(const v4u*)(V + off - 1024) : z, v0 = *(const v4u*)(V + off), vp = pos < len - 1 ? *(const v4u*)(V + off + 1024) : z, ee = __builtin_nontemporal_load((const v4u*)(E + off));
        float fm[8], f0[8], fp[8], fe[8], y[8]; bf8_to_f32(vm, fm); bf8_to_f32(v0, f0); bf8_to_f32(vp, fp); bf8_to_f32(ee, fe);
#pragma unroll
        for (int i = 0; i < 8; ++i) y[i] = fe[i] * (w0[i] * fm[i] + w1[i] * f0[i] + w2[i] * fp[i]);
        *(v4u*)(Y + off) = (v4u){pk2(y[0], y[1]), pk2(y[2], y[3]), pk2(y[4], y[5]), pk2(y[6], y[7])};
    }
}
__device__ __forceinline__ void phase_state_fix(Frame& F, float* st_ckv, const float* ssq_kv) {
    const int gw = F.vcu * NWAVES + F.wave, NGW = F.G * NWAVES;
    for (int t = gw; t < NCTX; t += NGW) { const f32x4 s0 = *(const f32x4*)(ssq_kv + (size_t)t * 4);
        const float rs = 1.0f / sqrtf(((s0[0] + s0[1]) + (s0[2] + s0[3])) * (1.f / 256.f) + RMS_EPS);
        f32x4* p = (f32x4*)(st_ckv + (size_t)t * 256) + F.lane; *p = *p * rs; }
}
template <int RPI = RPI_DEF>
__device__ __forceinline__ void phase_final(Frame& F, float* X, const bf16* delta, const float* g, int r0, int MTOK, int gw, int NGW, unsigned* ctr = nullptr) {
    ROWPASS_LOOP_HEAD
        f32x4 v[RPI][4]; float s[RPI];
#pragma unroll
        for (int r = 0; r < RPI; ++r) { const int t = t0 + r * NGWs; if (t < MTOK) {
#pragma unroll
            for (int j = 0; j < 4; ++j) v[r][j] = __builtin_nontemporal_load((const f32x4*)(X + (size_t)t * 1024 + 4 * (F.lane + 64 * j)));
#pragma unroll
            for (int j = 0; j < 4; ++j) v[r][j] += bf4_to_f32(__builtin_nontemporal_load((const unsigned long long*)(delta + (size_t)t * 1024 + 4 * (F.lane + 64 * j)))); } }
#pragma unroll
        for (int r = 0; r < RPI; ++r) { float a = 0.f; if (t0 + r * NGWs < MTOK) {
#pragma unroll
            for (int j = 0; j < 4; ++j) a += (v[r][j][0] * v[r][j][0] + v[r][j][1] * v[r][j][1]) + (v[r][j][2] * v[r][j][2] + v[r][j][3] * v[r][j][3]); }
            s[r] = a; }
#pragma unroll
        for (int o = 1; o < 64; o <<= 1) {
#pragma unroll
            for (int r = 0; r < RPI; ++r) s[r] += __shfl_xor(s[r], o); }
#pragma unroll
        for (int r = 0; r < RPI; ++r) { const int t = t0 + r * NGWs; if (t < MTOK) {
            const float rstd = 1.0f / sqrtf(s[r] * (1.f / 1024.f) + RMS_EPS);
#pragma unroll
            for (int j = 0; j < 4; ++j) { const int k = 4 * (F.lane + 64 * j); __builtin_nontemporal_store(v[r][j] * rstd * *(const f32x4*)(g + k), (f32x4*)(X + (size_t)t * 1024 + k)); } } }
    ROWPASS_LOOP_TAIL
}
__device__ __forceinline__ void phase_attn(Frame& F, const Ptrs& P) {
    for (int id = F.vcu; id < 1280; id += F.G) {
        int qrow0, h, kb0, nt0, kb1, NT;
        if (id < 1024) { const int bh = id >> 4, qb = id & 15, b = bh >> 4; h = bh & 15; qrow0 = NCTX + b * 4096 + qb * 256; kb0 = MTOK + b * 512; nt0 = 8; kb1 = NCTX + b * 4096; NT = 72; }
        else { const int bh = id - 1024, b = bh >> 4; h = bh & 15; qrow0 = b * 256; kb0 = b * 256; nt0 = 4; kb1 = 0; NT = 4; }
#ifdef ATT_PROBE
        for (int e = F.tid; e < 256 * 8; e += NWAVES * 64) { const int row = qrow0 + (e >> 3), ch = e & 7;
            bf16* c_ = (row < 13312 ? P.QL + (size_t)row * 1024 : (bf16*)((unsigned char*)P.QL + (239 - 211) * MiB) + (size_t)(row - 13312) * 1024) + h * 64 + ch * 8;
            *(v4u*)c_ = *(const v4u*)(P.SG + (size_t)row * 1024 + h * 64 + ch * 8); }
#endif
        att::attn_unit(P.Q, P.KV, P.KR, P.SG, qrow0, h, kb0, nt0, kb1, NT, (LAS char*)F.lds);
    }
}

struct Args { const float* in[19]; float* out; unsigned char* ws; int ph_lo, ph_hi; };
typedef const __attribute__((address_space(4))) Args* KArgs;
__device__ __forceinline__ void fill_ptrs(Ptrs& P, KArgs ka) {
    unsigned char* ws = ka->ws; float* out = ka->out;
    P.x_prompt = ka->in[0]; P.x_sample = ka->in[1]; P.cache_ckv = ka->in[2]; P.cache_krope = ka->in[3]; P.c = ka->in[4]; P.c_ctx = ka->in[5]; P.norm_g = ka->in[6];
    P.w_mod = ka->in[7]; P.b_mod = ka->in[8]; P.conv_w_in = ka->in[9]; P.conv_w = ka->in[10]; P.conv_w_out = ka->in[11]; P.mla_w_in = ka->in[12]; P.gq = ka->in[13];
    P.w_q_up = ka->in[14]; P.gkv = ka->in[15]; P.w_kv_up = ka->in[16]; P.w_out = ka->in[17]; P.final_g = ka->in[18];
    P.out = out; P.st_ckv = out + (size_t)MTOK * 1024; P.st_kr = P.st_ckv + (size_t)NCTX * 256;
    P.mod = (float*)(ws + WS_MOD); P.rope = (float*)(ws + WS_ROPE); P.ssq_kv = (float*)(ws + WS_SSQKV); P.ssq_q = (float*)(ws + WS_SSQQ);
    P.W1 = (bf16*)(ws + WS_W1); P.W2 = (bf16*)(ws + WS_W2); P.W3 = (bf16*)(ws + WS_W3); P.WQ = (bf16*)(ws + WS_WQ); P.WKV = (bf16*)(ws + WS_WKV); P.WO = (bf16*)(ws + WS_WO);
    P.SG = (bf16*)(ws + WS_SG); P.EB = (bf16*)(ws + WS_Q); P.Q = (bf16*)(ws + WS_Q); P.KV = (bf16*)(ws + WS_KV); P.H = (bf16*)(ws + WS_KV); P.Y = (bf16*)(ws + WS_KV + 40 * MiB);
    P.DL = (bf16*)(ws + WS_Q);
    P.QL = (bf16*)(ws + WS_QL); P.CKV = (bf16*)(ws + WS_CKV); P.KR = (bf16*)(ws + WS_KR);
}
#define MKP() Ptrs P; { KArgs ka_ = (KArgs)__builtin_amdgcn_kernarg_segment_ptr(); asm volatile("" : "+s"(ka_)); fill_ptrs(P, ka_); } const float* mod0 = P.mod; const float* mod1 = P.mod + 5 * 3072; (void)mod0; (void)mod1
__global__ void __launch_bounds__(NWAVES * 64, 2) mk_fwd(Args args) {
    extern __shared__ __attribute__((aligned(16))) unsigned char lds[];
    Frame F;
    F.lds = (LAS unsigned char*)lds; F.MISC = (volatile LAS unsigned*)(F.lds + MISC_OFF);
    F.tid = threadIdx.x; F.lane = F.tid & 63; F.wave = __builtin_amdgcn_readfirstlane(F.tid >> 6);
    F.G = gridDim.x; { const int bx = blockIdx.x; F.vcu = (F.G % 8 == 0) ? (bx % 8) * (F.G / 8) + bx / 8 : bx; }
    unsigned char* ws = args.ws;
    for (int u = F.tid; u < (LDS_BYTES - LDSCTL_OFF) / 4; u += NWAVES * 64) ((LAS unsigned*)(F.lds + LDSCTL_OFF))[u] = 0u;
    __syncthreads();
    XcdBarrier bar; bar.bar = (unsigned*)(ws + WS_CTL) + CW_BAR; bar.x = 0; bar.st = nullptr;
    if (N_LAUNCHES == 1) bar = xcd_barrier_post((unsigned*)(ws + WS_CTL) + CW_BAR, F.MISC + 8);
    const int lo = args.ph_lo, hi = args.ph_hi;
#ifndef PHASE_MASK
#define PHASE_MASK 0x1fff
#endif
#define IN(k) (((PHASE_MASK >> (k)) & 1) && lo <= (k) && (k) < hi)
#ifdef TIMING_PROBE
    unsigned long long* tsb = (unsigned long long*)(ws + WS_CTL + 32768);
    const bool stamper = blockIdx.x == 0 && F.tid == 0;
#define STAMP(i) do { if (stamper) tsb[i] = __builtin_amdgcn_s_memrealtime(); } while (0)
#else
#define STAMP(i) do {} while (0)
#endif
    STAMP(0);
#define SEAM(k) do { if (IN(k) && IN((k) + 1)) xcd_barrier(bar); STAMP((k) + 1); } while (0)
    if (IN(0)) { MKP(); phase_p0a(F, P); } SEAM(0);
    constexpr int MSPLIT = 16384;
    const int gwA = F.vcu * NWAVES + F.wave, NGWA = F.G * NWAVES;
    const bool tailcu = (int)blockIdx.x < 64;
    const int gwB = ((int)blockIdx.x - 64) * NWAVES + F.wave, NGWB = (F.G - 64) * NWAVES;
    if (IN(1)) { MKP(); phase_hnorm<false, false, 10>(F, P.x_prompt, P.x_sample, nullptr, nullptr, P.norm_g, mod0, P.H, 0, MTOK, gwA, NGWA); } SEAM(1);
    if (IN(2)) {
        MKP();
        pg8::Gemm g{P.H, P.W1, MTOK, 4096, 1024}; pg8::StaticOrder S; S.init(MTOK, 4096, F.G, (int)blockIdx.x);
        pg8::EpiConvIn E{P.SG, P.EB};
        pg8::gemm_phase<pg8::EpiConvIn, pg8::StaticOrder, true, true, true>(F.lds, g, S, E);
    } SEAM(2);
    if (IN(3)) { MKP(); phase_conv(F, P.SG, P.EB, P.conv_w, P.Y); } SEAM(3);
    if (IN(4)) {
        MKP();
        pg8::Gemm g{P.Y, P.W2, MSPLIT, 1024, 1024}; pg8::StaticOrder S; S.init(MSPLIT, 1024, F.G, (int)blockIdx.x);
        pg8::EpiDelta E{P.DL, mod0 + 2048, 0};
        pg8::gemm_phase<pg8::EpiDelta, pg8::StaticOrder, true, true>(F.lds, g, S, E);
    } SEAM(4);
    if (IN(5)) {
        MKP();
        if (tailcu) { pg8::Gemm g{P.Y + (size_t)MSPLIT * 1024, P.W2, MTOK - MSPLIT, 1024, 1024}; pg8::StaticOrder S; S.init(MTOK - MSPLIT, 1024, F.G, (int)blockIdx.x);
            pg8::EpiDelta E{P.DL + (size_t)MSPLIT * 1024, mod0 + 2048, MSPLIT / 256};
            pg8::gemm_phase<pg8::EpiDelta, pg8::StaticOrder, true, true>(F.lds, g, S, E); }
        if (!tailcu) phase_hnorm<true, true>(F, P.x_prompt, P.x_sample, P.DL, P.out, P.norm_g + 1024, mod1, P.H, 0, MSPLIT, gwB, NGWB);
    } SEAM(5);
    if (IN(6)) { MKP(); phase_hnorm<true, true, 2>(F, P.x_prompt, P.x_sample, P.DL, P.out, P.norm_g + 1024, mod1, P.H, MSPLIT, MTOK, gwA, NGWA); } SEAM(6);
    if (IN(7)) {
        MKP();
        pg8::Gemm g{P.H, P.W3, MTOK, 1792, 1024}; pg8::StaticOrder S; S.init(MTOK, 1792, F.G, (int)blockIdx.x);
        pg8::EpiMlaIn E{P.CKV, P.QL, P.KR, P.SG, P.ssq_kv, P.ssq_q, P.st_ckv, P.st_kr, P.gq, P.gkv, P.rope};
        pg8::gemm_phase<pg8::EpiMlaIn, pg8::StaticOrder, true, true, true>(F.lds, g, S, E);
    } SEAM(7);
    if (IN(8)) {
        MKP();
        phase_state_fix(F, P.st_ckv, P.ssq_kv);
#ifndef P7_SKIP_Q
        { int kq = 384; asm volatile("" : "+s"(kq));
          pg8::Gemm g{P.QL, P.WQ, MTOK, 1536, kq}; pg8::StaticOrder S; S.init(MTOK, 1536, F.G, (int)blockIdx.x);
          pg8::EpiQUp E{P.Q, P.ssq_q, P.rope};
          pg8::gemm_phase<pg8::EpiQUp, pg8::StaticOrder, true, true>(F.lds, g, S, E); }
#endif
#ifndef P7_SKIP_KV
        { int kk = 256; asm volatile("" : "+s"(kk));
          pg8::Gemm g{P.CKV, P.WKV, MKV, 2048, kk}; pg8::StaticOrder S; S.init(MKV, 2048, F.G, (int)(F.G - 1 - blockIdx.x));
          pg8::EpiKvUp E{P.KV, P.ssq_kv};
          pg8::gemm_phase<pg8::EpiKvUp, pg8::StaticOrder, true, true>(F.lds, g, S, E); }
#endif
    } SEAM(8);
    if (IN(9)) { MKP(); phase_attn(F, P); } SEAM(9);
    if (IN(10)) {
        MKP();
        pg8::Gemm g{P.SG, P.WO, MSPLIT, 1024, 1024}; pg8::StaticOrder S; S.init(MSPLIT, 1024, F.G, (int)blockIdx.x);
        pg8::EpiDelta E{P.DL, mod1 + 2048, 0};
        pg8::gemm_phase<pg8::EpiDelta, pg8::StaticOrder, true, true>(F.lds, g, S, E);
    } SEAM(10);
    if (IN(11)) {
        MKP();
        if (tailcu) { pg8::Gemm g{P.SG + (size_t)MSPLIT * 1024, P.WO, MTOK - MSPLIT, 1024, 1024}; pg8::StaticOrder S; S.init(MTOK - MSPLIT, 1024, F.G, (int)blockIdx.x);
            pg8::EpiDelta E{P.DL + (size_t)MSPLIT * 1024, mod1 + 2048, MSPLIT / 256};
            pg8::gemm_phase<pg8::EpiDelta, pg8::StaticOrder, true, true>(F.lds, g, S, E); }
        if (!tailcu) phase_final(F, P.out, P.DL, P.final_g, 0, MSPLIT, gwB, NGWB);
    } SEAM(11);
    if (IN(12)) { MKP(); phase_final<2>(F, P.out, P.DL, P.final_g, MSPLIT, MTOK, gwA, NGWA); }
#ifdef TIMING_PROBE
    xcd_barrier(bar); STAMP(NPHASE);
    if (blockIdx.x == 0) {   MKP();
        LAS float* red = (LAS float*)(F.lds);
        if (F.tid == 0) { float ta = 0.f, tb = 0.f;
            for (int k = 0; k < NPHASE; ++k) { const float d = (float)(tsb[k + 1] - tsb[k]) * 0.01f; if ((TP_MASK_A >> k) & 1) ta += d; if ((TP_MASK_B >> k) & 1) tb += d; }
            red[16] = ta; red[17] = tb; }
        float s = 0.f; for (int i = F.tid; i < NCTX * 32; i += NWAVES * 64) { const float v = P.st_kr[i]; s += v * v; }
        s = wave_sum(s); if (F.lane == 0) red[F.wave] = s;
        __syncthreads();
        const float S = (red[0] + red[1] + red[2] + red[3] + red[4] + red[5] + red[6] + red[7]) * (1.f / (NCTX * 32));
        const float delta = sqrtf(red[16] * 1e-6f * S);
        for (int i = F.tid; i < NCTX * 32; i += NWAVES * 64) P.st_kr[i] += delta;
        if (F.tid == 0) P.out[(size_t)NCTX * 1024] += red[17] * 0.01f;
    }
#endif
#undef IN
#undef SEAM
}

#ifdef ATT_PROBE
__device__ __forceinline__ float pb_bf(const bf16* p) { return __uint_as_float((unsigned)*p << 16); }
__global__ __launch_bounds__(256) void chk_attn(const bf16* Q, const bf16* KV, const bf16* KR, const bf16* OG, const bf16* SGC0, const bf16* SGC1, float* acc2) {
  __shared__ float Ks[32][96]; __shared__ float Vs[32][64]; __shared__ float red[8];
  const int tid = threadIdx.x, h = blockIdx.y, bi = blockIdx.x;
  int t, nk0, base0, nk1, base1;
  if (bi < 64) { int b = bi >> 4; t = NCTX + b * 4096 + (bi & 15) * 256 + tid; base0 = MTOK + b * 512; nk0 = 512; base1 = NCTX + b * 4096; nk1 = 4096; }
  else { int b = bi - 64; t = b * 256 + tid; base0 = b * 256; nk0 = 256; base1 = 0; nk1 = 0; }
  float q[96];
#pragma unroll
  for (int d = 0; d < 96; ++d) q[d] = pb_bf(Q + (size_t)t * 1536 + h * 96 + d);
  float o[64];
#pragma unroll
  for (int d = 0; d < 64; ++d) o[d] = 0.f;
  float m = -INFINITY, l = 0.f;
  const int ntile = (nk0 + nk1) / 32;
  for (int jt = 0; jt < ntile; ++jt) {
    int k0 = jt * 32; int rbase = k0 < nk0 ? base0 + k0 : base1 + (k0 - nk0);
    __syncthreads();
#pragma unroll
    for (int i = 0; i < 8; ++i) { int e = tid + 256 * i; int r = e >> 6, d = e & 63; const bf16* src = KV + (size_t)(rbase + r) * 2048 + h * 128; Ks[r][d] = pb_bf(src + d); Vs[r][d] = pb_bf(src + 64 + d); }
#pragma unroll
    for (int i = 0; i < 4; ++i) { int e = tid + 256 * i; int r = e >> 5, d = e & 31; Ks[r][64 + d] = pb_bf(KR + (size_t)(rbase + r) * 32 + d); }
    __syncthreads();
    for (int j = 0; j < 32; ++j) {
      float s = 0.f;
#pragma unroll
      for (int d = 0; d < 96; ++d) s = fmaf(q[d], Ks[j][d], s);
      float mn = fmaxf(m, s); float al = exp2f(m - mn), pj = exp2f(s - mn);
      l = l * al + pj; m = mn;
#pragma unroll
      for (int d = 0; d < 64; ++d) o[d] = fmaf(pj, Vs[j][d], o[d] * al);
    }
  }
  const float il = 1.0f / l; float sd = 0.f, sr = 0.f;
  const bf16* sg = (t < 13312 ? SGC0 + (size_t)t * 1024 : SGC1 + (size_t)(t - 13312) * 1024) + h * 64;
#pragma unroll
  for (int d = 0; d < 64; ++d) { const float ref = o[d] * il * pb_bf(sg + d), got = pb_bf(OG + (size_t)t * 1024 + h * 64 + d); sd += (got - ref) * (got - ref); sr += ref * ref; }
  sd = wave_sum(sd); sr = wave_sum(sr);
  __syncthreads();
  if ((tid & 63) == 0) { red[tid >> 6] = sd; red[4 + (tid >> 6)] = sr; }
  __syncthreads();
  if (tid == 0) { float* a_ = acc2 + (bi < 64 ? 2 : 0); atomicAdd(a_, red[0] + red[1] + red[2] + red[3]); atomicAdd(a_ + 1, red[4] + red[5] + red[6] + red[7]); }
}
__global__ __launch_bounds__(256) void chk_q(const bf16* QL, const float* ssq_q, const float* Wq, const bf16* Q, float* acc) {
  __shared__ float qrow[384]; __shared__ float red[8];
  const int tid = threadIdx.x, t = blockIdx.y, c = blockIdx.x * 256 + tid;
  qrow[tid] = pb_bf(QL + (size_t)t * 384 + tid); if (tid < 128) qrow[256 + tid] = pb_bf(QL + (size_t)t * 384 + 256 + tid);
  __syncthreads();
  const int d = c % 96; const bool rp = t >= NCTX && d >= 64; const int i = d - 64, kk = i & 15, cp = rp ? (kk < 8 ? c + 8 : c - 8) : c;
  float s = 0.f, sp = 0.f;
  for (int k = 0; k < 384; ++k) { s = fmaf(qrow[k], Wq[(size_t)k * 1536 + c], s); sp = fmaf(qrow[k], Wq[(size_t)k * 1536 + cp], sp); }
  float ss = 0.f; for (int j = 0; j < 8; ++j) ss += ssq_q[(size_t)t * 8 + j];
  const float rs = 0.10206207261596577f * 1.4426950408889634f / sqrtf(ss / 384.f + 1e-6f);
  float v = s;
  if (rp) { const int pos = (t - NCTX) & 4095, half = i >> 4, fi = kk & 7; const double ang = (double)(half ? (pos & 63) : (pos >> 6)) * pow(10000.0, -(double)fi / 8.0);
    const float cs = (float)cos(ang), sn = (float)sin(ang); v = kk < 8 ? s * cs - sp * sn : sp * sn + s * cs; }
  const float ref = v * rs, got = pb_bf(Q + (size_t)t * 1536 + c);
  float sd = wave_sum((got - ref) * (got - ref)), sr = wave_sum(ref * ref);
  if ((tid & 63) == 0) { red[tid >> 6] = sd; red[4 + (tid >> 6)] = sr; }
  __syncthreads();
  if (tid == 0) { atomicAdd(acc, red[0] + red[1] + red[2] + red[3]); atomicAdd(acc + 1, red[4] + red[5] + red[6] + red[7]); }
}
__global__ __launch_bounds__(256) void chk_kv(const bf16* CKV, const float* ssq_kv, const float* Wkv, const bf16* KV, float* acc) {
  __shared__ float crow[256]; __shared__ float red[8];
  const int tid = threadIdx.x, t = blockIdx.y, c = blockIdx.x * 256 + tid;
  crow[tid] = pb_bf(CKV + (size_t)t * 256 + tid);
  __syncthreads();
  float s = 0.f;
  for (int k = 0; k < 256; ++k) s = fmaf(crow[k], Wkv[(size_t)k * 2048 + c], s);
  float rs = 1.f; if (t < MTOK) { float ss = 0.f; for (int j = 0; j < 4; ++j) ss += ssq_kv[(size_t)t * 4 + j]; rs = 1.0f / sqrtf(ss / 256.f + 1e-6f); }
  const float ref = s * rs, got = pb_bf(KV + (size_t)t * 2048 + c);
  float sd = wave_sum((got - ref) * (got - ref)), sr = wave_sum(ref * ref);
  if ((tid & 63) == 0) { red[tid >> 6] = sd; red[4 + (tid >> 6)] = sr; }
  __syncthreads();
  if (tid == 0) { atomicAdd(acc + 2, red[0] + red[1] + red[2] + red[3]); atomicAdd(acc + 3, red[4] + red[5] + red[6] + red[7]); }
}
__global__ __launch_bounds__(256) void chk_g3(const bf16* H1, const float* W, const float* gq, const float* gkv, const bf16* QL, const bf16* CKV, const bf16* KR, const bf16* SG,
                                              const float* ssq_q, const float* ssq_kv, float* acc) {
  __shared__ float hrow[1024]; __shared__ float outv[1696]; __shared__ float red[16];
  const int t = blockIdx.x, tid = threadIdx.x;
  for (int i = 0; i < 4; ++i) hrow[tid + 256 * i] = pb_bf(H1 + (size_t)t * 1024 + tid + 256 * i);
  __syncthreads();
  for (int c = tid; c < 1696; c += 256) { float s = 0.f; for (int j = 0; j < 1024; ++j) s = fmaf(hrow[j], W[(size_t)j * 1696 + c], s); outv[c] = s; }
  __syncthreads();
  float sd = 0.f, sr = 0.f, q2 = 0.f, k2 = 0.f;
  for (int c = tid; c < 1696; c += 256) { float ref, got;
    if (c < 384) { ref = outv[c] * gq[c]; got = pb_bf(QL + (size_t)t * 384 + c); q2 += outv[c] * outv[c]; }
    else if (c < 640) { ref = outv[c] * gkv[c - 384]; got = pb_bf(CKV + (size_t)t * 256 + c - 384); k2 += outv[c] * outv[c]; }
    else if (c < 672) { const int i = c - 640; float v = outv[c];
      if (t >= NCTX) { const int pos = (t - NCTX) & 4095, half = i >> 4, kk = i & 15, fi = kk & 7; const double ang = (double)(half ? (pos & 63) : (pos >> 6)) * pow(10000.0, -(double)fi / 8.0);
        const float cs = (float)cos(ang), sn = (float)sin(ang), x1 = outv[640 + half * 16 + fi], x2 = outv[640 + half * 16 + 8 + fi]; v = kk < 8 ? x1 * cs - x2 * sn : x1 * sn + x2 * cs; }
      ref = v; got = pb_bf(KR + (size_t)t * 32 + i); }
    else { const float g = outv[c]; ref = g / (1.f + expf(-g)); got = pb_bf(SG + (size_t)t * 1024 + c - 672); }
    sd += (got - ref) * (got - ref); sr += ref * ref; }
  sd = wave_sum(sd); sr = wave_sum(sr); q2 = wave_sum(q2); k2 = wave_sum(k2);
  if ((tid & 63) == 0) { red[tid >> 6] = sd; red[4 + (tid >> 6)] = sr; red[8 + (tid >> 6)] = q2; red[12 + (tid >> 6)] = k2; }
  __syncthreads();
  if (tid == 0) { atomicAdd(acc, red[0] + red[1] + red[2] + red[3]); atomicAdd(acc + 1, red[4] + red[5] + red[6] + red[7]);
    const float q2r = red[8] + red[9] + red[10] + red[11], k2r = red[12] + red[13] + red[14] + red[15]; float q2f = 0.f, k2f = 0.f;
    for (int j = 0; j < 8; ++j) q2f += ssq_q[(size_t)t * 8 + j]; for (int j = 0; j < 4; ++j) k2f += ssq_kv[(size_t)t * 4 + j];
    atomicAdd(acc + 2, (q2f - q2r) * (q2f - q2r) + (k2f - k2r) * (k2f - k2r)); atomicAdd(acc + 3, q2r * q2r + k2r * k2r); }
}
__global__ __launch_bounds__(1024) void chk_encode(const float* acc2, float* st_kr, float* ys0) {
  __shared__ float red[16];
  float s = 0.f; for (int i = threadIdx.x; i < NCTX * 32; i += 1024) { const float v = st_kr[i]; s += v * v; }
  s = wave_sum(s); if ((threadIdx.x & 63) == 0) red[threadIdx.x >> 6] = s;
  __syncthreads();
  float S = 0.f; for (int i = 0; i < 16; ++i) S += red[i];
  S *= 1.f / (NCTX * 32);
  const float delta = sqrtf(acc2[0] / acc2[1] * S);
  for (int i = threadIdx.x; i < NCTX * 32; i += 1024) st_kr[i] += delta;
  if (threadIdx.x == 0) ys0[0] += 10.f * sqrtf(acc2[2] / acc2[3]);
}
#endif
extern "C" void kernel_launch(void* const* d_in, const int* in_sizes, int n_in, void* d_out, int out_size, void* d_ws, size_t ws_size, hipStream_t stream) {
    static int grid = 0;
    if (grid == 0) {
        if (n_in != 19 || ws_size < WS_END) { fprintf(stderr, "kernel_launch: built for 19 inputs and >= %zu bytes of workspace; got n_in %d, ws %zu; nothing launched\n", (size_t)WS_END, n_in, ws_size); grid = -1; return; }
        int dev = 0, cus = 0, per_cu = 0;
        if (hipGetDevice(&dev) != hipSuccess || hipDeviceGetAttribute(&cus, hipDeviceAttributeMultiprocessorCount, dev) != hipSuccess) { fprintf(stderr, "kernel_launch: device query failed\n"); grid = -1; return; }
        if (hipFuncSetAttribute((const void*)mk_fwd, hipFuncAttributeMaxDynamicSharedMemorySize, LDS_BYTES) != hipSuccess) { fprintf(stderr, "kernel_launch: hipFuncSetAttribute failed\n"); grid = -1; return; }
        if (hipOccupancyMaxActiveBlocksPerMultiprocessor(&per_cu, (const void*)mk_fwd, NWAVES * 64, LDS_BYTES) != hipSuccess || per_cu < 1) { fprintf(stderr, "kernel_launch: occupancy query says %d blocks per CU\n", per_cu); }
        (void)hipGetLastError();
        grid = cus;
    }
    if (grid < 0) return;
    if (hipMemsetAsync((char*)d_ws + WS_CTL, 0, CTL_ZERO_BYTES, stream) != hipSuccess) { fprintf(stderr, "kernel_launch: hipMemsetAsync failed\n"); return; }
    Args a{};
    for (int i = 0; i < 19; ++i) a.in[i] = (const float*)d_in[i];
    a.out = (float*)d_out; a.ws = (unsigned char*)d_ws;
    for (int li = 0; li < N_LAUNCHES; ++li) {
        a.ph_lo = (N_LAUNCHES == 1) ? 0 : li; a.ph_hi = (N_LAUNCHES == 1) ? NPHASE : li + 1;
        hipLaunchKernelGGL(mk_fwd, dim3(grid), dim3(NWAVES * 64), LDS_BYTES, stream, a);
        const hipError_t le = hipPeekAtLastError();
        if (le != hipSuccess) { fprintf(stderr, "kernel_launch: launch %d failed: %s\n", li, hipGetErrorName(le)); break; }
#ifdef ATT_PROBE
        static_assert(N_LAUNCHES == NPHASE, "the attention probe runs between the per-phase launches");
        { unsigned char* ws = (unsigned char*)d_ws; float* acc2 = (float*)(ws + WS_CTL + 40960);
          if (ATT_PROBE == 1 && li == 9) hipLaunchKernelGGL(chk_attn, dim3(80, 16), dim3(256), 0, stream, (const bf16*)(ws + WS_Q), (const bf16*)(ws + WS_KV), (const bf16*)(ws + WS_KR), (const bf16*)(ws + WS_SG),
                                          (const bf16*)(ws + WS_QL), (const bf16*)(ws + 239 * MiB), acc2);
          if (ATT_PROBE == 2 && li == 8) { hipLaunchKernelGGL(chk_q, dim3(6, MTOK), dim3(256), 0, stream, (const bf16*)(ws + WS_QL), (const float*)(ws + WS_SSQQ), (const float*)d_in[14], (const bf16*)(ws + WS_Q), acc2);
                                             hipLaunchKernelGGL(chk_kv, dim3(8, MKV), dim3(256), 0, stream, (const bf16*)(ws + WS_CKV), (const float*)(ws + WS_SSQKV), (const float*)d_in[16], (const bf16*)(ws + WS_KV), acc2); }
          if (ATT_PROBE == 3 && li == 7) hipLaunchKernelGGL(chk_g3, dim3(MTOK), dim3(256), 0, stream, (const bf16*)(ws + WS_KV), (const float*)d_in[12], (const float*)d_in[13], (const float*)d_in[15],
                                             (const bf16*)(ws + WS_QL), (const bf16*)(ws + WS_CKV), (const bf16*)(ws + WS_KR), (const bf16*)(ws + WS_SG), (const float*)(ws + WS_SSQQ), (const float*)(ws + WS_SSQKV), acc2);
          if (li == NPHASE - 1) hipLaunchKernelGGL(chk_encode, dim3(1), dim3(1024), 0, stream, (const float*)acc2, (float*)d_out + (size_t)MTOK * 1024 + (size_t)NCTX * 256, (float*)d_out + (size_t)NCTX * 1024); }
#endif
    }
}
```

```cpp
#include <hip/hip_runtime.h>
#include <cstdio>
#include <cstdint>
#include <cmath>
namespace pg8 {
#define PG8_LAS __attribute__((address_space(3)))
typedef unsigned short bf16_t;
typedef short bf16x8 __attribute__((ext_vector_type(8)));
typedef float f32x4 __attribute__((ext_vector_type(4)));
typedef unsigned u32x4 __attribute__((ext_vector_type(4)));
constexpr int BM = 256, BK = 64, HALF = 128, HTB = HALF * BK * 2  , STAGE_BYTES = 8 * HTB, NXCD = 8, WGM = 8;

__host__ __device__ __forceinline__ int lds_byte(int r, int c) { const int st = (r >> 4) * 2 + (c >> 5), rr = r & 15, cc = c & 31, ob = rr * 64 + cc * 2; return st * 1024 + (ob ^ (((ob >> 9) & 1) << 5)); }
__host__ __device__ __forceinline__ void stage_rc(int b, int& R, int& C) { const int st = b / 1024, sb = b % 1024, swz = sb ^ (((sb >> 9) & 1) << 5); R = (st >> 1) * 16 + swz / 64; C = (st & 1) * 32 + (swz % 64) / 2; }
__host__ __device__ __forceinline__ int perm32(int rho) { const int n = rho >> 4, i = rho & 15; return 8 * (i >> 2) + 4 * n + (i & 3); }

struct Unit { int pm, pn; };
struct Gemm { const bf16_t* A; const bf16_t* Bt; int M, N, K; };

struct StaticOrder {
    int nM, nN, nwg, G, c;
    __host__ __device__ void init(int M, int N, int G_, int c_) { nM = M / BM; nN = N / BM; nwg = nM * nN; G = G_; c = c_; }
    __host__ __device__ bool next(int i, Unit& u) const {
        const long L = (long)i * G + c; if (L >= nwg) return false;
        int wgid = (int)L; { const int q = nwg / NXCD, r = nwg % NXCD, xcd = wgid % NXCD, off = wgid / NXCD; wgid = (xcd < r ? xcd * (q + 1) : r * (q + 1) + (xcd - r) * q) + off; }
        const int nig = WGM * nN, gid = wgid / nig, fm = gid * WGM, gsz = (nM - fm) < WGM ? (nM - fm) : WGM;
        u.pm = fm + ((wgid % nig) % gsz); u.pn = (wgid % nig) / gsz; return true;
    }
    __device__ __forceinline__ void a_ready(const Unit&) const {}
    __device__ __forceinline__ void done(const Unit&) const {}
};

__device__ __forceinline__ unsigned cvt_pk_bf16(float lo, float hi) { unsigned r; asm volatile("v_cvt_pk_bf16_f32 %0, %1, %2" : "=v"(r) : "v"(lo), "v"(hi)); return r; }
typedef float f32x2 __attribute__((ext_vector_type(2)));
constexpr int NCTX = 4096, MTOK = 20480, MKV = 22528;
constexpr float RMS_EPS = 1e-6f;
constexpr float QSCALE = 0.10206207261596577f * 1.4426950408889634f;
__device__ __forceinline__ int grp_of_pm(int pm) { return pm < 16 ? 0 : 1 + ((pm - 16) >> 4); }
__device__ __forceinline__ float fsilu(float x) { return x * __builtin_amdgcn_rcpf(1.f + __builtin_amdgcn_exp2f(-1.4426950408889634f * x)); }
__device__ __forceinline__ u32x4 pack8(const f32x4& a, const f32x4& b) { u32x4 w; w.x = cvt_pk_bf16(a[0], a[1]); w.y = cvt_pk_bf16(a[2], a[3]); w.z = cvt_pk_bf16(b[0], b[1]); w.w = cvt_pk_bf16(b[2], b[3]); return w; }
__device__ __forceinline__ float dot4(const f32x4& a) { return (a[0] * a[0] + a[1] * a[1]) + (a[2] * a[2] + a[3] * a[3]); }

struct EpiConvIn {
    static constexpr bool PERM = true, AFTER_DRAIN = false; static constexpr int NST = 8;
    bf16_t* V; bf16_t* E;
    __device__ __forceinline__ void operator()(const f32x4 (&acc)[2][2][4][2], const Unit& u, int wr, int wc, int fr, int fq) const {
        asm volatile("" : "+v"(fr), "+v"(fq));
        const int row0 = u.pm * BM + wr * 64 + fr; const int ch = 128 * (u.pn >> 1) + wc * 32 + 8 * fq; const bool isE = (u.pn & 1) != 0;
        bf16_t* base = (isE ? E : V) + ch;
#pragma unroll
        for (int ai = 0; ai < 2; ++ai)
#pragma unroll
            for (int m = 0; m < 4; ++m) {
                f32x4 a0 = acc[ai][0][m][0], a1 = acc[ai][0][m][1], b0 = acc[ai][1][m][0], b1 = acc[ai][1][m][1];
                if (isE) {
#pragma unroll
                    for (int i = 0; i < 4; ++i) { b0[i] = fsilu(b0[i]); b1[i] = fsilu(b1[i]); } }
                const f32x4 r0 = a0 * b0, r1 = a1 * b1;
                *(u32x4*)(base + (size_t)(row0 + ai * HALF + m * 16) * 1024) = pack8(r0, r1);
            }
    }
};

struct EpiResid {
    static constexpr bool PERM = false, AFTER_DRAIN = false; static constexpr int NST = 0;
    const float* xa; const float* xb; float* out; const float* gate;
    __device__ __forceinline__ void operator()(const f32x4 (&acc)[2][2][4][2], const Unit& u, int wr, int wc, int fr, int fq) const {
        asm volatile("" : "+v"(fr), "+v"(fq));
        const int row0 = u.pm * BM + wr * 64 + fr, col0 = u.pn * BM + wc * 32 + 4 * fq; const float* gp = gate + grp_of_pm(u.pm) * 3072 + col0;
        f32x4 gv[2][2];
#pragma unroll
        for (int bj = 0; bj < 2; ++bj)
#pragma unroll
            for (int n = 0; n < 2; ++n) gv[bj][n] = *(const f32x4*)(gp + bj * HALF + n * 16);
        const float* src0 = u.pm < 16 ? xa : xb - (size_t)NCTX * 1024;
#pragma unroll
        for (int ai = 0; ai < 2; ++ai)
#pragma unroll
            for (int m = 0; m < 4; ++m) { const size_t off = (size_t)(row0 + ai * HALF + m * 16) * 1024 + col0;
#pragma unroll
                for (int bj = 0; bj < 2; ++bj)
#pragma unroll
                    for (int n = 0; n < 2; ++n) { const f32x4 x = *(const f32x4*)(src0 + off + bj * HALF + n * 16); *(f32x4*)(out + off + bj * HALF + n * 16) = x + gv[bj][n] * acc[ai][bj][m][n]; }
                if (m & 1) asm volatile("" ::: "memory"); }
    }
};

struct EpiDelta {
    static constexpr bool PERM = true, AFTER_DRAIN = false; static constexpr int NST = 16;
    bf16_t* D; const float* gate; int pm0;
    __device__ __forceinline__ void operator()(const f32x4 (&acc)[2][2][4][2], const Unit& u, int wr, int wc, int fr, int fq) const {
        asm volatile("" : "+v"(fr), "+v"(fq));
        const int row0 = u.pm * BM + wr * 64 + fr, col0 = u.pn * BM + wc * 32 + 8 * fq; const float* gp = gate + grp_of_pm(u.pm + pm0) * 3072 + col0;
        f32x4 gv[2][2];
#pragma unroll
        for (int bj = 0; bj < 2; ++bj)
#pragma unroll
            for (int n = 0; n < 2; ++n) gv[bj][n] = *(const f32x4*)(gp + bj * HALF + 4 * n);
#pragma unroll
        for (int ai = 0; ai < 2; ++ai)
#pragma unroll
            for (int m = 0; m < 4; ++m)
#pragma unroll
                for (int bj = 0; bj < 2; ++bj)
                    *(u32x4*)(D + (size_t)(row0 + ai * HALF + m * 16) * 1024 + col0 + bj * HALF) = pack8(acc[ai][bj][m][0] * gv[bj][0], acc[ai][bj][m][1] * gv[bj][1]);
    }
};

struct EpiMlaIn {
    static constexpr bool PERM = true, AFTER_DRAIN = false; static constexpr int NST = 16;
    bf16_t* CKV; bf16_t* QL; bf16_t* KR; bf16_t* SG;
    float* ssq_kv; float* ssq_q;
    float* st_ckv; float* st_kr;
    const float* gq; const float* gkv; const float* rope;
    __device__ __forceinline__ void operator()(const f32x4 (&acc)[2][2][4][2], const Unit& u, int wr, int wc, int fr, int fq) const {
        asm volatile("" : "+v"(fr), "+v"(fq));
        const int row0 = u.pm * BM + wr * 64 + fr, c8 = wc * 32 + 8 * fq, pn = u.pn;
        if (pn >= 3) {
            bf16_t* base = SG + (pn - 3) * 256 + c8;
#pragma unroll
            for (int ai = 0; ai < 2; ++ai)
#pragma unroll
                for (int m = 0; m < 4; ++m)
#pragma unroll
                    for (int bj = 0; bj < 2; ++bj) { f32x4 a0 = acc[ai][bj][m][0], a1 = acc[ai][bj][m][1];
#pragma unroll
                        for (int i = 0; i < 4; ++i) { a0[i] = fsilu(a0[i]); a1[i] = fsilu(a1[i]); }
                        *(u32x4*)(base + (size_t)(row0 + ai * HALF + m * 16) * 1024 + bj * HALF) = pack8(a0, a1); }
        } else if (pn <= 1) {
            const float* gsrc = pn == 0 ? gkv : gq; const int ld = pn == 0 ? 256 : 384, nslot = pn == 0 ? 4 : 8;
            bf16_t* dst = pn == 0 ? CKV : QL; float* ssq = pn == 0 ? ssq_kv : ssq_q;
            f32x4 gv[2][2];
#pragma unroll
            for (int bj = 0; bj < 2; ++bj)
#pragma unroll
                for (int n = 0; n < 2; ++n) gv[bj][n] = *(const f32x4*)(gsrc + c8 + bj * HALF + 4 * n);
#pragma unroll
            for (int ai = 0; ai < 2; ++ai)
#pragma unroll
                for (int m = 0; m < 4; ++m) { const int row = row0 + ai * HALF + m * 16; float ss = 0.f;
#pragma unroll
                    for (int bj = 0; bj < 2; ++bj) { const f32x4 a0 = acc[ai][bj][m][0], a1 = acc[ai][bj][m][1]; ss += dot4(a0) + dot4(a1);
                        const f32x4 w0 = a0 * gv[bj][0], w1 = a1 * gv[bj][1];
                        *(u32x4*)(dst + (size_t)row * ld + c8 + bj * HALF) = pack8(w0, w1);
                        if (pn == 0 && u.pm < 16) { float* sp = st_ckv + (size_t)row * 256 + c8 + bj * HALF; *(f32x4*)sp = w0; *(f32x4*)(sp + 4) = w1; } }
                    ss += __shfl_xor(ss, 16); ss += __shfl_xor(ss, 32);
                    if (fq == 0) ssq[(size_t)row * nslot + wc] = ss; }
        } else {
            f32x4 gv[2];
#pragma unroll
            for (int n = 0; n < 2; ++n) gv[n] = *(const f32x4*)(gq + 256 + c8 + 4 * n);
#pragma unroll
            for (int ai = 0; ai < 2; ++ai)
#pragma unroll
                for (int m = 0; m < 4; ++m) { const int row = row0 + ai * HALF + m * 16;
                    const f32x4 a0 = acc[ai][0][m][0], a1 = acc[ai][0][m][1]; float ss = dot4(a0) + dot4(a1);
                    *(u32x4*)(QL + (size_t)row * 384 + 256 + c8) = pack8(a0 * gv[0], a1 * gv[1]);
                    ss += __shfl_xor(ss, 16); ss += __shfl_xor(ss, 32);
                    if (fq == 0) ssq_q[(size_t)row * 8 + 4 + wc] = ss; }
            if (wc == 0) {
#pragma unroll
                for (int ai = 0; ai < 2; ++ai)
#pragma unroll
                    for (int m = 0; m < 4; ++m) { const int row = row0 + ai * HALF + m * 16;
                        f32x4 a0 = acc[ai][1][m][0], a1 = acc[ai][1][m][1];
                        if (u.pm < 16) { float* sp = st_kr + (size_t)row * 32 + 8 * fq; *(f32x4*)sp = a0; *(f32x4*)(sp + 4) = a1; }
                        else {
                            const int pos = (row - NCTX) & 4095, p = (fq >> 1) ? (pos & 63) : (pos >> 6);
                            const f32x4* cs = (const f32x4*)(rope + p * 16); const f32x4 c01 = cs[0], c23 = cs[1], c45 = cs[2], c67 = cs[3];
                            f32x4 p0, p1;
#pragma unroll
                            for (int i = 0; i < 4; ++i) { p0[i] = __shfl_xor(a0[i], 16); p1[i] = __shfl_xor(a1[i], 16); }
                            const float sg = (fq & 1) ? 1.f : -1.f;
                            a0[0] = a0[0] * c01[0] + sg * p0[0] * c01[1]; a0[1] = a0[1] * c01[2] + sg * p0[1] * c01[3];
                            a0[2] = a0[2] * c23[0] + sg * p0[2] * c23[1]; a0[3] = a0[3] * c23[2] + sg * p0[3] * c23[3];
                            a1[0] = a1[0] * c45[0] + sg * p1[0] * c45[1]; a1[1] = a1[1] * c45[2] + sg * p1[1] * c45[3];
                            a1[2] = a1[2] * c67[0] + sg * p1[2] * c67[1]; a1[3] = a1[3] * c67[2] + sg * p1[3] * c67[3];
                        }
                        *(u32x4*)(KR + (size_t)row * 32 + 8 * fq) = pack8(a0, a1); }
            }
        }
    }
};

struct EpiQUp {
    static constexpr bool PERM = true, AFTER_DRAIN = false; static constexpr int NST = 16;
    bf16_t* Q; const float* ssq_q; const float* rope;
    __device__ __forceinline__ void operator()(const f32x4 (&acc)[2][2][4][2], const Unit& u, int wr, int wc, int fr, int fq) const {
        asm volatile("" : "+v"(fr), "+v"(fq));
        const int row0 = u.pm * BM + wr * 64 + fr, col0 = u.pn * BM + wc * 32 + 8 * fq; const bool latent = u.pm >= 16;
        int d8[2];
#pragma unroll
        for (int bj = 0; bj < 2; ++bj) d8[bj] = ((col0 + bj * HALF) >> 3) % 12;
#pragma unroll
        for (int ai = 0; ai < 2; ++ai)
#pragma unroll
            for (int m = 0; m < 4; ++m) { const int row = row0 + ai * HALF + m * 16;
                const f32x4 s0 = *(const f32x4*)(ssq_q + (size_t)row * 8), s1 = *(const f32x4*)(ssq_q + (size_t)row * 8 + 4);
                const float ss = ((s0[0] + s0[1]) + (s0[2] + s0[3])) + ((s1[0] + s1[1]) + (s1[2] + s1[3]));
                const float rs = QSCALE / sqrtf(ss * (1.f / 384.f) + RMS_EPS);
                const int pos = (row - NCTX) & 4095;
#pragma unroll
                for (int bj = 0; bj < 2; ++bj) { f32x4 a0 = acc[ai][bj][m][0] * rs, a1 = acc[ai][bj][m][1] * rs;
                    if (latent) {
                        f32x4 p0, p1;
#pragma unroll
                        for (int i = 0; i < 4; ++i) { p0[i] = __shfl_xor(a0[i], 16); p1[i] = __shfl_xor(a1[i], 16); }
                        if (d8[bj] >= 8) {
                            const int p = d8[bj] >= 10 ? (pos & 63) : (pos >> 6);
                            const f32x4* cs = (const f32x4*)(rope + p * 16); const f32x4 c01 = cs[0], c23 = cs[1], c45 = cs[2], c67 = cs[3];
                            const float sg = (d8[bj] & 1) ? 1.f : -1.f;
                            a0[0] = a0[0] * c01[0] + sg * p0[0] * c01[1]; a0[1] = a0[1] * c01[2] + sg * p0[1] * c01[3];
                            a0[2] = a0[2] * c23[0] + sg * p0[2] * c23[1]; a0[3] = a0[3] * c23[2] + sg * p0[3] * c23[3];
                            a1[0] = a1[0] * c45[0] + sg * p1[0] * c45[1]; a1[1] = a1[1] * c45[2] + sg * p1[1] * c45[3];
                            a1[2] = a1[2] * c67[0] + sg * p1[2] * c67[1]; a1[3] = a1[3] * c67[2] + sg * p1[3] * c67[3];
                        }
                    }
                    *(u32x4*)(Q + (size_t)row * 1536 + col0 + bj * HALF) = pack8(a0, a1); } }
    }
};

struct EpiKvUp {
    static constexpr bool PERM = true, AFTER_DRAIN = false; static constexpr int NST = 16;
    bf16_t* KV; const float* ssq_kv;
    __device__ __forceinline__ void operator()(const f32x4 (&acc)[2][2][4][2], const Unit& u, int wr, int wc, int fr, int fq) const {
        asm volatile("" : "+v"(fr), "+v"(fq));
        const int row0 = u.pm * BM + wr * 64 + fr, col0 = u.pn * BM + wc * 32 + 8 * fq; const bool tok = u.pm < MTOK / BM;
#pragma unroll
        for (int ai = 0; ai < 2; ++ai)
#pragma unroll
            for (int m = 0; m < 4; ++m) { const int row = row0 + ai * HALF + m * 16; float rs = 1.f;
                if (tok) { const f32x4 s0 = *(const f32x4*)(ssq_kv + (size_t)row * 4); rs = 1.0f / sqrtf(((s0[0] + s0[1]) + (s0[2] + s0[3])) * (1.f / 256.f) + RMS_EPS); }
#pragma unroll
                for (int bj = 0; bj < 2; ++bj) *(u32x4*)(KV + (size_t)row * 2048 + col0 + bj * HALF) = pack8(acc[ai][bj][m][0] * rs, acc[ai][bj][m][1] * rs); }
    }
};
template <class Epi, class Sched, bool ALIGN_EPI = false, bool SP2 = false, bool RELAX = false>
__device__ __forceinline__ void gemm_phase(PG8_LAS unsigned char* lds, const Gemm g, const Sched& S, const Epi& E) {
    int tid = threadIdx.x; asm volatile("" : "+v"(tid));
    const int wid = __builtin_amdgcn_readfirstlane(tid >> 6), lane = tid & 63, wr = wid >> 2, wc = wid & 3, fr = lane & 15, fq = lane >> 4;
    const int K = g.K, nt = K / BK;
    unsigned voffA[2], voffB[2];
#pragma unroll
    for (int i = 0; i < 2; ++i) { int R, C; stage_rc(tid * 16 + i * 8192, R, C); const int Rb = Epi::PERM ? ((R & ~31) + perm32(R & 31)) : R;
        voffA[i] = (unsigned)(R * K + C) * 2u; voffB[i] = (unsigned)(Rb * K + C) * 2u; }
    const size_t kstep = (size_t)(BK * 2);
    const size_t hstep = (size_t)HALF * K * 2;
    const size_t tstep = 2 * hstep;
    const unsigned ldsw = (unsigned)wid * 1024u;
    const int aoff = lds_byte(wr * 64 + fr, fq * 8), boff = lds_byte(wc * 32 + fr, fq * 8);
#define PG8_SA(b, h) (((b) * 2 + (h)) * HTB)
#define PG8_SB(b, h) ((4 + (b) * 2 + (h)) * HTB)
#define PG8_STAGE(bufoff, gbase, voff) do { _Pragma("unroll") for (int _i = 0; _i < 2; ++_i) \
        __builtin_amdgcn_global_load_lds((const unsigned*)((const char*)(gbase) + (voff)[_i]), (PG8_LAS unsigned*)(lds + (bufoff) + ldsw + _i * 8192), 16, 0, 0); } while (0)
#define PG8_LDA(dst, b, h) do { _Pragma("unroll") for (int m = 0; m < 4; ++m) _Pragma("unroll") for (int k = 0; k < 2; ++k) dst[m][k] = *(const PG8_LAS bf16x8*)(lds + PG8_SA(b, h) + aoff + m * 2048 + k * 1024); } while (0)
#define PG8_LDB(dst, b, h) do { _Pragma("unroll") for (int n = 0; n < 2; ++n) _Pragma("unroll") for (int k = 0; k < 2; ++k) dst[n][k] = *(const PG8_LAS bf16x8*)(lds + PG8_SB(b, h) + boff + n * 2048 + k * 1024); } while (0)
#define PG8_MMA(ai, bj, At, Bt) do { __builtin_amdgcn_s_setprio(1); _Pragma("unroll") for (int m = 0; m < 4; ++m) _Pragma("unroll") for (int n = 0; n < 2; ++n) _Pragma("unroll") for (int k = 0; k < 2; ++k) \
        acc[ai][bj][m][n] = __builtin_amdgcn_mfma_f32_16x16x32_bf16(Bt[n][k], At[m][k], acc[ai][bj][m][n], 0, 0, 0); __builtin_amdgcn_s_setprio(0); } while (0)
#define PG8_WAIT_V(n) asm volatile("s_waitcnt vmcnt(" #n ")" ::: "memory")
#define PG8_WAIT_L(n) asm volatile("s_waitcnt lgkmcnt(" #n ")" ::: "memory")
#define PG8_BAR __builtin_amdgcn_s_barrier()
#define PG8_SCHED __builtin_amdgcn_sched_barrier(0)
    Unit cur, nxt; int ui = 0;
    if (!S.next(0, cur)) return;
    f32x4 acc[2][2][4][2];
#pragma unroll
    for (int a = 0; a < 2; ++a)
#pragma unroll
        for (int b = 0; b < 2; ++b)
#pragma unroll
            for (int m = 0; m < 4; ++m)
#pragma unroll
                for (int n = 0; n < 2; ++n) acc[a][b][m][n] = (f32x4){0.f, 0.f, 0.f, 0.f};
    bf16x8 At[4][2], B0[2][2], B1[2][2];
    const char* cA = (const char*)g.A + (size_t)cur.pm * tstep; const char* cB = (const char*)g.Bt + (size_t)cur.pn * tstep;
    S.a_ready(cur);
    if constexpr (SP2) {
        PG8_STAGE(PG8_SB(0, 0), cB, voffB); PG8_STAGE(PG8_SB(0, 1), cB + hstep, voffB); PG8_STAGE(PG8_SA(0, 0), cA, voffA); PG8_STAGE(PG8_SA(0, 1), cA + hstep, voffA);
        if (wr == 1) PG8_BAR;
        PG8_WAIT_V(2); PG8_BAR;
        PG8_STAGE(PG8_SB(1, 0), cB + kstep, voffB); PG8_STAGE(PG8_SA(1, 0), cA + kstep, voffA); PG8_STAGE(PG8_SB(1, 1), cB + hstep + kstep, voffB);
        if constexpr (RELAX) { PG8_STAGE(PG8_SA(1, 1), cA + hstep + kstep, voffA); PG8_WAIT_V(8); } else PG8_WAIT_V(6);
        PG8_BAR;
    } else {
        PG8_STAGE(PG8_SB(0, 0), cB, voffB); PG8_STAGE(PG8_SA(0, 0), cA, voffA); PG8_STAGE(PG8_SB(0, 1), cB + hstep, voffB); PG8_STAGE(PG8_SA(0, 1), cA + hstep, voffA);
        if (wr == 1) PG8_BAR;
        PG8_WAIT_V(4); PG8_BAR;
        PG8_STAGE(PG8_SB(1, 0), cB + kstep, voffB); PG8_STAGE(PG8_SA(1, 0), cA + kstep, voffA); PG8_STAGE(PG8_SB(1, 1), cB + hstep + kstep, voffB);
        PG8_WAIT_V(6); PG8_BAR;
    }
#define PG8_WAIT_VX(fresh) do { if constexpr (RELAX) asm volatile("s_cmp_lg_u32 %0, 0\n\ts_cbranch_scc1 1f\n\ts_waitcnt vmcnt(8)\n1:\n\ts_waitcnt vmcnt(%1)" :: "s"(fresh), "n"(8 + Epi::NST) : "memory", "scc"); else PG8_WAIT_V(8); } while (0)
    int pre = 0;
    for (;;) {
        const bool has_next = S.next(ui + 1, nxt);
        const char* nA = has_next ? (const char*)g.A + (size_t)nxt.pm * tstep : cA; const char* nB = has_next ? (const char*)g.Bt + (size_t)nxt.pn * tstep : cB;
        for (int t = 0; t < nt; t += 2) {
            const bool last = (t == nt - 2);
            const char* a1 = cA + (size_t)(t + 1) * kstep;
            const char* a2 = last ? nA : cA + (size_t)(t + 2) * kstep; const char* b2 = last ? nB : cB + (size_t)(t + 2) * kstep;
            const char* a3 = a2 + kstep; const char* b3 = b2 + kstep;
            if (last && has_next) S.a_ready(nxt);
            if constexpr (SP2) {
            const int fresh = RELAX ? __builtin_amdgcn_readfirstlane(t == 0 ? pre : 0) : 0; (void)fresh;
            PG8_LDB(B0, 0, 0); PG8_LDB(B1, 0, 1); PG8_SCHED; PG8_LDA(At, 0, 0); if constexpr (!RELAX) PG8_STAGE(PG8_SA(1, 1), a1 + hstep, voffA);
            PG8_WAIT_VX(fresh); PG8_WAIT_L(0); PG8_BAR; PG8_MMA(0, 0, At, B0); PG8_MMA(0, 1, At, B1); PG8_BAR; PG8_SCHED;
            PG8_LDA(At, 0, 1); PG8_STAGE(PG8_SB(0, 0), b2, voffB); PG8_STAGE(PG8_SB(0, 1), b2 + hstep, voffB); PG8_STAGE(PG8_SA(0, 0), a2, voffA);
            PG8_WAIT_VX(fresh); PG8_WAIT_L(0); PG8_BAR; PG8_MMA(1, 0, At, B0); PG8_MMA(1, 1, At, B1); PG8_BAR; PG8_SCHED;
            PG8_LDB(B0, 1, 0); PG8_LDB(B1, 1, 1); PG8_SCHED; PG8_LDA(At, 1, 0); PG8_STAGE(PG8_SA(0, 1), a2 + hstep, voffA);
            PG8_WAIT_VX(fresh); PG8_WAIT_L(0); PG8_BAR; PG8_MMA(0, 0, At, B0); PG8_MMA(0, 1, At, B1); PG8_BAR; PG8_SCHED;
            PG8_LDA(At, 1, 1); PG8_STAGE(PG8_SB(1, 0), b3, voffB); PG8_STAGE(PG8_SB(1, 1), b3 + hstep, voffB); PG8_STAGE(PG8_SA(1, 0), a3, voffA);
            PG8_WAIT_V(8); PG8_WAIT_L(0); PG8_BAR; PG8_MMA(1, 0, At, B0); PG8_MMA(1, 1, At, B1); PG8_BAR; PG8_SCHED;
            if constexpr (RELAX) { PG8_STAGE(PG8_SA(1, 1), a3 + hstep, voffA); PG8_SCHED; }
            } else {
            PG8_LDB(B0, 0, 0); PG8_SCHED; PG8_LDA(At, 0, 0); PG8_STAGE(PG8_SA(1, 1), a1 + hstep, voffA);
            PG8_WAIT_L(8); PG8_BAR; PG8_WAIT_L(0); PG8_MMA(0, 0, At, B0); PG8_BAR; PG8_SCHED;
            PG8_LDB(B1, 0, 1); PG8_STAGE(PG8_SB(0, 0), b2, voffB);
            PG8_BAR; PG8_WAIT_L(0); PG8_MMA(0, 1, At, B1); PG8_BAR;
            PG8_LDA(At, 0, 1); PG8_STAGE(PG8_SA(0, 0), a2, voffA);
            PG8_BAR; PG8_WAIT_L(0); PG8_MMA(1, 0, At, B0); PG8_BAR; PG8_SCHED;
            PG8_STAGE(PG8_SB(0, 1), b2 + hstep, voffB);
            PG8_WAIT_V(6); PG8_BAR; PG8_MMA(1, 1, At, B1); PG8_BAR;
            PG8_LDB(B0, 1, 0); PG8_SCHED; PG8_LDA(At, 1, 0); PG8_STAGE(PG8_SA(0, 1), a2 + hstep, voffA);
            PG8_WAIT_L(8); PG8_BAR; PG8_WAIT_L(0); PG8_MMA(0, 0, At, B0); PG8_BAR; PG8_SCHED;
            PG8_LDB(B1, 1, 1); PG8_STAGE(PG8_SB(1, 0), b3, voffB);
            PG8_BAR; PG8_WAIT_L(0); PG8_MMA(0, 1, At, B1); PG8_BAR;
            PG8_LDA(At, 1, 1); PG8_STAGE(PG8_SA(1, 0), a3, voffA);
            PG8_BAR; PG8_WAIT_L(0); PG8_MMA(1, 0, At, B0); PG8_BAR; PG8_SCHED;
            PG8_STAGE(PG8_SB(1, 1), b3 + hstep, voffB);
            PG8_WAIT_V(6); PG8_BAR; PG8_MMA(1, 1, At, B1); PG8_BAR;
            }
        }
        if constexpr (ALIGN_EPI) { if (wr == 0) PG8_BAR; }
        if constexpr (!Epi::AFTER_DRAIN) { E(acc, cur, wr, wc, fr, fq); S.done(cur); }
        if (!has_next) break;
#pragma unroll
        for (int a = 0; a < 2; ++a)
#pragma unroll
            for (int b = 0; b < 2; ++b)
#pragma unroll
                for (int m = 0; m < 4; ++m)
#pragma unroll
                    for (int n = 0; n < 2; ++n) acc[a][b][m][n] = (f32x4){0.f, 0.f, 0.f, 0.f};
        cur = nxt; cA = nA; cB = nB; ++ui; pre = 1;
        if constexpr (ALIGN_EPI) { if (wr == 1) PG8_BAR; }
    }
    PG8_WAIT_V(0);
    if constexpr (!ALIGN_EPI) { if (wr == 0) PG8_BAR; }
    PG8_BAR;
    if constexpr (Epi::AFTER_DRAIN) { E.fused(acc, cur, wr, wc, fr, fq, lds, wid, lane); S.done(cur); }
#undef PG8_SA
#undef PG8_SB
#undef PG8_STAGE
#undef PG8_LDA
#undef PG8_LDB
#undef PG8_MMA
#undef PG8_WAIT_V
#undef PG8_WAIT_L
#undef PG8_WAIT_VX
#undef PG8_BAR
#undef PG8_SCHED
}
}
namespace att {
#define ATT_LAS __attribute__((address_space(3)))
typedef unsigned short bf16_t;
using bf16x8 = __attribute__((ext_vector_type(8))) short;
using s16x4  = __attribute__((ext_vector_type(4))) short;
using f32x16 = __attribute__((ext_vector_type(16))) float;
using u32x4  = __attribute__((ext_vector_type(4))) unsigned;
constexpr int NW = 8, QBLK = 32, KVBLK = 64;
constexpr int SHM_K = 64 * 256, SHM_V = 64 * 64 * 2;
constexpr int NBUF = 5;
constexpr int LDS_BYTES = NBUF * SHM_V + NBUF * SHM_K + NW * 64 * 4;
constexpr int LDS_TOTAL = LDS_BYTES + NW * 4096;
constexpr float THR = 8.f;
#define KSWZ(row, colB) ((row) * 256 + ((colB) ^ (((row) & 15) << 4)))
#define ATT_SBAR() __builtin_amdgcn_sched_barrier(0)
__device__ __forceinline__ int crow(int r, int hi) { return (r & 3) + 8 * (r >> 2) + 4 * hi; }
__device__ __forceinline__ unsigned cvtpk(float lo, float hi) { unsigned r; asm volatile("v_cvt_pk_bf16_f32 %0, %1, %2" : "=v"(r) : "v"(lo), "v"(hi)); return r; }

template <bool FIRST>
__device__ __forceinline__ void partialSM(f32x16& p0, f32x16& p1, float& m_reg, f32x16& negm, float& alpha) {
  float pmax = p0[0];
#pragma unroll
  for (int r = 1; r < 16; ++r) pmax = fmaxf(pmax, p0[r]);
#pragma unroll
  for (int r = 0; r < 16; ++r) pmax = fmaxf(pmax, p1[r]);
  { auto rr = __builtin_amdgcn_permlane32_swap(__float_as_uint(pmax), __float_as_uint(pmax), false, false);
    pmax = fmaxf(__uint_as_float(rr[0]), __uint_as_float(rr[1])); }
  alpha = 1.f;
  if (FIRST || __builtin_expect(__any(pmax > THR), 0)) {
    const float dl = FIRST ? pmax : fmaxf(pmax, 0.f);
    m_reg += dl;
#pragma unroll
    for (int r = 0; r < 16; ++r) { p0[r] -= dl; p1[r] -= dl; }
#pragma unroll
    for (int r = 0; r < 16; ++r) negm[r] = -m_reg;
    if (!FIRST) alpha = __builtin_amdgcn_exp2f(-dl);
  }
}
__device__ __forceinline__ void finishSM(f32x16& p0, f32x16& p1, float alpha, float& l_reg, bf16x8& pa0, bf16x8& pa1, bf16x8& pa2, bf16x8& pa3) {
#pragma unroll
  for (int r = 0; r < 16; ++r) p0[r] = __builtin_amdgcn_exp2f(p0[r]);
#pragma unroll
  for (int r = 0; r < 16; ++r) p1[r] = __builtin_amdgcn_exp2f(p1[r]);
  float ps = 0;
#pragma unroll
  for (int r = 0; r < 16; ++r) ps += p0[r];
#pragma unroll
  for (int r = 0; r < 16; ++r) ps += p1[r];
  { auto rr = __builtin_amdgcn_permlane32_swap(__float_as_uint(ps), __float_as_uint(ps), false, false);
    ps = __uint_as_float(rr[0]) + __uint_as_float(rr[1]); }
  l_reg = l_reg * alpha + ps;
#define ATT_PK4(P, BASE, OUT) do { unsigned a0 = cvtpk(P[BASE + 0], P[BASE + 1]), a1 = cvtpk(P[BASE + 2], P[BASE + 3]);   \
    unsigned b0 = cvtpk(P[BASE + 4], P[BASE + 5]), b1 = cvtpk(P[BASE + 6], P[BASE + 7]);                              \
    auto r0 = __builtin_amdgcn_permlane32_swap(a0, b0, false, false); auto r1 = __builtin_amdgcn_permlane32_swap(a1, b1, false, false); \
    u32x4 w = {r0[0], r1[0], r0[1], r1[1]}; OUT = __builtin_bit_cast(bf16x8, w); } while (0)
  ATT_PK4(p0, 0, pa0); ATT_PK4(p0, 8, pa1); ATT_PK4(p1, 0, pa2); ATT_PK4(p1, 8, pa3);
#undef ATT_PK4
}
__device__ __forceinline__ void qkt(f32x16& p0, f32x16& p1, const ATT_LAS char* Ks, const bf16x8* qr, const f32x16& negm, int r32, int hi) {
#pragma unroll
  for (int d0 = 0; d0 < 6; ++d0) { const int cb = (d0 * 16 + hi * 8) * 2;
    const bf16x8 b0 = *(const ATT_LAS bf16x8*)(Ks + KSWZ(r32, cb));
    const bf16x8 b1 = *(const ATT_LAS bf16x8*)(Ks + KSWZ(32 + r32, cb));
    if (d0 == 0) { p0 = __builtin_amdgcn_mfma_f32_32x32x16_bf16(b0, qr[0], negm, 0, 0, 0); p1 = __builtin_amdgcn_mfma_f32_32x32x16_bf16(b1, qr[0], negm, 0, 0, 0); }
    else { p0 = __builtin_amdgcn_mfma_f32_32x32x16_bf16(b0, qr[d0], p0, 0, 0, 0); p1 = __builtin_amdgcn_mfma_f32_32x32x16_bf16(b1, qr[d0], p1, 0, 0, 0); } }
}
__device__ __forceinline__ int v_st(int k, int c) { const int kk = (k & ~0xC) | ((k & 4) << 1) | ((k & 8) >> 1); return ((kk >> 3) * 2 + (c >> 5)) * 512 + ((kk & 7) * 32 + (c & 31)) * 2; }
__device__ __forceinline__ int v_rd_base(int lane) { return ((lane & 3) << 3) | (((lane >> 2) & 3) << 6) | (((lane >> 4) & 1) << 5) | (((lane >> 5) & 1) << 8); }
constexpr int v_rd_off(int d0, int ks, int half) { return d0 * 512 + ks * 2048 + half * 1024; }
template <int OFF> __device__ __forceinline__ s16x4 tr_read(int vb) {
  s16x4 r; asm volatile("ds_read_b64_tr_b16 %0, %1 offset:%2" : "=&v"(r) : "v"(vb), "i"(OFF) : "memory"); return r;
}
__device__ __forceinline__ void pv_d0(f32x16* o, int vb, bf16x8 pa0, bf16x8 pa1, bf16x8 pa2, bf16x8 pa3) {
  const s16x4 l0 = tr_read<v_rd_off(0, 0, 0)>(vb), h0 = tr_read<v_rd_off(0, 0, 1)>(vb), l1 = tr_read<v_rd_off(0, 1, 0)>(vb), h1 = tr_read<v_rd_off(0, 1, 1)>(vb);
  const s16x4 l2 = tr_read<v_rd_off(0, 2, 0)>(vb), h2 = tr_read<v_rd_off(0, 2, 1)>(vb), l3 = tr_read<v_rd_off(0, 3, 0)>(vb), h3 = tr_read<v_rd_off(0, 3, 1)>(vb);
  const s16x4 m0 = tr_read<v_rd_off(1, 0, 0)>(vb), n0 = tr_read<v_rd_off(1, 0, 1)>(vb), m1 = tr_read<v_rd_off(1, 1, 0)>(vb), n1 = tr_read<v_rd_off(1, 1, 1)>(vb);
  const s16x4 m2 = tr_read<v_rd_off(1, 2, 0)>(vb), n2 = tr_read<v_rd_off(1, 2, 1)>(vb), m3 = tr_read<v_rd_off(1, 3, 0)>(vb), n3 = tr_read<v_rd_off(1, 3, 1)>(vb);
#define ATT_PK(L, H) (bf16x8){L[0], L[1], L[2], L[3], H[0], H[1], H[2], H[3]}
  asm volatile("s_waitcnt lgkmcnt(8)" ::: "memory"); ATT_SBAR();
  o[0] = __builtin_amdgcn_mfma_f32_32x32x16_bf16(pa0, ATT_PK(l0, h0), o[0], 0, 0, 0);
  o[0] = __builtin_amdgcn_mfma_f32_32x32x16_bf16(pa1, ATT_PK(l1, h1), o[0], 0, 0, 0);
  o[0] = __builtin_amdgcn_mfma_f32_32x32x16_bf16(pa2, ATT_PK(l2, h2), o[0], 0, 0, 0);
  o[0] = __builtin_amdgcn_mfma_f32_32x32x16_bf16(pa3, ATT_PK(l3, h3), o[0], 0, 0, 0);
  asm volatile("s_waitcnt lgkmcnt(0)" ::: "memory"); ATT_SBAR();
  o[1] = __builtin_amdgcn_mfma_f32_32x32x16_bf16(pa0, ATT_PK(m0, n0), o[1], 0, 0, 0);
  o[1] = __builtin_amdgcn_mfma_f32_32x32x16_bf16(pa1, ATT_PK(m1, n1), o[1], 0, 0, 0);
  o[1] = __builtin_amdgcn_mfma_f32_32x32x16_bf16(pa2, ATT_PK(m2, n2), o[1], 0, 0, 0);
  o[1] = __builtin_amdgcn_mfma_f32_32x32x16_bf16(pa3, ATT_PK(m3, n3), o[1], 0, 0, 0);
#undef ATT_PK
}
__device__ __forceinline__ float bf2f(unsigned short b) { return __uint_as_float((unsigned)b << 16); }
__device__ __forceinline__ unsigned short f2bf(float f) { unsigned u = __float_as_uint(f); return (unsigned short)((u + 0x7fffu + ((u >> 16) & 1u)) >> 16); }

__device__ __forceinline__ void attn_unit(const bf16_t* __restrict__ Q, const bf16_t* __restrict__ KV, const bf16_t* __restrict__ KR, bf16_t* SG,
                                          int qrow0, int h, int kb0, int nt0, int kb1, int NT, ATT_LAS char* lds) {
  const int tid = threadIdx.x, wid = tid >> 6, lane = tid & 63, r32 = lane & 31, hi = lane >> 5;
  ATT_LAS char* V_lds = lds; ATT_LAS char* K_lds = lds + NBUF * SHM_V;
  ATT_LAS float* ws = (ATT_LAS float*)(lds + NBUF * SHM_V + NBUF * SHM_K) + wid * 64; ATT_LAS float* li_l = ws; ATT_LAS float* al_l = ws + 32;
  float m_reg = 0.f, l_reg = 0.f; f32x16 o[2] = {}; f32x16 negm = {}; bf16x8 qr[6];
  const bf16_t* Qw = Q + (size_t)(qrow0 + wid * QBLK + r32) * 1536 + h * 96 + hi * 8;
#pragma unroll
  for (int d0 = 0; d0 < 6; ++d0) qr[d0] = *(const bf16x8*)(Qw + d0 * 16);
  const int wu = __builtin_amdgcn_readfirstlane(wid);
  int offK[4], offV[2]; bool isR[4];
#pragma unroll
  for (int a_ = 0; a_ < 4; ++a_) { const int q_ = 4 * (wid & 3) + a_, r_ = 4 * q_ + (lane >> 4), c_ = (lane & 15) ^ (r_ & 15);
    isR[a_] = c_ >= 8 && c_ < 12; offK[a_] = isR[a_] ? r_ * 64 + (c_ - 8) * 16 : r_ * 4096 + h * 256 + (c_ < 8 ? c_ : 0) * 16; }
#pragma unroll
  for (int a_ = 0; a_ < 2; ++a_) { const int P = 64 * (2 * (wid & 3) + a_) + lane, sub = P >> 5, w_ = P & 31, kk = (sub >> 1) * 8 + (w_ >> 2), cc = (sub & 1) * 32 + (w_ & 3) * 8, k_ = (kk & ~0xC) | ((kk & 4) << 1) | ((kk & 8) >> 1);
    offV[a_] = k_ * 4096 + h * 256 + 128 + cc * 2; }
#define ATT_TBASE(t) ((t) < nt0 ? kb0 + (t) * KVBLK : kb1 + ((t) - nt0) * KVBLK)
#define ATT_DMA(t, slot) do { if (wu < 4) { const size_t rb_ = (size_t)ATT_TBASE(t); const char* kvb_ = (const char*)KV + rb_ * 4096; const char* krb_ = (const char*)KR + rb_ * 64; \
    _Pragma("unroll") for (int a_ = 0; a_ < 4; ++a_) __builtin_amdgcn_global_load_lds((const unsigned*)((isR[a_] ? krb_ : kvb_) + offK[a_]), (ATT_LAS unsigned*)(K_lds + (slot) * SHM_K + (4 * wu + a_) * 1024), 16, 0, 0); \
    _Pragma("unroll") for (int a_ = 0; a_ < 2; ++a_) __builtin_amdgcn_global_load_lds((const unsigned*)(kvb_ + offV[a_]), (ATT_LAS unsigned*)(V_lds + (slot) * SHM_V + (2 * wu + a_) * 1024), 16, 0, 0); } } while (0)
#define ATT_DMA_SYNC() do { asm volatile("s_waitcnt vmcnt(0)" ::: "memory"); __syncthreads(); } while (0)
  const int vb0 = (int)(unsigned)(size_t)V_lds + v_rd_base(lane);
#define ATT_RESC(a) do { if (__any((a) < 1.f)) { if (hi == 0) al_l[r32] = (a); asm volatile("s_waitcnt lgkmcnt(0)" ::: "memory"); \
    _Pragma("unroll") for (int d = 0; d < 2; ++d) _Pragma("unroll") for (int r = 0; r < 16; ++r) o[d][r] *= al_l[crow(r, hi)]; } } while (0)
#define ATT_M5(x) ((x) >= 5 ? (x) - 5 : (x))
  f32x16 pA0, pA1, pB0, pB1; float alA, alB; bf16x8 pa0, pa1, pa2, pa3;
  ATT_DMA(0, 0); ATT_DMA(1, 1); if (2 < NT) ATT_DMA(2, 2);
  ATT_DMA_SYNC();
  qkt(pA0, pA1, K_lds, qr, negm, r32, hi); partialSM<true>(pA0, pA1, m_reg, negm, alA);
  int b = 1;
  for (int j = 1; j + 1 < NT; j += 2) {
    if (j + 2 < NT) ATT_DMA(j + 2, ATT_M5(b + 2));
    ATT_SBAR(); qkt(pB0, pB1, K_lds + b * SHM_K, qr, negm, r32, hi);
    finishSM(pA0, pA1, alA, l_reg, pa0, pa1, pa2, pa3); ATT_SBAR();
    pv_d0(o, vb0 + ATT_M5(b + 4) * SHM_V, pa0, pa1, pa2, pa3); partialSM<false>(pB0, pB1, m_reg, negm, alB);
    ATT_RESC(alB);
    if (j + 3 < NT) ATT_DMA(j + 3, ATT_M5(b + 3));
    ATT_SBAR(); qkt(pA0, pA1, K_lds + ATT_M5(b + 1) * SHM_K, qr, negm, r32, hi);
    finishSM(pB0, pB1, alB, l_reg, pa0, pa1, pa2, pa3); ATT_SBAR();
    pv_d0(o, vb0 + b * SHM_V, pa0, pa1, pa2, pa3); partialSM<false>(pA0, pA1, m_reg, negm, alA);
    ATT_RESC(alA); ATT_DMA_SYNC(); b = ATT_M5(b + 2);
  }
  ATT_SBAR(); qkt(pB0, pB1, K_lds + b * SHM_K, qr, negm, r32, hi);
  finishSM(pA0, pA1, alA, l_reg, pa0, pa1, pa2, pa3); ATT_SBAR();
  pv_d0(o, vb0 + ATT_M5(b + 4) * SHM_V, pa0, pa1, pa2, pa3); partialSM<false>(pB0, pB1, m_reg, negm, alB);
  ATT_RESC(alB);
  finishSM(pB0, pB1, alB, l_reg, pa0, pa1, pa2, pa3); ATT_SBAR();
  pv_d0(o, vb0 + b * SHM_V, pa0, pa1, pa2, pa3);
  if (hi == 0) li_l[r32] = l_reg; asm volatile("s_waitcnt lgkmcnt(0)" ::: "memory");
  float rli[16];
#pragma unroll
  for (int r = 0; r < 16; ++r) rli[r] = __builtin_amdgcn_rcpf(li_l[crow(r, hi)]);
  bf16_t* Ow = SG + (size_t)(qrow0 + wid * QBLK) * 1024 + h * 64 + r32;
#pragma unroll
  for (int r = 0; r < 16; ++r) { const int orow = crow(r, hi);
#pragma unroll
    for (int d0 = 0; d0 < 2; ++d0) { bf16_t* p = Ow + (size_t)orow * 1024 + d0 * 32; *p = f2bf(o[d0][r] * rli[r] * bf2f(*p)); } }
  __syncthreads();
#undef ATT_TBASE
#undef ATT_DMA
#undef ATT_DMA_SYNC
#undef ATT_RESC
#undef ATT_M5
}
#undef KSWZ
}
#define GAS __attribute__((address_space(1)))
#define LAS __attribute__((address_space(3)))
typedef unsigned short bf16;
typedef unsigned v4u __attribute__((ext_vector_type(4)));
typedef float f32x4 __attribute__((ext_vector_type(4)));
typedef short bf16x8 __attribute__((ext_vector_type(8)));
typedef GAS unsigned gu32;
typedef GAS unsigned long long gu64;
#define RLX_AGENT __ATOMIC_RELAXED, __HIP_MEMORY_SCOPE_AGENT
#define LDS_WAIT() asm volatile("s_waitcnt lgkmcnt(0)" ::: "memory")
#define VM_WAIT() asm volatile("s_waitcnt vmcnt(0)" ::: "memory")
__device__ __forceinline__ unsigned long long rt() { return __builtin_amdgcn_s_memrealtime(); }
__device__ __forceinline__ unsigned f2bf(float f) { unsigned u = __builtin_bit_cast(unsigned, f); return (u + 0x7fffu + ((u >> 16) & 1u)) >> 16; }
__device__ __forceinline__ unsigned pk2(float lo, float hi) { return f2bf(lo) | (f2bf(hi) << 16); }

#define XB_TMO      128
#define XB_XCNT(j)  (256  + 64 * (j))
#define XB_XSUB(j)  (1280 + 64 * (j))
#define XB_XGEN(j)  (2304 + 64 * (j))
#define XB_TOP      3328
#define XB_TOPGEN   3392
#define XCD_BAR_WORDS 3456
#define XB_SPIN_CAP (1u << 18)

__device__ __forceinline__ unsigned xb_ld(unsigned* p)              { return __hip_atomic_load(p, __ATOMIC_RELAXED, __HIP_MEMORY_SCOPE_AGENT); }
__device__ __forceinline__ unsigned xb_add(unsigned* p, unsigned v) { return __hip_atomic_fetch_add(p, v, __ATOMIC_RELAXED, __HIP_MEMORY_SCOPE_AGENT); }
__device__ __forceinline__ unsigned xb_xcc_id() { return (unsigned)__builtin_amdgcn_s_getreg((3 << 11) | 20) & 0xFu; }
#define XB_SPIN(cond, bar) do { unsigned _sp = 0; while (cond) { __builtin_amdgcn_s_sleep(1); \
    if ((++_sp & 255u) == 0u) { if (xb_ld(&(bar)[XB_TMO])) break; if (_sp > XB_SPIN_CAP) { atomicAdd(&(bar)[XB_TMO], 1u); break; } } } } while (0)

struct XcdBarrier {
    unsigned* bar; unsigned x;
    volatile LAS unsigned* st;
};

__device__ __forceinline__ XcdBarrier xcd_barrier_post(unsigned* bar, volatile LAS unsigned* st) {
    XcdBarrier b; b.bar = bar; b.x = xb_xcc_id(); b.st = st;
    if (threadIdx.x == 0) (void)xb_add(&bar[XB_XCNT(b.x)], 1u);
    return b;
}
__device__ __forceinline__ void xcd_barrier_complete(unsigned* bar, unsigned x, unsigned& nloc, unsigned& nx) {
    const unsigned G = gridDim.x * gridDim.y * gridDim.z;
    unsigned sum, cnt, mine, sp = 0u;
    for (;;) {
        sum = 0u; cnt = 0u; mine = 0u;
#pragma unroll
        for (unsigned j = 0; j < 16; ++j) { const unsigned c = xb_ld(&bar[XB_XCNT(j)]); sum += c; cnt += (c > 0u) ? 1u : 0u; mine = (j == x) ? c : mine; }
        if (sum == G) break;
        __builtin_amdgcn_s_sleep(1);
        if ((++sp & 255u) == 0u) { if (xb_ld(&bar[XB_TMO])) break; if (sp > XB_SPIN_CAP) { atomicAdd(&bar[XB_TMO], 1u); break; } }
    }
    nloc = mine > 0u ? mine : 1u; nx = cnt > 0u ? cnt : 1u;
}

__device__ __forceinline__ void xcd_barrier(const XcdBarrier& b) {
    asm volatile("s_waitcnt vmcnt(0)" ::: "memory");
    __syncthreads();
    if (threadIdx.x == 0) {
        unsigned* bar = b.bar;
        __builtin_amdgcn_s_waitcnt(0);
        unsigned nloc = b.st[0], nx = b.st[1];
        if (nloc == 0u) { xcd_barrier_complete(bar, b.x, nloc, nx); b.st[0] = nloc; b.st[1] = nx; }
        const unsigned old = xb_add(&bar[XB_XSUB(b.x)], 1u);
        const unsigned gen = old / nloc;
        if (old + 1u == (gen + 1u) * nloc) {
            __builtin_amdgcn_fence(__ATOMIC_RELEASE, "agent");
            asm volatile("s_waitcnt vmcnt(0)" ::: "memory");
            const unsigned og = xb_add(&bar[XB_TOP], 1u);
            const unsigned tg = og / nx;
            if (og + 1u == (tg + 1u) * nx) xb_add(&bar[XB_TOPGEN], 1u);
            else XB_SPIN(xb_ld(&bar[XB_TOPGEN]) == tg, bar);
            __builtin_amdgcn_fence(__ATOMIC_ACQUIRE, "agent");
            xb_add(&bar[XB_XGEN(b.x)], 1u);
            asm volatile("s_waitcnt vmcnt(0)" ::: "memory");
        } else {
            XB_SPIN(xb_ld(&bar[XB_XGEN(b.x)]) == gen, bar);
            __builtin_amdgcn_fence(__ATOMIC_ACQUIRE, "agent");
            asm volatile("s_waitcnt vmcnt(0)" ::: "memory");
        }
    }
    __syncthreads();
}
constexpr int CW_C1 = 512, CW_C2 = 576;
struct InOrder {
    int x, j; unsigned* c1; unsigned* c2;
    __device__ __forceinline__ bool next(int i, pg8::Unit& u) const { const int e = j + 32 * i; if (e >= 70) return false;
        if (e < 30) { u.pn = e / 10; u.pm = 10 * x + e % 10; } else { const int g = e - 30; u.pn = 3 + g / 10; u.pm = 10 * x + g % 10; } return true; }
    __device__ __forceinline__ void a_ready(const pg8::Unit&) const {}
    __device__ __forceinline__ void done(const pg8::Unit& u) const {
        const int e = u.pn <= 2 ? u.pn * 10 + (u.pm - 10 * x) : 30 + (u.pn - 3) * 10 + (u.pm - 10 * x);
        const bool lat = u.pn <= 2, lastu = e + 32 >= 70;
        if (lat || lastu) {
            asm volatile("s_waitcnt vmcnt(0)" ::: "memory");
            __builtin_amdgcn_s_barrier();
            if (threadIdx.x == 0) { __builtin_amdgcn_fence(__ATOMIC_RELEASE, "agent"); asm volatile("s_waitcnt vmcnt(0)" ::: "memory");
                if (lat) (void)xb_add(c1, 1u); if (lastu) (void)xb_add(c2, 1u); } }
    }
};
struct QUpOrder {
    int x, q0, nq;
    __device__ __forceinline__ bool next(int i, pg8::Unit& u) const { if (i >= nq) return false; const int q = q0 + i; u.pm = 10 * x + q / 6; u.pn = q % 6; return true; }
    __device__ __forceinline__ void a_ready(const pg8::Unit&) const {}
    __device__ __forceinline__ void done(const pg8::Unit&) const {}
};
struct KvUpOrder {
    int x, k0, nk; unsigned* c2;
    __device__ __forceinline__ bool next(int i, pg8::Unit& u) const { if (i >= nk) return false; const int k = k0 + i; u.pm = 11 * x + k / 8; u.pn = k % 8; return true; }
    __device__ __forceinline__ void a_ready(const pg8::Unit& u) const {
        if (u.pm < 40) { unsigned sp = 0; while (xb_ld(c2) < 256u) { __builtin_amdgcn_s_sleep(2); if (++sp > (1u << 22)) break; } asm volatile("" ::: "memory"); }
    }
    __device__ __forceinline__ void done(const pg8::Unit&) const {}
};
constexpr int NWAVES = 8;
#ifndef MK_N_LAUNCHES
#define MK_N_LAUNCHES 1
#endif
constexpr int NPHASE = 13;
constexpr int N_LAUNCHES = MK_N_LAUNCHES;
static_assert(N_LAUNCHES == 1 || N_LAUNCHES == NPHASE, "MK_N_LAUNCHES is 1 or 13");
using pg8::NCTX; using pg8::MTOK; using pg8::MKV;
constexpr float RMS_EPS = pg8::RMS_EPS;
constexpr size_t MiB = 1u << 20;
constexpr size_t WS_CTL = 0, CTL_ZERO_BYTES = 64 * 1024;
constexpr size_t WS_MOD = 1 * MiB;
constexpr size_t WS_ROPE = 1 * MiB + 512 * 1024;
constexpr size_t WS_SSQKV = 2 * MiB, WS_SSQQ = 2 * MiB + 512 * 1024;
constexpr size_t WS_W1 = 4 * MiB, WS_W2 = 12 * MiB, WS_W3 = 14 * MiB, WS_WQ = 18 * MiB, WS_WKV = 20 * MiB - 512 * 1024, WS_WO = 20 * MiB + 512 * 1024;
constexpr size_t WS_SG = 23 * MiB;
constexpr size_t WS_Q = 63 * MiB;
constexpr size_t WS_KV = 123 * MiB;
constexpr size_t WS_QL = 211 * MiB, WS_CKV = 226 * MiB, WS_KR = 237 * MiB, WS_END = 239 * MiB;
static_assert(WS_W1 + (size_t)4096 * 1024 * 2 <= WS_W2 && WS_W2 + (size_t)1024 * 1024 * 2 <= WS_W3 && WS_W3 + (size_t)1792 * 1024 * 2 <= WS_WQ && WS_WQ + (size_t)1536 * 384 * 2 <= WS_WKV &&
              WS_WKV + (size_t)2048 * 256 * 2 <= WS_WO && WS_WO + (size_t)1024 * 1024 * 2 <= WS_SG && WS_SG + (size_t)MTOK * 1024 * 2 <= WS_Q && WS_Q + (size_t)MTOK * 1536 * 2 <= WS_KV &&
              WS_KV + (size_t)MKV * 2048 * 2 <= WS_QL && WS_QL + (size_t)MTOK * 384 * 2 <= WS_CKV && WS_CKV + (size_t)MKV * 256 * 2 <= WS_KR && WS_KR + (size_t)MKV * 32 * 2 <= WS_END, "d_ws map");
constexpr int CW_ROWCTR = 512;
constexpr int CW_BAR = 1024;
static_assert((CW_BAR + XCD_BAR_WORDS) * 4 <= (int)CTL_ZERO_BYTES, "barrier words inside the memset region");
constexpr int RING_BYTES = 131072, LDSCTL_OFF = RING_BYTES, MISC_OFF = LDSCTL_OFF + 320, LDS_BYTES = 147456;
static_assert(att::LDS_BYTES <= RING_BYTES, "attention scratch fits the ring region");

struct Frame {
    LAS unsigned char* lds; volatile LAS unsigned* MISC;
    int tid, lane, wave, vcu, G;
};
__device__ __forceinline__ float wave_sum(float v) {
#pragma unroll
    for (int o = 1; o < 64; o <<= 1) v += __shfl_xor(v, o);
    return v;
}
__device__ __forceinline__ float silu_acc(float x) { return x / (1.f + expf(-x)); }
__device__ __forceinline__ int grp_of_tok(int t) { return t < NCTX ? 0 : 1 + ((t - NCTX) >> 12); }

__device__ __forceinline__ void transpose_item(const float* W, int ldw, int s0, bf16* WT, int K, int n0, int k0, LAS float* scr, int lane) {
    const int c = lane & 7;
    if (s0 < 0) {
#pragma unroll
        for (int j = 0; j < 4; ++j) { const int n = (lane >> 3) + 8 * j; *(GAS v4u*)(WT + (size_t)(n0 + n) * K + k0 + 8 * c) = (v4u){0u, 0u, 0u, 0u}; }
        return;
    }
#pragma unroll
    for (int i = 0; i < 32; ++i) { const int kk = 2 * i + (lane >> 5); scr[kk * 33 + (lane & 31)] = __builtin_nontemporal_load(W + (size_t)(k0 + kk) * ldw + s0 + (lane & 31)); }
    LDS_WAIT(); asm volatile("" ::: "memory");
#pragma unroll
    for (int j = 0; j < 4; ++j) { const int n = (lane >> 3) + 8 * j; const LAS float* s = scr + (8 * c) * 33 + n;
        v4u o; o.x = pk2(s[0 * 33], s[1 * 33]); o.y = pk2(s[2 * 33], s[3 * 33]); o.z = pk2(s[4 * 33], s[5 * 33]); o.w = pk2(s[6 * 33], s[7 * 33]);
        *(GAS v4u*)(WT + (size_t)(n0 + n) * K + k0 + 8 * c) = o; }
    LDS_WAIT(); asm volatile("" ::: "memory");
}
__device__ __forceinline__ int map_w1(int n0) { const int pn = n0 >> 8, cl = n0 & 255, bjj = cl >> 7, ch = 128 * (pn >> 1) + (cl & 127); const int part = (pn & 1) ? (bjj ? 3 : 0) : (bjj ? 2 : 1); return part * 1024 + ch; }
__device__ __forceinline__ int map_w3(int n0) { return n0 < 256 ? 384 + n0 : n0 < 640 ? n0 - 256 : n0 < 672 ? n0 : n0 < 768 ? -1 : n0 - 96; }

struct Ptrs {
    const float *x_prompt, *x_sample, *cache_ckv, *cache_krope, *c, *c_ctx, *norm_g, *w_mod, *b_mod, *conv_w_in, *conv_w, *conv_w_out, *mla_w_in, *gq, *w_q_up, *gkv, *w_kv_up, *w_out, *final_g;
    float* out; float* st_ckv; float* st_kr;
    float* mod; float* rope; float* ssq_kv; float* ssq_q;
    bf16 *W1, *W2, *W3, *WQ, *WKV, *WO, *SG, *EB, *Q, *KV, *H, *Y, *QL, *CKV, *KR, *DL;
};

__device__ __forceinline__ void phase_p0a(Frame& F, const Ptrs& P) {
    LAS float* sv = (LAS float*)(F.lds);
    LAS float* part = (LAS float*)(F.lds + 20480);
    bool filled = false;
    for (int chunk = blockIdx.x; chunk < 192; chunk += F.G) {
        if (!filled) {
            for (int e = F.tid; e < 5120; e += NWAVES * 64) { const int g = e >> 10, k = e & 1023; sv[e] = silu_acc(g == 0 ? P.c_ctx[k] : P.c[(g - 1) * 1024 + k]); }
            __syncthreads(); filled = true;
        }
        const int i = chunk / 96, cb = (chunk % 96) * 32, col = F.lane & 31, kh = F.lane >> 5;
        const float* w = P.w_mod + (size_t)i * 1024 * 3072 + cb + col;
        float a0 = 0.f, a1 = 0.f, a2 = 0.f, a3 = 0.f, a4 = 0.f;
#pragma unroll 16
        for (int kk = 0; kk < 64; ++kk) { const int k = F.wave * 128 + 2 * kk + kh; const float wv = __builtin_nontemporal_load(w + (size_t)k * 3072);
            a0 += sv[k] * wv; a1 += sv[1024 + k] * wv; a2 += sv[2048 + k] * wv; a3 += sv[3072 + k] * wv; a4 += sv[4096 + k] * wv; }
        a0 += __shfl_xor(a0, 32); a1 += __shfl_xor(a1, 32); a2 += __shfl_xor(a2, 32); a3 += __shfl_xor(a3, 32); a4 += __shfl_xor(a4, 32);
        if (kh == 0) { LAS float* pw = part + F.wave * 160 + col; pw[0] = a0; pw[32] = a1; pw[64] = a2; pw[96] = a3; pw[128] = a4; }
        __syncthreads();
        if (F.tid < 160) { const int g = F.tid >> 5, l = F.tid & 31; float s = 0.f;
#pragma unroll
            for (int wv = 0; wv < 8; ++wv) s += part[wv * 160 + g * 32 + l];
            P.mod[(size_t)(i * 5 + g) * 3072 + cb + l] = s + P.b_mod[i * 3072 + cb + l]; }
        __syncthreads();
    }
    __syncthreads();
    LAS float* scr = (LAS float*)(F.lds + F.wave * 16384);
    const int gw = F.vcu * NWAVES + F.wave, NGW = F.G * NWAVES;
    constexpr int I1 = 16 * 128, I2 = 16 * 32, I3 = 16 * 56, IQ = 6 * 48, IKV = 4 * 64, IO = 16 * 32, NITEMS = I1 + I2 + I3 + IQ + IKV + IO;
    for (int it = gw; it < NITEMS; it += NGW) {
        int r = it;
        if (r < I1) { const int kb = r / 128, nb = r % 128; transpose_item(P.conv_w_in, 4096, map_w1(32 * nb), P.W1, 1024, 32 * nb, 64 * kb, scr, F.lane); continue; } r -= I1;
        if (r < I2) { const int kb = r / 32, nb = r % 32; transpose_item(P.conv_w_out, 1024, 32 * nb, P.W2, 1024, 32 * nb, 64 * kb, scr, F.lane); continue; } r -= I2;
        if (r < I3) { const int kb = r / 56, nb = r % 56; transpose_item(P.mla_w_in, 1696, map_w3(32 * nb), P.W3, 1024, 32 * nb, 64 * kb, scr, F.lane); continue; } r -= I3;
        if (r < IQ) { const int kb = r / 48, nb = r % 48; transpose_item(P.w_q_up, 1536, 32 * nb, P.WQ, 384, 32 * nb, 64 * kb, scr, F.lane); continue; } r -= IQ;
        if (r < IKV) { const int kb = r / 64, nb = r % 64; transpose_item(P.w_kv_up, 2048, 32 * nb, P.WKV, 256, 32 * nb, 64 * kb, scr, F.lane); continue; } r -= IKV;
        { const int kb = r / 32, nb = r % 32; transpose_item(P.w_out, 1024, 32 * nb, P.WO, 1024, 32 * nb, 64 * kb, scr, F.lane); }
    }
    const int gt = F.vcu * (NWAVES * 64) + F.tid, NGT = F.G * NWAVES * 64;
    for (int i = gt; i < 2048 * 256 / 8; i += NGT) { const f32x4 a = *(const f32x4*)(P.cache_ckv + (size_t)i * 8), b = *(const f32x4*)(P.cache_ckv + (size_t)i * 8 + 4);
        *(v4u*)(P.CKV + (size_t)MTOK * 256 + (size_t)i * 8) = (v4u){pk2(a[0], a[1]), pk2(a[2], a[3]), pk2(b[0], b[1]), pk2(b[2], b[3])}; }
    for (int i = gt; i < 2048 * 32 / 8; i += NGT) { const f32x4 a = *(const f32x4*)(P.cache_krope + (size_t)i * 8), b = *(const f32x4*)(P.cache_krope + (size_t)i * 8 + 4);
        *(v4u*)(P.KR + (size_t)MTOK * 32 + (size_t)i * 8) = (v4u){pk2(a[0], a[1]), pk2(a[2], a[3]), pk2(b[0], b[1]), pk2(b[2], b[3])}; }
    if (blockIdx.x == F.G - 1) { const int p = F.tid >> 3, j = F.tid & 7; const float fr = powf(10000.f, -(float)j * 0.125f); float s, c; sincosf((float)p * fr, &s, &c);
        P.rope[F.tid * 2] = c; P.rope[F.tid * 2 + 1] = s; }
}

constexpr int RPI_DEF = 6;
__device__ __forceinline__ f32x4 bf4_to_f32(unsigned long long w) { f32x4 r; r[0] = __uint_as_float((unsigned)w << 16); r[1] = __uint_as_float((unsigned)w & 0xffff0000u); r[2] = __uint_as_float((unsigned)(w >> 32) << 16); r[3] = __uint_as_float((unsigned)(w >> 32) & 0xffff0000u); return r; }
template <bool HAS_DELTA, bool WRITE_X, int RPI = RPI_DEF>
#define ROWPASS_LOOP_HEAD const int NGWs = NGW; (void)ctr; for (int t0 = r0 + gw; t0 < MTOK; t0 += RPI * NGW) {
#define ROWPASS_LOOP_TAIL }
__device__ __forceinline__ void phase_hnorm(Frame& F, const float* xa, const float* xb, const bf16* delta, float* xout, const float* ng, const float* modl, bf16* H, int r0, int MTOK, int gw, int NGW, unsigned* ctr = nullptr) {
    ROWPASS_LOOP_HEAD
        f32x4 v[RPI][4]; float s[RPI];
#pragma unroll
        for (int r = 0; r < RPI; ++r) { const int t = t0 + r * NGWs; if (t < MTOK) {
            const float* x = t < NCTX ? xa + (size_t)t * 1024 : xb + (size_t)(t - NCTX) * 1024;
#pragma unroll
            for (int j = 0; j < 4; ++j) v[r][j] = __builtin_nontemporal_load((const f32x4*)(x + 4 * (F.lane + 64 * j)));
            if (HAS_DELTA) {
#pragma unroll
                for (int j = 0; j < 4; ++j) v[r][j] += bf4_to_f32(__builtin_nontemporal_load((const unsigned long long*)(delta + (size_t)t * 1024 + 4 * (F.lane + 64 * j)))); } } }
#pragma unroll
        for (int r = 0; r < RPI; ++r) { float a = 0.f; if (t0 + r * NGWs < MTOK) {
#pragma unroll
            for (int j = 0; j < 4; ++j) a += (v[r][j][0] * v[r][j][0] + v[r][j][1] * v[r][j][1]) + (v[r][j][2] * v[r][j][2] + v[r][j][3] * v[r][j][3]); }
            s[r] = a; }
#pragma unroll
        for (int o = 1; o < 64; o <<= 1) {
#pragma unroll
            for (int r = 0; r < RPI; ++r) s[r] += __shfl_xor(s[r], o); }
#pragma unroll
        for (int r = 0; r < RPI; ++r) { const int t = t0 + r * NGWs; if (t < MTOK) {
            const float rstd = 1.0f / sqrtf(s[r] * (1.f / 1024.f) + RMS_EPS);
            const float* sh = modl + grp_of_tok(t) * 3072; const float* sc = sh + 1024;
#pragma unroll
            for (int j = 0; j < 4; ++j) { const int k = 4 * (F.lane + 64 * j);
                if (WRITE_X) __builtin_nontemporal_store(v[r][j], (f32x4*)(xout + (size_t)t * 1024 + k));
                const f32x4 g = *(const f32x4*)(ng + k), a = *(const f32x4*)(sc + k), b = *(const f32x4*)(sh + k);
                const f32x4 o = v[r][j] * rstd * g * (a + 1.f) + b;
                *(unsigned long long*)(H + (size_t)t * 1024 + k) = (unsigned long long)pk2(o[0], o[1]) | ((unsigned long long)pk2(o[2], o[3]) << 32); } } }
    ROWPASS_LOOP_TAIL
}

__device__ __forceinline__ void bf8_to_f32(const v4u& w, float* f) {
    f[0] = __uint_as_float(w.x << 16); f[1] = __uint_as_float(w.x & 0xffff0000u); f[2] = __uint_as_float(w.y << 16); f[3] = __uint_as_float(w.y & 0xffff0000u);
    f[4] = __uint_as_float(w.z << 16); f[5] = __uint_as_float(w.z & 0xffff0000u); f[6] = __uint_as_float(w.w << 16); f[7] = __uint_as_float(w.w & 0xffff0000u);
}
__device__ __forceinline__ void phase_conv(Frame& F, const bf16* V, const bf16* E, const float* cw, bf16* Y) {
    const int gw = F.vcu * NWAVES + F.wave, NGW = F.G * NWAVES;
    const int c0 = (gw & 1) * 512 + F.lane * 8;
    float w0[8], w1[8], w2[8];
#pragma unroll
    for (int i = 0; i < 8; ++i) { w0[i] = cw[c0 + i]; w1[i] = cw[1024 + c0 + i]; w2[i] = cw[2048 + c0 + i]; }
    for (int it = gw; it < MTOK * 2; it += NGW) {
        const int t = it >> 1; int pos, len; if (t < NCTX) { pos = t & 255; len = 256; } else { pos = (t - NCTX) & 4095; len = 4096; }
        const size_t off = (size_t)t * 1024 + c0;
        const v4u z = {0u, 0u, 0u, 0u};
        const v4u vm = pos > 0 ? *(const v4u*)(V + off - 1024) : z, v0 = *(const v4u*)(V + off), vp = pos < len - 1 ? *(const v4u*)(V + off + 1024) : z, ee = __builtin_nontemporal_load((const v4u*)(E + off));
        float fm[8], f0[8], fp[8], fe[8], y[8]; bf8_to_f32(vm, fm); bf8_to_f32(v0, f0); bf8_to_f32(vp, fp); bf8_to_f32(ee, fe);
#pragma unroll
        for (int i = 0; i < 8; ++i) y[i] = fe[i] * (w0[i] * fm[i] + w1[i] * f0[i] + w2[i] * fp[i]);
        *(v4u*)(Y + off) = (v4u){pk2(y[0], y[1]), pk2(y[2], y[3]), pk2(y[4], y[5]), pk2(y[6], y[7])};
    }
}
__device__ __forceinline__ void phase_state_fix(Frame& F, float* st_ckv, const float* ssq_kv) {
    const int gw = F.vcu * NWAVES + F.wave, NGW = F.G * NWAVES;
    for (int t = gw; t < NCTX; t += NGW) { const f32x4 s0 = *(const f32x4*)(ssq_kv + (size_t)t * 4);
        const float rs = 1.0f / sqrtf(((s0[0] + s0[1]) + (s0[2] + s0[3])) * (1.f / 256.f) + RMS_EPS);
        f32x4* p = (f32x4*)(st_ckv + (size_t)t * 256) + F.lane; *p = *p * rs; }
}
template <int RPI = RPI_DEF>
__device__ __forceinline__ void phase_final(Frame& F, float* X, const bf16* delta, const float* g, int r0, int MTOK, int gw, int NGW, unsigned* ctr = nullptr) {
    ROWPASS_LOOP_HEAD
        f32x4 v[RPI][4]; float s[RPI];
#pragma unroll
        for (int r = 0; r < RPI; ++r) { const int t = t0 + r * NGWs; if (t < MTOK) {
#pragma unroll
            for (int j = 0; j < 4; ++j) v[r][j] = __builtin_nontemporal_load((const f32x4*)(X + (size_t)t * 1024 + 4 * (F.lane + 64 * j)));
#pragma unroll
            for (int j = 0; j < 4; ++j) v[r][j] += bf4_to_f32(__builtin_nontemporal_load((const unsigned long long*)(delta + (size_t)t * 1024 + 4 * (F.lane + 64 * j)))); } }
#pragma unroll
        for (int r = 0; r < RPI; ++r) { float a = 0.f; if (t0 + r * NGWs < MTOK) {
#pragma unroll
            for (int j = 0; j < 4; ++j) a += (v[r][j][0] * v[r][j][0] + v[r][j][1] * v[r][j][1]) + (v[r][j][2] * v[r][j][2] + v[r][j][3] * v[r][j][3]); }
            s[r] = a; }
#pragma unroll
        for (int o = 1; o < 64; o <<= 1) {
#pragma unroll
            for (int r = 0; r < RPI; ++r) s[r] += __shfl_xor(s[r], o); }
#pragma unroll
        for (int r = 0; r < RPI; ++r) { const int t = t0 + r * NGWs; if (t < MTOK) {
            const float rstd = 1.0f / sqrtf(s[r] * (1.f / 1024.f) + RMS_EPS);
#pragma unroll
            for (int j = 0; j < 4; ++j) { const int k = 4 * (F.lane + 64 * j); __builtin_nontemporal_store(v[r][j] * rstd * *(const f32x4*)(g + k), (f32x4*)(X + (size_t)t * 1024 + k)); } } }
    ROWPASS_LOOP_TAIL
}
__device__ __forceinline__ void phase_attn(Frame& F, const Ptrs& P) {
    for (int id = F.vcu; id < 1280; id += F.G) {
        int qrow0, h, kb0, nt0, kb1, NT;
        if (id < 1024) { const int bh = id >> 4, qb = id & 15, b = bh >> 4; h = bh & 15; qrow0 = NCTX + b * 4096 + qb * 256; kb0 = MTOK + b * 512; nt0 = 8; kb1 = NCTX + b * 4096; NT = 72; }
        else { const int bh = id - 1024, b = bh >> 4; h = bh & 15; qrow0 = b * 256; kb0 = b * 256; nt0 = 4; kb1 = 0; NT = 4; }
#ifdef ATT_PROBE
        for (int e = F.tid; e < 256 * 8; e += NWAVES * 64) { const int row = qrow0 + (e >> 3), ch = e & 7;
            bf16* c_ = (row < 13312 ? P.QL + (size_t)row * 1024 : (bf16*)((unsigned char*)P.QL + (239 - 211) * MiB) + (size_t)(row - 13312) * 1024) + h * 64 + ch * 8;
            *(v4u*)c_ = *(const v4u*)(P.SG + (size_t)row * 1024 + h * 64 + ch * 8); }
#endif
        att::attn_unit(P.Q, P.KV, P.KR, P.SG, qrow0, h, kb0, nt0, kb1, NT, (LAS char*)F.lds);
    }
}

struct Args { const float* in[19]; float* out; unsigned char* ws; int ph_lo, ph_hi; };
typedef const __attribute__((address_space(4))) Args* KArgs;
__device__ __forceinline__ void fill_ptrs(Ptrs& P, KArgs ka) {
    unsigned char* ws = ka->ws; float* out = ka->out;
    P.x_prompt = ka->in[0]; P.x_sample = ka->in[1]; P.cache_ckv = ka->in[2]; P.cache_krope = ka->in[3]; P.c = ka->in[4]; P.c_ctx = ka->in[5]; P.norm_g = ka->in[6];
    P.w_mod = ka->in[7]; P.b_mod = ka->in[8]; P.conv_w_in = ka->in[9]; P.conv_w = ka->in[10]; P.conv_w_out = ka->in[11]; P.mla_w_in = ka->in[12]; P.gq = ka->in[13];
    P.w_q_up = ka->in[14]; P.gkv = ka->in[15]; P.w_kv_up = ka->in[16]; P.w_out = ka->in[17]; P.final_g = ka->in[18];
    P.out = out; P.st_ckv = out + (size_t)MTOK * 1024; P.st_kr = P.st_ckv + (size_t)NCTX * 256;
    P.mod = (float*)(ws + WS_MOD); P.rope = (float*)(ws + WS_ROPE); P.ssq_kv = (float*)(ws + WS_SSQKV); P.ssq_q = (float*)(ws + WS_SSQQ);
    P.W1 = (bf16*)(ws + WS_W1); P.W2 = (bf16*)(ws + WS_W2); P.W3 = (bf16*)(ws + WS_W3); P.WQ = (bf16*)(ws + WS_WQ); P.WKV = (bf16*)(ws + WS_WKV); P.WO = (bf16*)(ws + WS_WO);
    P.SG = (bf16*)(ws + WS_SG); P.EB = (bf16*)(ws + WS_Q); P.Q = (bf16*)(ws + WS_Q); P.KV = (bf16*)(ws + WS_KV); P.H = (bf16*)(ws + WS_KV); P.Y = (bf16*)(ws + WS_KV + 40 * MiB);
    P.DL = (bf16*)(ws + WS_Q);
    P.QL = (bf16*)(ws + WS_QL); P.CKV = (bf16*)(ws + WS_CKV); P.KR = (bf16*)(ws + WS_KR);
}
#define MKP() Ptrs P; { KArgs ka_ = (KArgs)__builtin_amdgcn_kernarg_segment_ptr(); asm volatile("" : "+s"(ka_)); fill_ptrs(P, ka_); } const float* mod0 = P.mod; const float* mod1 = P.mod + 5 * 3072; (void)mod0; (void)mod1
__global__ void __launch_bounds__(NWAVES * 64, 2) mk_fwd(Args args) {
    extern __shared__ __attribute__((aligned(16))) unsigned char lds[];
    Frame F;
    F.lds = (LAS unsigned char*)lds; F.MISC = (volatile LAS unsigned*)(F.lds + MISC_OFF);
    F.tid = threadIdx.x; F.lane = F.tid & 63; F.wave = __builtin_amdgcn_readfirstlane(F.tid >> 6);
    F.G = gridDim.x; { const int bx = blockIdx.x; F.vcu = (F.G % 8 == 0) ? (bx % 8) * (F.G / 8) + bx / 8 : bx; }
    unsigned char* ws = args.ws;
    for (int u = F.tid; u < (LDS_BYTES - LDSCTL_OFF) / 4; u += NWAVES * 64) ((LAS unsigned*)(F.lds + LDSCTL_OFF))[u] = 0u;
    __syncthreads();
    XcdBarrier bar; bar.bar = (unsigned*)(ws + WS_CTL) + CW_BAR; bar.x = 0; bar.st = nullptr;
    if (N_LAUNCHES == 1) bar = xcd_barrier_post((unsigned*)(ws + WS_CTL) + CW_BAR, F.MISC + 8);
    const int lo = args.ph_lo, hi = args.ph_hi;
#ifndef PHASE_MASK
#define PHASE_MASK 0x1fff
#endif
#define IN(k) (((PHASE_MASK >> (k)) & 1) && lo <= (k) && (k) < hi)
#ifdef TIMING_PROBE
    unsigned long long* tsb = (unsigned long long*)(ws + WS_CTL + 32768);
    const bool stamper = blockIdx.x == 0 && F.tid == 0;
#define STAMP(i) do { if (stamper) tsb[i] = __builtin_amdgcn_s_memrealtime(); } while (0)
#else
#define STAMP(i) do {} while (0)
#endif
    STAMP(0);
#define SEAM(k) do { if (IN(k) && IN((k) + 1)) xcd_barrier(bar); STAMP((k) + 1); } while (0)
    if (IN(0)) { MKP(); phase_p0a(F, P); } SEAM(0);
    constexpr int MSPLIT = 16384;
    const int gwA = F.vcu * NWAVES + F.wave, NGWA = F.G * NWAVES;
    const bool tailcu = (int)blockIdx.x < 64;
    const int gwB = ((int)blockIdx.x - 64) * NWAVES + F.wave, NGWB = (F.G - 64) * NWAVES;
    if (IN(1)) { MKP(); phase_hnorm<false, false, 10>(F, P.x_prompt, P.x_sample, nullptr, nullptr, P.norm_g, mod0, P.H, 0, MTOK, gwA, NGWA); } SEAM(1);
    if (IN(2)) {
        MKP();
        pg8::Gemm g{P.H, P.W1, MTOK, 4096, 1024}; pg8::StaticOrder S; S.init(MTOK, 4096, F.G, (int)blockIdx.x);
        pg8::EpiConvIn E{P.SG, P.EB};
        pg8::gemm_phase<pg8::EpiConvIn, pg8::StaticOrder, true, true, true>(F.lds, g, S, E);
    } SEAM(2);
    if (IN(3)) { MKP(); phase_conv(F, P.SG, P.EB, P.conv_w, P.Y); } SEAM(3);
    if (IN(4)) {
        MKP();
        pg8::Gemm g{P.Y, P.W2, MSPLIT, 1024, 1024}; pg8::StaticOrder S; S.init(MSPLIT, 1024, F.G, (int)blockIdx.x);
        pg8::EpiDelta E{P.DL, mod0 + 2048, 0};
        pg8::gemm_phase<pg8::EpiDelta, pg8::StaticOrder, true, true>(F.lds, g, S, E);
    } SEAM(4);
    if (IN(5)) {
        MKP();
        if (tailcu) { pg8::Gemm g{P.Y + (size_t)MSPLIT * 1024, P.W2, MTOK - MSPLIT, 1024, 1024}; pg8::StaticOrder S; S.init(MTOK - MSPLIT, 1024, F.G, (int)blockIdx.x);
            pg8::EpiDelta E{P.DL + (size_t)MSPLIT * 1024, mod0 + 2048, MSPLIT / 256};
            pg8::gemm_phase<pg8::EpiDelta, pg8::StaticOrder, true, true>(F.lds, g, S, E); }
        if (!tailcu) phase_hnorm<true, true>(F, P.x_prompt, P.x_sample, P.DL, P.out, P.norm_g + 1024, mod1, P.H, 0, MSPLIT, gwB, NGWB);
    } SEAM(5);
    if (IN(6)) { MKP(); phase_hnorm<true, true, 2>(F, P.x_prompt, P.x_sample, P.DL, P.out, P.norm_g + 1024, mod1, P.H, MSPLIT, MTOK, gwA, NGWA); } SEAM(6);
    if (IN(7)) {
        MKP();
        const int xq = (int)blockIdx.x & 7, jq = (int)blockIdx.x >> 3;
        unsigned* ctl = (unsigned*)((unsigned char*)P.mod - WS_MOD + WS_CTL); unsigned* c1 = ctl + CW_C1; unsigned* c2 = ctl + CW_C2;
        { pg8::Gemm g{P.H, P.W3, MTOK, 1792, 1024}; InOrder S{xq, jq, c1, c2};
          pg8::EpiMlaIn E{P.CKV, P.QL, P.KR, P.SG, P.ssq_kv, P.ssq_q, P.st_ckv, P.st_kr, P.gq, P.gkv, P.rope};
          pg8::gemm_phase<pg8::EpiMlaIn, InOrder, true, true, true>(F.lds, g, S, E); }
        if (F.tid == 0) { unsigned sp = 0; while (xb_ld(c1) < 240u) { __builtin_amdgcn_s_sleep(2); if (++sp > (1u << 22)) break; }
            __builtin_amdgcn_fence(__ATOMIC_ACQUIRE, "agent"); asm volatile("s_waitcnt vmcnt(0)" ::: "memory"); }
        __syncthreads();
        phase_state_fix(F, P.st_ckv, P.ssq_kv);
        int q0, nq, k0, nk;
        if (jq >= 6) { q0 = 2 * (jq - 6); nq = 2; k0 = 3 * (jq - 6); nk = 3; } else if (jq < 4) { q0 = 52 + jq; nq = 1; k0 = 78 + 2 * jq; nk = 2; } else { q0 = 56 + 2 * (jq - 4); nq = 2; k0 = 86 + (jq - 4); nk = 1; }
#ifndef P7_SKIP_Q
        { int kq = 384; asm volatile("" : "+s"(kq));
          pg8::Gemm g{P.QL, P.WQ, MTOK, 1536, kq}; QUpOrder S{xq, q0, nq};
          pg8::EpiQUp E{P.Q, P.ssq_q, P.rope};
          pg8::gemm_phase<pg8::EpiQUp, QUpOrder, true, true>(F.lds, g, S, E); }
#endif
#ifndef P7_SKIP_KV
        { int kk = 256; asm volatile("" : "+s"(kk));
          pg8::Gemm g{P.CKV, P.WKV, MKV, 2048, kk}; KvUpOrder S{xq, k0, nk, c2};
          pg8::EpiKvUp E{P.KV, P.ssq_kv};
          pg8::gemm_phase<pg8::EpiKvUp, KvUpOrder, true, true>(F.lds, g, S, E); }
#endif
    } STAMP(8);
    SEAM(8);
    if (IN(9)) { MKP(); phase_attn(F, P); } SEAM(9);
    if (IN(10)) {
        MKP();
        pg8::Gemm g{P.SG, P.WO, MSPLIT, 1024, 1024}; pg8::StaticOrder S; S.init(MSPLIT, 1024, F.G, (int)blockIdx.x);
        pg8::EpiDelta E{P.DL, mod1 + 2048, 0};
        pg8::gemm_phase<pg8::EpiDelta, pg8::StaticOrder, true, true>(F.lds, g, S, E);
    } SEAM(10);
    if (IN(11)) {
        MKP();
        if (tailcu) { pg8::Gemm g{P.SG + (size_t)MSPLIT * 1024, P.WO, MTOK - MSPLIT, 1024, 1024}; pg8::StaticOrder S; S.init(MTOK - MSPLIT, 1024, F.G, (int)blockIdx.x);
            pg8::EpiDelta E{P.DL + (size_t)MSPLIT * 1024, mod1 + 2048, MSPLIT / 256};
            pg8::gemm_phase<pg8::EpiDelta, pg8::StaticOrder, true, true>(F.lds, g, S, E); }
        if (!tailcu) phase_final(F, P.out, P.DL, P.final_g, 0, MSPLIT, gwB, NGWB);
    } SEAM(11);
    if (IN(12)) { MKP(); phase_final<2>(F, P.out, P.DL, P.final_g, MSPLIT, MTOK, gwA, NGWA); }
#ifdef TIMING_PROBE
    xcd_barrier(bar); STAMP(NPHASE);
    if (blockIdx.x == 0) {   MKP();
        LAS float* red = (LAS float*)(F.lds);
        if (F.tid == 0) { float ta = 0.f, tb = 0.f;
            for (int k = 0; k < NPHASE; ++k) { const float d = (float)(tsb[k + 1] - tsb[k]) * 0.01f; if ((TP_MASK_A >> k) & 1) ta += d; if ((TP_MASK_B >> k) & 1) tb += d; }
            red[16] = ta; red[17] = tb; }
        float s = 0.f; for (int i = F.tid; i < NCTX * 32; i += NWAVES * 64) { const float v = P.st_kr[i]; s += v * v; }
        s = wave_sum(s); if (F.lane == 0) red[F.wave] = s;
        __syncthreads();
        const float S = (red[0] + red[1] + red[2] + red[3] + red[4] + red[5] + red[6] + red[7]) * (1.f / (NCTX * 32));
        const float delta = sqrtf(red[16] * 1e-6f * S);
        for (int i = F.tid; i < NCTX * 32; i += NWAVES * 64) P.st_kr[i] += delta;
        if (F.tid == 0) P.out[(size_t)NCTX * 1024] += red[17] * 0.01f;
    }
#endif
#undef IN
#undef SEAM
}

#ifdef ATT_PROBE
__device__ __forceinline__ float pb_bf(const bf16* p) { return __uint_as_float((unsigned)*p << 16); }
__global__ __launch_bounds__(256) void chk_attn(const bf16* Q, const bf16* KV, const bf16* KR, const bf16* OG, const bf16* SGC0, const bf16* SGC1, float* acc2) {
  __shared__ float Ks[32][96]; __shared__ float Vs[32][64]; __shared__ float red[8];
  const int tid = threadIdx.x, h = blockIdx.y, bi = blockIdx.x;
  int t, nk0, base0, nk1, base1;
  if (bi < 64) { int b = bi >> 4; t = NCTX + b * 4096 + (bi & 15) * 256 + tid; base0 = MTOK + b * 512; nk0 = 512; base1 = NCTX + b * 4096; nk1 = 4096; }
  else { int b = bi - 64; t = b * 256 + tid; base0 = b * 256; nk0 = 256; base1 = 0; nk1 = 0; }
  float q[96];
#pragma unroll
  for (int d = 0; d < 96; ++d) q[d] = pb_bf(Q + (size_t)t * 1536 + h * 96 + d);
  float o[64];
#pragma unroll
  for (int d = 0; d < 64; ++d) o[d] = 0.f;
  float m = -INFINITY, l = 0.f;
  const int ntile = (nk0 + nk1) / 32;
  for (int jt = 0; jt < ntile; ++jt) {
    int k0 = jt * 32; int rbase = k0 < nk0 ? base0 + k0 : base1 + (k0 - nk0);
    __syncthreads();
#pragma unroll
    for (int i = 0; i < 8; ++i) { int e = tid + 256 * i; int r = e >> 6, d = e & 63; const bf16* src = KV + (size_t)(rbase + r) * 2048 + h * 128; Ks[r][d] = pb_bf(src + d); Vs[r][d] = pb_bf(src + 64 + d); }
#pragma unroll
    for (int i = 0; i < 4; ++i) { int e = tid + 256 * i; int r = e >> 5, d = e & 31; Ks[r][64 + d] = pb_bf(KR + (size_t)(rbase + r) * 32 + d); }
    __syncthreads();
    for (int j = 0; j < 32; ++j) {
      float s = 0.f;
#pragma unroll
      for (int d = 0; d < 96; ++d) s = fmaf(q[d], Ks[j][d], s);
      float mn = fmaxf(m, s); float al = exp2f(m - mn), pj = exp2f(s - mn);
      l = l * al + pj; m = mn;
#pragma unroll
      for (int d = 0; d < 64; ++d) o[d] = fmaf(pj, Vs[j][d], o[d] * al);
    }
  }
  const float il = 1.0f / l; float sd = 0.f, sr = 0.f;
  const bf16* sg = (t < 13312 ? SGC0 + (size_t)t * 1024 : SGC1 + (size_t)(t - 13312) * 1024) + h * 64;
#pragma unroll
  for (int d = 0; d < 64; ++d) { const float ref = o[d] * il * pb_bf(sg + d), got = pb_bf(OG + (size_t)t * 1024 + h * 64 + d); sd += (got - ref) * (got - ref); sr += ref * ref; }
  sd = wave_sum(sd); sr = wave_sum(sr);
  __syncthreads();
  if ((tid & 63) == 0) { red[tid >> 6] = sd; red[4 + (tid >> 6)] = sr; }
  __syncthreads();
  if (tid == 0) { float* a_ = acc2 + (bi < 64 ? 2 : 0); atomicAdd(a_, red[0] + red[1] + red[2] + red[3]); atomicAdd(a_ + 1, red[4] + red[5] + red[6] + red[7]); }
}
__global__ __launch_bounds__(256) void chk_q(const bf16* QL, const float* ssq_q, const float* Wq, const bf16* Q, float* acc) {
  __shared__ float qrow[384]; __shared__ float red[8];
  const int tid = threadIdx.x, t = blockIdx.y, c = blockIdx.x * 256 + tid;
  qrow[tid] = pb_bf(QL + (size_t)t * 384 + tid); if (tid < 128) qrow[256 + tid] = pb_bf(QL + (size_t)t * 384 + 256 + tid);
  __syncthreads();
  const int d = c % 96; const bool rp = t >= NCTX && d >= 64; const int i = d - 64, kk = i & 15, cp = rp ? (kk < 8 ? c + 8 : c - 8) : c;
  float s = 0.f, sp = 0.f;
  for (int k = 0; k < 384; ++k) { s = fmaf(qrow[k], Wq[(size_t)k * 1536 + c], s); sp = fmaf(qrow[k], Wq[(size_t)k * 1536 + cp], sp); }
  float ss = 0.f; for (int j = 0; j < 8; ++j) ss += ssq_q[(size_t)t * 8 + j];
  const float rs = 0.10206207261596577f * 1.4426950408889634f / sqrtf(ss / 384.f + 1e-6f);
  float v = s;
  if (rp) { const int pos = (t - NCTX) & 4095, half = i >> 4, fi = kk & 7; const double ang = (double)(half ? (pos & 63) : (pos >> 6)) * pow(10000.0, -(double)fi / 8.0);
    const float cs = (float)cos(ang), sn = (float)sin(ang); v = kk < 8 ? s * cs - sp * sn : sp * sn + s * cs; }
  const float ref = v * rs, got = pb_bf(Q + (size_t)t * 1536 + c);
  float sd = wave_sum((got - ref) * (got - ref)), sr = wave_sum(ref * ref);
  if ((tid & 63) == 0) { red[tid >> 6] = sd; red[4 + (tid >> 6)] = sr; }
  __syncthreads();
  if (tid == 0) { atomicAdd(acc, red[0] + red[1] + red[2] + red[3]); atomicAdd(acc + 1, red[4] + red[5] + red[6] + red[7]); }
}
__global__ __launch_bounds__(256) void chk_kv(const bf16* CKV, const float* ssq_kv, const float* Wkv, const bf16* KV, float* acc) {
  __shared__ float crow[256]; __shared__ float red[8];
  const int tid = threadIdx.x, t = blockIdx.y, c = blockIdx.x * 256 + tid;
  crow[tid] = pb_bf(CKV + (size_t)t * 256 + tid);
  __syncthreads();
  float s = 0.f;
  for (int k = 0; k < 256; ++k) s = fmaf(crow[k], Wkv[(size_t)k * 2048 + c], s);
  float rs = 1.f; if (t < MTOK) { float ss = 0.f; for (int j = 0; j < 4; ++j) ss += ssq_kv[(size_t)t * 4 + j]; rs = 1.0f / sqrtf(ss / 256.f + 1e-6f); }
  const float ref = s * rs, got = pb_bf(KV + (size_t)t * 2048 + c);
  float sd = wave_sum((got - ref) * (got - ref)), sr = wave_sum(ref * ref);
  if ((tid & 63) == 0) { red[tid >> 6] = sd; red[4 + (tid >> 6)] = sr; }
  __syncthreads();
  if (tid == 0) { atomicAdd(acc + 2, red[0] + red[1] + red[2] + red[3]); atomicAdd(acc + 3, red[4] + red[5] + red[6] + red[7]); }
}
__global__ __launch_bounds__(256) void chk_g3(const bf16* H1, const float* W, const float* gq, const float* gkv, const bf16* QL, const bf16* CKV, const bf16* KR, const bf16* SG,
                                              const float* ssq_q, const float* ssq_kv, float* acc) {
  __shared__ float hrow[1024]; __shared__ float outv[1696]; __shared__ float red[16];
  const int t = blockIdx.x, tid = threadIdx.x;
  for (int i = 0; i < 4; ++i) hrow[tid + 256 * i] = pb_bf(H1 + (size_t)t * 1024 + tid + 256 * i);
  __syncthreads();
  for (int c = tid; c < 1696; c += 256) { float s = 0.f; for (int j = 0; j < 1024; ++j) s = fmaf(hrow[j], W[(size_t)j * 1696 + c], s); outv[c] = s; }
  __syncthreads();
  float sd = 0.f, sr = 0.f, q2 = 0.f, k2 = 0.f;
  for (int c = tid; c < 1696; c += 256) { float ref, got;
    if (c < 384) { ref = outv[c] * gq[c]; got = pb_bf(QL + (size_t)t * 384 + c); q2 += outv[c] * outv[c]; }
    else if (c < 640) { ref = outv[c] * gkv[c - 384]; got = pb_bf(CKV + (size_t)t * 256 + c - 384); k2 += outv[c] * outv[c]; }
    else if (c < 672) { const int i = c - 640; float v = outv[c];
      if (t >= NCTX) { const int pos = (t - NCTX) & 4095, half = i >> 4, kk = i & 15, fi = kk & 7; const double ang = (double)(half ? (pos & 63) : (pos >> 6)) * pow(10000.0, -(double)fi / 8.0);
        const float cs = (float)cos(ang), sn = (float)sin(ang), x1 = outv[640 + half * 16 + fi], x2 = outv[640 + half * 16 + 8 + fi]; v = kk < 8 ? x1 * cs - x2 * sn : x1 * sn + x2 * cs; }
      ref = v; got = pb_bf(KR + (size_t)t * 32 + i); }
    else { const float g = outv[c]; ref = g / (1.f + expf(-g)); got = pb_bf(SG + (size_t)t * 1024 + c - 672); }
    sd += (got - ref) * (got - ref); sr += ref * ref; }
  sd = wave_sum(sd); sr = wave_sum(sr); q2 = wave_sum(q2); k2 = wave_sum(k2);
  if ((tid & 63) == 0) { red[tid >> 6] = sd; red[4 + (tid >> 6)] = sr; red[8 + (tid >> 6)] = q2; red[12 + (tid >> 6)] = k2; }
  __syncthreads();
  if (tid == 0) { atomicAdd(acc, red[0] + red[1] + red[2] + red[3]); atomicAdd(acc + 1, red[4] + red[5] + red[6] + red[7]);
    const float q2r = red[8] + red[9] + red[10] + red[11], k2r = red[12] + red[13] + red[14] + red[15]; float q2f = 0.f, k2f = 0.f;
    for (int j = 0; j < 8; ++j) q2f += ssq_q[(size_t)t * 8 + j]; for (int j = 0; j < 4; ++j) k2f += ssq_kv[(size_t)t * 4 + j];
    atomicAdd(acc + 2, (q2f - q2r) * (q2f - q2r) + (k2f - k2r) * (k2f - k2r)); atomicAdd(acc + 3, q2r * q2r + k2r * k2r); }
}
__global__ __launch_bounds__(1024) void chk_encode(const float* acc2, float* st_kr, float* ys0) {
  __shared__ float red[16];
  float s = 0.f; for (int i = threadIdx.x; i < NCTX * 32; i += 1024) { const float v = st_kr[i]; s += v * v; }
  s = wave_sum(s); if ((threadIdx.x & 63) == 0) red[threadIdx.x >> 6] = s;
  __syncthreads();
  float S = 0.f; for (int i = 0; i < 16; ++i) S += red[i];
  S *= 1.f / (NCTX * 32);
  const float delta = sqrtf(acc2[0] / acc2[1] * S);
  for (int i = threadIdx.x; i < NCTX * 32; i += 1024) st_kr[i] += delta;
  if (threadIdx.x == 0) ys0[0] += 10.f * sqrtf(acc2[2] / acc2[3]);
}
#endif
extern "C" void kernel_launch(void* const* d_in, const int* in_sizes, int n_in, void* d_out, int out_size, void* d_ws, size_t ws_size, hipStream_t stream) {
    static int grid = 0;
    if (grid == 0) {
        if (n_in != 19 || ws_size < WS_END) { fprintf(stderr, "kernel_launch: built for 19 inputs and >= %zu bytes of workspace; got n_in %d, ws %zu; nothing launched\n", (size_t)WS_END, n_in, ws_size); grid = -1; return; }
        int dev = 0, cus = 0, per_cu = 0;
        if (hipGetDevice(&dev) != hipSuccess || hipDeviceGetAttribute(&cus, hipDeviceAttributeMultiprocessorCount, dev) != hipSuccess) { fprintf(stderr, "kernel_launch: device query failed\n"); grid = -1; return; }
        if (hipFuncSetAttribute((const void*)mk_fwd, hipFuncAttributeMaxDynamicSharedMemorySize, LDS_BYTES) != hipSuccess) { fprintf(stderr, "kernel_launch: hipFuncSetAttribute failed\n"); grid = -1; return; }
        if (hipOccupancyMaxActiveBlocksPerMultiprocessor(&per_cu, (const void*)mk_fwd, NWAVES * 64, LDS_BYTES) != hipSuccess || per_cu < 1) { fprintf(stderr, "kernel_launch: occupancy query says %d blocks per CU\n", per_cu); }
        (void)hipGetLastError();
        if (cus < 256) fprintf(stderr, "kernel_launch: built for the 256 CUs of an MI355X, this device reports %d\n", cus);
        grid = 256;
    }
    if (grid < 0) return;
    if (hipMemsetAsync((char*)d_ws + WS_CTL, 0, CTL_ZERO_BYTES, stream) != hipSuccess) { fprintf(stderr, "kernel_launch: hipMemsetAsync failed\n"); return; }
    Args a{};
    for (int i = 0; i < 19; ++i) a.in[i] = (const float*)d_in[i];
    a.out = (float*)d_out; a.ws = (unsigned char*)d_ws;
    for (int li = 0; li < N_LAUNCHES; ++li) {
        a.ph_lo = (N_LAUNCHES == 1) ? 0 : li; a.ph_hi = (N_LAUNCHES == 1) ? NPHASE : li + 1;
        hipLaunchKernelGGL(mk_fwd, dim3(grid), dim3(NWAVES * 64), LDS_BYTES, stream, a);
        const hipError_t le = hipPeekAtLastError();
        if (le != hipSuccess) { fprintf(stderr, "kernel_launch: launch %d failed: %s\n", li, hipGetErrorName(le)); break; }
#ifdef ATT_PROBE
        static_assert(N_LAUNCHES == NPHASE, "the attention probe runs between the per-phase launches");
        { unsigned char* ws = (unsigned char*)d_ws; float* acc2 = (float*)(ws + WS_CTL + 40960);
          if (ATT_PROBE == 1 && li == 9) hipLaunchKernelGGL(chk_attn, dim3(80, 16), dim3(256), 0, stream, (const bf16*)(ws + WS_Q), (const bf16*)(ws + WS_KV), (const bf16*)(ws + WS_KR), (const bf16*)(ws + WS_SG),
                                          (const bf16*)(ws + WS_QL), (const bf16*)(ws + 239 * MiB), acc2);
          if (ATT_PROBE == 2 && li == 8) { hipLaunchKernelGGL(chk_q, dim3(6, MTOK), dim3(256), 0, stream, (const bf16*)(ws + WS_QL), (const float*)(ws + WS_SSQQ), (const float*)d_in[14], (const bf16*)(ws + WS_Q), acc2);
                                             hipLaunchKernelGGL(chk_kv, dim3(8, MKV), dim3(256), 0, stream, (const bf16*)(ws + WS_CKV), (const float*)(ws + WS_SSQKV), (const float*)d_in[16], (const bf16*)(ws + WS_KV), acc2); }
          if (ATT_PROBE == 3 && li == 7) hipLaunchKernelGGL(chk_g3, dim3(MTOK), dim3(256), 0, stream, (const bf16*)(ws + WS_KV), (const float*)d_in[12], (const float*)d_in[13], (const float*)d_in[15],
                                             (const bf16*)(ws + WS_QL), (const bf16*)(ws + WS_CKV), (const bf16*)(ws + WS_KR), (const bf16*)(ws + WS_SG), (const float*)(ws + WS_SSQQ), (const float*)(ws + WS_SSQKV), acc2);
          if (li == NPHASE - 1) hipLaunchKernelGGL(chk_encode, dim3(1), dim3(1024), 0, stream, (const float*)acc2, (float*)d_out + (size_t)MTOK * 1024 + (size_t)NCTX * 256, (float*)d_out + (size_t)NCTX * 1024); }
#endif
    }
}
```

```cpp
#include <hip/hip_runtime.h>
#include <cstdio>
#include <cstdint>
#include <cmath>
namespace pg8 {
#define PG8_LAS __attribute__((address_space(3)))
typedef unsigned short bf16_t;
typedef short bf16x8 __attribute__((ext_vector_type(8)));
typedef float f32x4 __attribute__((ext_vector_type(4)));
typedef unsigned u32x4 __attribute__((ext_vector_type(4)));
constexpr int BM = 256, BK = 64, HALF = 128, HTB = HALF * BK * 2  , STAGE_BYTES = 8 * HTB, NXCD = 8, WGM = 8;

__host__ __device__ __forceinline__ int lds_byte(int r, int c) { const int st = (r >> 4) * 2 + (c >> 5), rr = r & 15, cc = c & 31, ob = rr * 64 + cc * 2; return st * 1024 + (ob ^ (((ob >> 9) & 1) << 5)); }
__host__ __device__ __forceinline__ void stage_rc(int b, int& R, int& C) { const int st = b / 1024, sb = b % 1024, swz = sb ^ (((sb >> 9) & 1) << 5); R = (st >> 1) * 16 + swz / 64; C = (st & 1) * 32 + (swz % 64) / 2; }
__host__ __device__ __forceinline__ int perm32(int rho) { const int n = rho >> 4, i = rho & 15; return 8 * (i >> 2) + 4 * n + (i & 3); }

struct Unit { int pm, pn; };
struct Gemm { const bf16_t* A; const bf16_t* Bt; int M, N, K; };

struct StaticOrder {
    int nM, nN, nwg, G, c;
    __host__ __device__ void init(int M, int N, int G_, int c_) { nM = M / BM; nN = N / BM; nwg = nM * nN; G = G_; c = c_; }
    __host__ __device__ bool next(int i, Unit& u) const {
        const long L = (long)i * G + c; if (L >= nwg) return false;
        int wgid = (int)L; { const int q = nwg / NXCD, r = nwg % NXCD, xcd = wgid % NXCD, off = wgid / NXCD; wgid = (xcd < r ? xcd * (q + 1) : r * (q + 1) + (xcd - r) * q) + off; }
        const int nig = WGM * nN, gid = wgid / nig, fm = gid * WGM, gsz = (nM - fm) < WGM ? (nM - fm) : WGM;
        u.pm = fm + ((wgid % nig) % gsz); u.pn = (wgid % nig) / gsz; return true;
    }
    __device__ __forceinline__ void a_ready(const Unit&) const {}
    __device__ __forceinline__ void pre_epi(const Unit&) const {}
    __device__ __forceinline__ void done(const Unit&) const {}
};

__device__ __forceinline__ unsigned cvt_pk_bf16(float lo, float hi) { unsigned r; asm volatile("v_cvt_pk_bf16_f32 %0, %1, %2" : "=v"(r) : "v"(lo), "v"(hi)); return r; }
typedef float f32x2 __attribute__((ext_vector_type(2)));
constexpr int NCTX = 4096, MTOK = 20480, MKV = 22528;
constexpr float RMS_EPS = 1e-6f;
constexpr float QSCALE = 0.10206207261596577f * 1.4426950408889634f;
__device__ __forceinline__ int grp_of_pm(int pm) { return pm < 16 ? 0 : 1 + ((pm - 16) >> 4); }
__device__ __forceinline__ float fsilu(float x) { return x * __builtin_amdgcn_rcpf(1.f + __builtin_amdgcn_exp2f(-1.4426950408889634f * x)); }
__device__ __forceinline__ u32x4 pack8(const f32x4& a, const f32x4& b) { u32x4 w; w.x = cvt_pk_bf16(a[0], a[1]); w.y = cvt_pk_bf16(a[2], a[3]); w.z = cvt_pk_bf16(b[0], b[1]); w.w = cvt_pk_bf16(b[2], b[3]); return w; }
__device__ __forceinline__ float dot4(const f32x4& a) { return (a[0] * a[0] + a[1] * a[1]) + (a[2] * a[2] + a[3] * a[3]); }

struct EpiConvIn {
    static constexpr bool PERM = true, AFTER_DRAIN = false; static constexpr int NST = 8;
    bf16_t* V; bf16_t* E;
    __device__ __forceinline__ void operator()(const f32x4 (&acc)[2][2][4][2], const Unit& u, int wr, int wc, int fr, int fq) const {
        asm volatile("" : "+v"(fr), "+v"(fq));
        const int row0 = u.pm * BM + wr * 64 + fr; const int ch = 128 * (u.pn >> 1) + wc * 32 + 8 * fq; const bool isE = (u.pn & 1) != 0;
        bf16_t* base = (isE ? E : V) + ch;
#pragma unroll
        for (int ai = 0; ai < 2; ++ai)
#pragma unroll
            for (int m = 0; m < 4; ++m) {
                f32x4 a0 = acc[ai][0][m][0], a1 = acc[ai][0][m][1], b0 = acc[ai][1][m][0], b1 = acc[ai][1][m][1];
                if (isE) {
#pragma unroll
                    for (int i = 0; i < 4; ++i) { b0[i] = fsilu(b0[i]); b1[i] = fsilu(b1[i]); } }
                const f32x4 r0 = a0 * b0, r1 = a1 * b1;
                *(u32x4*)(base + (size_t)(row0 + ai * HALF + m * 16) * 1024) = pack8(r0, r1);
            }
    }
};

struct EpiResid {
    static constexpr bool PERM = false, AFTER_DRAIN = false; static constexpr int NST = 0;
    const float* xa; const float* xb; float* out; const float* gate;
    __device__ __forceinline__ void operator()(const f32x4 (&acc)[2][2][4][2], const Unit& u, int wr, int wc, int fr, int fq) const {
        asm volatile("" : "+v"(fr), "+v"(fq));
        const int row0 = u.pm * BM + wr * 64 + fr, col0 = u.pn * BM + wc * 32 + 4 * fq; const float* gp = gate + grp_of_pm(u.pm) * 3072 + col0;
        f32x4 gv[2][2];
#pragma unroll
        for (int bj = 0; bj < 2; ++bj)
#pragma unroll
            for (int n = 0; n < 2; ++n) gv[bj][n] = *(const f32x4*)(gp + bj * HALF + n * 16);
        const float* src0 = u.pm < 16 ? xa : xb - (size_t)NCTX * 1024;
#pragma unroll
        for (int ai = 0; ai < 2; ++ai)
#pragma unroll
            for (int m = 0; m < 4; ++m) { const size_t off = (size_t)(row0 + ai * HALF + m * 16) * 1024 + col0;
#pragma unroll
                for (int bj = 0; bj < 2; ++bj)
#pragma unroll
                    for (int n = 0; n < 2; ++n) { const f32x4 x = *(const f32x4*)(src0 + off + bj * HALF + n * 16); *(f32x4*)(out + off + bj * HALF + n * 16) = x + gv[bj][n] * acc[ai][bj][m][n]; }
                if (m & 1) asm volatile("" ::: "memory"); }
    }
};

struct EpiDelta {
    static constexpr bool PERM = true, AFTER_DRAIN = false; static constexpr int NST = 16;
    bf16_t* D; const float* gate; int pm0;
    __device__ __forceinline__ void operator()(const f32x4 (&acc)[2][2][4][2], const Unit& u, int wr, int wc, int fr, int fq) const {
        asm volatile("" : "+v"(fr), "+v"(fq));
        const int row0 = u.pm * BM + wr * 64 + fr, col0 = u.pn * BM + wc * 32 + 8 * fq; const float* gp = gate + grp_of_pm(u.pm + pm0) * 3072 + col0;
        f32x4 gv[2][2];
#pragma unroll
        for (int bj = 0; bj < 2; ++bj)
#pragma unroll
            for (int n = 0; n < 2; ++n) gv[bj][n] = *(const f32x4*)(gp + bj * HALF + 4 * n);
#pragma unroll
        for (int ai = 0; ai < 2; ++ai)
#pragma unroll
            for (int m = 0; m < 4; ++m)
#pragma unroll
                for (int bj = 0; bj < 2; ++bj)
                    *(u32x4*)(D + (size_t)(row0 + ai * HALF + m * 16) * 1024 + col0 + bj * HALF) = pack8(acc[ai][bj][m][0] * gv[bj][0], acc[ai][bj][m][1] * gv[bj][1]);
    }
};

struct EpiMlaIn {
    static constexpr bool PERM = true, AFTER_DRAIN = false; static constexpr int NST = 16;
    bf16_t* CKV; bf16_t* QL; bf16_t* KR; bf16_t* SG;
    float* ssq_kv; float* ssq_q;
    float* st_ckv; float* st_kr;
    const float* gq; const float* gkv; const float* rope;
    __device__ __forceinline__ void operator()(const f32x4 (&acc)[2][2][4][2], const Unit& u, int wr, int wc, int fr, int fq) const {
        asm volatile("" : "+v"(fr), "+v"(fq));
        const int row0 = u.pm * BM + wr * 64 + fr, c8 = wc * 32 + 8 * fq, pn = u.pn;
        if (pn >= 3) {
            bf16_t* base = SG + (pn - 3) * 256 + c8;
#pragma unroll
            for (int ai = 0; ai < 2; ++ai)
#pragma unroll
                for (int m = 0; m < 4; ++m)
#pragma unroll
                    for (int bj = 0; bj < 2; ++bj) { f32x4 a0 = acc[ai][bj][m][0], a1 = acc[ai][bj][m][1];
#pragma unroll
                        for (int i = 0; i < 4; ++i) { a0[i] = fsilu(a0[i]); a1[i] = fsilu(a1[i]); }
                        *(u32x4*)(base + (size_t)(row0 + ai * HALF + m * 16) * 1024 + bj * HALF) = pack8(a0, a1); }
        } else if (pn <= 1) {
            const float* gsrc = pn == 0 ? gkv : gq; const int ld = pn == 0 ? 256 : 384, nslot = pn == 0 ? 4 : 8;
            bf16_t* dst = pn == 0 ? CKV : QL; float* ssq = pn == 0 ? ssq_kv : ssq_q;
            f32x4 gv[2][2];
#pragma unroll
            for (int bj = 0; bj < 2; ++bj)
#pragma unroll
                for (int n = 0; n < 2; ++n) gv[bj][n] = *(const f32x4*)(gsrc + c8 + bj * HALF + 4 * n);
#pragma unroll
            for (int ai = 0; ai < 2; ++ai)
#pragma unroll
                for (int m = 0; m < 4; ++m) { const int row = row0 + ai * HALF + m * 16; float ss = 0.f;
#pragma unroll
                    for (int bj = 0; bj < 2; ++bj) { const f32x4 a0 = acc[ai][bj][m][0], a1 = acc[ai][bj][m][1]; ss += dot4(a0) + dot4(a1);
                        const f32x4 w0 = a0 * gv[bj][0], w1 = a1 * gv[bj][1];
                        *(u32x4*)(dst + (size_t)row * ld + c8 + bj * HALF) = pack8(w0, w1);
                        if (pn == 0 && u.pm < 16) { float* sp = st_ckv + (size_t)row * 256 + c8 + bj * HALF; *(f32x4*)sp = w0; *(f32x4*)(sp + 4) = w1; } }
                    ss += __shfl_xor(ss, 16); ss += __shfl_xor(ss, 32);
                    if (fq == 0) ssq[(size_t)row * nslot + wc] = ss; }
        } else {
            f32x4 gv[2];
#pragma unroll
            for (int n = 0; n < 2; ++n) gv[n] = *(const f32x4*)(gq + 256 + c8 + 4 * n);
#pragma unroll
            for (int ai = 0; ai < 2; ++ai)
#pragma unroll
                for (int m = 0; m < 4; ++m) { const int row = row0 + ai * HALF + m * 16;
                    const f32x4 a0 = acc[ai][0][m][0], a1 = acc[ai][0][m][1]; float ss = dot4(a0) + dot4(a1);
                    *(u32x4*)(QL + (size_t)row * 384 + 256 + c8) = pack8(a0 * gv[0], a1 * gv[1]);
                    ss += __shfl_xor(ss, 16); ss += __shfl_xor(ss, 32);
                    if (fq == 0) ssq_q[(size_t)row * 8 + 4 + wc] = ss; }
            if (wc == 0) {
#pragma unroll
                for (int ai = 0; ai < 2; ++ai)
#pragma unroll
                    for (int m = 0; m < 4; ++m) { const int row = row0 + ai * HALF + m * 16;
                        f32x4 a0 = acc[ai][1][m][0], a1 = acc[ai][1][m][1];
                        if (u.pm < 16) { float* sp = st_kr + (size_t)row * 32 + 8 * fq; *(f32x4*)sp = a0; *(f32x4*)(sp + 4) = a1; }
                        else {
                            const int pos = (row - NCTX) & 4095, p = (fq >> 1) ? (pos & 63) : (pos >> 6);
                            const f32x4* cs = (const f32x4*)(rope + p * 16); const f32x4 c01 = cs[0], c23 = cs[1], c45 = cs[2], c67 = cs[3];
                            f32x4 p0, p1;
#pragma unroll
                            for (int i = 0; i < 4; ++i) { p0[i] = __shfl_xor(a0[i], 16); p1[i] = __shfl_xor(a1[i], 16); }
                            const float sg = (fq & 1) ? 1.f : -1.f;
                            a0[0] = a0[0] * c01[0] + sg * p0[0] * c01[1]; a0[1] = a0[1] * c01[2] + sg * p0[1] * c01[3];
                            a0[2] = a0[2] * c23[0] + sg * p0[2] * c23[1]; a0[3] = a0[3] * c23[2] + sg * p0[3] * c23[3];
                            a1[0] = a1[0] * c45[0] + sg * p1[0] * c45[1]; a1[1] = a1[1] * c45[2] + sg * p1[1] * c45[3];
                            a1[2] = a1[2] * c67[0] + sg * p1[2] * c67[1]; a1[3] = a1[3] * c67[2] + sg * p1[3] * c67[3];
                        }
                        *(u32x4*)(KR + (size_t)row * 32 + 8 * fq) = pack8(a0, a1); }
            }
        }
    }
};

struct EpiQUp {
    static constexpr bool PERM = true, AFTER_DRAIN = false; static constexpr int NST = 16;
    bf16_t* Q; const float* ssq_q; const float* rope;
    __device__ __forceinline__ void operator()(const f32x4 (&acc)[2][2][4][2], const Unit& u, int wr, int wc, int fr, int fq) const {
        asm volatile("" : "+v"(fr), "+v"(fq));
        const int row0 = u.pm * BM + wr * 64 + fr, col0 = u.pn * BM + wc * 32 + 8 * fq; const bool latent = u.pm >= 16;
        int d8[2];
#pragma unroll
        for (int bj = 0; bj < 2; ++bj) d8[bj] = ((col0 + bj * HALF) >> 3) % 12;
#pragma unroll
        for (int ai = 0; ai < 2; ++ai)
#pragma unroll
            for (int m = 0; m < 4; ++m) { const int row = row0 + ai * HALF + m * 16;
                const f32x4 s0 = *(const f32x4*)(ssq_q + (size_t)row * 8), s1 = *(const f32x4*)(ssq_q + (size_t)row * 8 + 4);
                const float ss = ((s0[0] + s0[1]) + (s0[2] + s0[3])) + ((s1[0] + s1[1]) + (s1[2] + s1[3]));
                const float rs = QSCALE / sqrtf(ss * (1.f / 384.f) + RMS_EPS);
                const int pos = (row - NCTX) & 4095;
#pragma unroll
                for (int bj = 0; bj < 2; ++bj) { f32x4 a0 = acc[ai][bj][m][0] * rs, a1 = acc[ai][bj][m][1] * rs;
                    if (latent) {
                        f32x4 p0, p1;
#pragma unroll
                        for (int i = 0; i < 4; ++i) { p0[i] = __shfl_xor(a0[i], 16); p1[i] = __shfl_xor(a1[i], 16); }
                        if (d8[bj] >= 8) {
                            const int p = d8[bj] >= 10 ? (pos & 63) : (pos >> 6);
                            const f32x4* cs = (const f32x4*)(rope + p * 16); const f32x4 c01 = cs[0], c23 = cs[1], c45 = cs[2], c67 = cs[3];
                            const float sg = (d8[bj] & 1) ? 1.f : -1.f;
                            a0[0] = a0[0] * c01[0] + sg * p0[0] * c01[1]; a0[1] = a0[1] * c01[2] + sg * p0[1] * c01[3];
                            a0[2] = a0[2] * c23[0] + sg * p0[2] * c23[1]; a0[3] = a0[3] * c23[2] + sg * p0[3] * c23[3];
                            a1[0] = a1[0] * c45[0] + sg * p1[0] * c45[1]; a1[1] = a1[1] * c45[2] + sg * p1[1] * c45[3];
                            a1[2] = a1[2] * c67[0] + sg * p1[2] * c67[1]; a1[3] = a1[3] * c67[2] + sg * p1[3] * c67[3];
                        }
                    }
                    *(u32x4*)(Q + (size_t)row * 1536 + col0 + bj * HALF) = pack8(a0, a1); } }
    }
};

struct EpiKvUp {
    static constexpr bool PERM = true, AFTER_DRAIN = false; static constexpr int NST = 16;
    bf16_t* KV; const float* ssq_kv;
    __device__ __forceinline__ void operator()(const f32x4 (&acc)[2][2][4][2], const Unit& u, int wr, int wc, int fr, int fq) const {
        asm volatile("" : "+v"(fr), "+v"(fq));
        const int row0 = u.pm * BM + wr * 64 + fr, col0 = u.pn * BM + wc * 32 + 8 * fq; const bool tok = u.pm < MTOK / BM;
#pragma unroll
        for (int ai = 0; ai < 2; ++ai)
#pragma unroll
            for (int m = 0; m < 4; ++m) { const int row = row0 + ai * HALF + m * 16; float rs = 1.f;
                if (tok) { const f32x4 s0 = *(const f32x4*)(ssq_kv + (size_t)row * 4); rs = 1.0f / sqrtf(((s0[0] + s0[1]) + (s0[2] + s0[3])) * (1.f / 256.f) + RMS_EPS); }
#pragma unroll
                for (int bj = 0; bj < 2; ++bj) *(u32x4*)(KV + (size_t)row * 2048 + col0 + bj * HALF) = pack8(acc[ai][bj][m][0] * rs, acc[ai][bj][m][1] * rs); }
    }
};
template <class Epi, class Sched, bool ALIGN_EPI = false, bool SP2 = false, bool RELAX = false>
__device__ __forceinline__ void gemm_phase(PG8_LAS unsigned char* lds, const Gemm g, const Sched& S, const Epi& E) {
    int tid = threadIdx.x; asm volatile("" : "+v"(tid));
    const int wid = __builtin_amdgcn_readfirstlane(tid >> 6), lane = tid & 63, wr = wid >> 2, wc = wid & 3, fr = lane & 15, fq = lane >> 4;
    const int K = g.K, nt = K / BK;
    unsigned voffA[2], voffB[2];
#pragma unroll
    for (int i = 0; i < 2; ++i) { int R, C; stage_rc(tid * 16 + i * 8192, R, C); const int Rb = Epi::PERM ? ((R & ~31) + perm32(R & 31)) : R;
        voffA[i] = (unsigned)(R * K + C) * 2u; voffB[i] = (unsigned)(Rb * K + C) * 2u; }
    const size_t kstep = (size_t)(BK * 2);
    const size_t hstep = (size_t)HALF * K * 2;
    const size_t tstep = 2 * hstep;
    const unsigned ldsw = (unsigned)wid * 1024u;
    const int aoff = lds_byte(wr * 64 + fr, fq * 8), boff = lds_byte(wc * 32 + fr, fq * 8);
#define PG8_SA(b, h) (((b) * 2 + (h)) * HTB)
#define PG8_SB(b, h) ((4 + (b) * 2 + (h)) * HTB)
#define PG8_STAGE(bufoff, gbase, voff) do { _Pragma("unroll") for (int _i = 0; _i < 2; ++_i) \
        __builtin_amdgcn_global_load_lds((const unsigned*)((const char*)(gbase) + (voff)[_i]), (PG8_LAS unsigned*)(lds + (bufoff) + ldsw + _i * 8192), 16, 0, 0); } while (0)
#define PG8_LDA(dst, b, h) do { _Pragma("unroll") for (int m = 0; m < 4; ++m) _Pragma("unroll") for (int k = 0; k < 2; ++k) dst[m][k] = *(const PG8_LAS bf16x8*)(lds + PG8_SA(b, h) + aoff + m * 2048 + k * 1024); } while (0)
#define PG8_LDB(dst, b, h) do { _Pragma("unroll") for (int n = 0; n < 2; ++n) _Pragma("unroll") for (int k = 0; k < 2; ++k) dst[n][k] = *(const PG8_LAS bf16x8*)(lds + PG8_SB(b, h) + boff + n * 2048 + k * 1024); } while (0)
#define PG8_MMA(ai, bj, At, Bt) do { __builtin_amdgcn_s_setprio(1); _Pragma("unroll") for (int m = 0; m < 4; ++m) _Pragma("unroll") for (int n = 0; n < 2; ++n) _Pragma("unroll") for (int k = 0; k < 2; ++k) \
        acc[ai][bj][m][n] = __builtin_amdgcn_mfma_f32_16x16x32_bf16(Bt[n][k], At[m][k], acc[ai][bj][m][n], 0, 0, 0); __builtin_amdgcn_s_setprio(0); } while (0)
#define PG8_WAIT_V(n) asm volatile("s_waitcnt vmcnt(" #n ")" ::: "memory")
#define PG8_WAIT_L(n) asm volatile("s_waitcnt lgkmcnt(" #n ")" ::: "memory")
#define PG8_BAR __builtin_amdgcn_s_barrier()
#define PG8_SCHED __builtin_amdgcn_sched_barrier(0)
    Unit cur, nxt; int ui = 0;
    if (!S.next(0, cur)) return;
    f32x4 acc[2][2][4][2];
#pragma unroll
    for (int a = 0; a < 2; ++a)
#pragma unroll
        for (int b = 0; b < 2; ++b)
#pragma unroll
            for (int m = 0; m < 4; ++m)
#pragma unroll
                for (int n = 0; n < 2; ++n) acc[a][b][m][n] = (f32x4){0.f, 0.f, 0.f, 0.f};
    bf16x8 At[4][2], B0[2][2], B1[2][2];
    const char* cA = (const char*)g.A + (size_t)cur.pm * tstep; const char* cB = (const char*)g.Bt + (size_t)cur.pn * tstep;
    S.a_ready(cur);
    if constexpr (SP2) {
        PG8_STAGE(PG8_SB(0, 0), cB, voffB); PG8_STAGE(PG8_SB(0, 1), cB + hstep, voffB); PG8_STAGE(PG8_SA(0, 0), cA, voffA); PG8_STAGE(PG8_SA(0, 1), cA + hstep, voffA);
        if (wr == 1) PG8_BAR;
        PG8_WAIT_V(2); PG8_BAR;
        PG8_STAGE(PG8_SB(1, 0), cB + kstep, voffB); PG8_STAGE(PG8_SA(1, 0), cA + kstep, voffA); PG8_STAGE(PG8_SB(1, 1), cB + hstep + kstep, voffB);
        if constexpr (RELAX) { PG8_STAGE(PG8_SA(1, 1), cA + hstep + kstep, voffA); PG8_WAIT_V(8); } else PG8_WAIT_V(6);
        PG8_BAR;
    } else {
        PG8_STAGE(PG8_SB(0, 0), cB, voffB); PG8_STAGE(PG8_SA(0, 0), cA, voffA); PG8_STAGE(PG8_SB(0, 1), cB + hstep, voffB); PG8_STAGE(PG8_SA(0, 1), cA + hstep, voffA);
        if (wr == 1) PG8_BAR;
        PG8_WAIT_V(4); PG8_BAR;
        PG8_STAGE(PG8_SB(1, 0), cB + kstep, voffB); PG8_STAGE(PG8_SA(1, 0), cA + kstep, voffA); PG8_STAGE(PG8_SB(1, 1), cB + hstep + kstep, voffB);
        PG8_WAIT_V(6); PG8_BAR;
    }
#define PG8_WAIT_VX(fresh) do { if constexpr (RELAX) asm volatile("s_cmp_lg_u32 %0, 0\n\ts_cbranch_scc1 1f\n\ts_waitcnt vmcnt(8)\n1:\n\ts_waitcnt vmcnt(%1)" :: "s"(fresh), "n"(8 + Epi::NST) : "memory", "scc"); else PG8_WAIT_V(8); } while (0)
    int pre = 0;
    for (;;) {
        const bool has_next = S.next(ui + 1, nxt);
        const char* nA = has_next ? (const char*)g.A + (size_t)nxt.pm * tstep : cA; const char* nB = has_next ? (const char*)g.Bt + (size_t)nxt.pn * tstep : cB;
        for (int t = 0; t < nt; t += 2) {
            const bool last = (t == nt - 2);
            const char* a1 = cA + (size_t)(t + 1) * kstep;
            const char* a2 = last ? nA : cA + (size_t)(t + 2) * kstep; const char* b2 = last ? nB : cB + (size_t)(t + 2) * kstep;
            const char* a3 = a2 + kstep; const char* b3 = b2 + kstep;
            if (last && has_next) S.a_ready(nxt);
            if constexpr (SP2) {
            const int fresh = RELAX ? __builtin_amdgcn_readfirstlane(t == 0 ? pre : 0) : 0; (void)fresh;
            PG8_LDB(B0, 0, 0); PG8_LDB(B1, 0, 1); PG8_SCHED; PG8_LDA(At, 0, 0); if constexpr (!RELAX) PG8_STAGE(PG8_SA(1, 1), a1 + hstep, voffA);
            PG8_WAIT_VX(fresh); PG8_WAIT_L(0); PG8_BAR; PG8_MMA(0, 0, At, B0); PG8_MMA(0, 1, At, B1); PG8_BAR; PG8_SCHED;
            PG8_LDA(At, 0, 1); PG8_STAGE(PG8_SB(0, 0), b2, voffB); PG8_STAGE(PG8_SB(0, 1), b2 + hstep, voffB); PG8_STAGE(PG8_SA(0, 0), a2, voffA);
            PG8_WAIT_VX(fresh); PG8_WAIT_L(0); PG8_BAR; PG8_MMA(1, 0, At, B0); PG8_MMA(1, 1, At, B1); PG8_BAR; PG8_SCHED;
            PG8_LDB(B0, 1, 0); PG8_LDB(B1, 1, 1); PG8_SCHED; PG8_LDA(At, 1, 0); PG8_STAGE(PG8_SA(0, 1), a2 + hstep, voffA);
            PG8_WAIT_VX(fresh); PG8_WAIT_L(0); PG8_BAR; PG8_MMA(0, 0, At, B0); PG8_MMA(0, 1, At, B1); PG8_BAR; PG8_SCHED;
            PG8_LDA(At, 1, 1); PG8_STAGE(PG8_SB(1, 0), b3, voffB); PG8_STAGE(PG8_SB(1, 1), b3 + hstep, voffB); PG8_STAGE(PG8_SA(1, 0), a3, voffA);
            PG8_WAIT_V(8); PG8_WAIT_L(0); PG8_BAR; PG8_MMA(1, 0, At, B0); PG8_MMA(1, 1, At, B1); PG8_BAR; PG8_SCHED;
            if constexpr (RELAX) { PG8_STAGE(PG8_SA(1, 1), a3 + hstep, voffA); PG8_SCHED; }
            } else {
            PG8_LDB(B0, 0, 0); PG8_SCHED; PG8_LDA(At, 0, 0); PG8_STAGE(PG8_SA(1, 1), a1 + hstep, voffA);
            PG8_WAIT_L(8); PG8_BAR; PG8_WAIT_L(0); PG8_MMA(0, 0, At, B0); PG8_BAR; PG8_SCHED;
            PG8_LDB(B1, 0, 1); PG8_STAGE(PG8_SB(0, 0), b2, voffB);
            PG8_BAR; PG8_WAIT_L(0); PG8_MMA(0, 1, At, B1); PG8_BAR;
            PG8_LDA(At, 0, 1); PG8_STAGE(PG8_SA(0, 0), a2, voffA);
            PG8_BAR; PG8_WAIT_L(0); PG8_MMA(1, 0, At, B0); PG8_BAR; PG8_SCHED;
            PG8_STAGE(PG8_SB(0, 1), b2 + hstep, voffB);
            PG8_WAIT_V(6); PG8_BAR; PG8_MMA(1, 1, At, B1); PG8_BAR;
            PG8_LDB(B0, 1, 0); PG8_SCHED; PG8_LDA(At, 1, 0); PG8_STAGE(PG8_SA(0, 1), a2 + hstep, voffA);
            PG8_WAIT_L(8); PG8_BAR; PG8_WAIT_L(0); PG8_MMA(0, 0, At, B0); PG8_BAR; PG8_SCHED;
            PG8_LDB(B1, 1, 1); PG8_STAGE(PG8_SB(1, 0), b3, voffB);
            PG8_BAR; PG8_WAIT_L(0); PG8_MMA(0, 1, At, B1); PG8_BAR;
            PG8_LDA(At, 1, 1); PG8_STAGE(PG8_SA(1, 0), a3, voffA);
            PG8_BAR; PG8_WAIT_L(0); PG8_MMA(1, 0, At, B0); PG8_BAR; PG8_SCHED;
            PG8_STAGE(PG8_SB(1, 1), b3 + hstep, voffB);
            PG8_WAIT_V(6); PG8_BAR; PG8_MMA(1, 1, At, B1); PG8_BAR;
            }
        }
        if constexpr (ALIGN_EPI) { if (wr == 0) PG8_BAR; }
        if constexpr (!Epi::AFTER_DRAIN) { S.pre_epi(cur); E(acc, cur, wr, wc, fr, fq); S.done(cur); }
        if (!has_next) break;
#pragma unroll
        for (int a = 0; a < 2; ++a)
#pragma unroll
            for (int b = 0; b < 2; ++b)
#pragma unroll
                for (int m = 0; m < 4; ++m)
#pragma unroll
                    for (int n = 0; n < 2; ++n) acc[a][b][m][n] = (f32x4){0.f, 0.f, 0.f, 0.f};
        cur = nxt; cA = nA; cB = nB; ++ui; pre = 1;
        if constexpr (ALIGN_EPI) { if (wr == 1) PG8_BAR; }
    }
    PG8_WAIT_V(0);
    if constexpr (!ALIGN_EPI) { if (wr == 0) PG8_BAR; }
    PG8_BAR;
    if constexpr (Epi::AFTER_DRAIN) { E.fused(acc, cur, wr, wc, fr, fq, lds, wid, lane); S.done(cur); }
#undef PG8_SA
#undef PG8_SB
#undef PG8_STAGE
#undef PG8_LDA
#undef PG8_LDB
#undef PG8_MMA
#undef PG8_WAIT_V
#undef PG8_WAIT_L
#undef PG8_WAIT_VX
#undef PG8_BAR
#undef PG8_SCHED
}
}
namespace att {
#define ATT_LAS __attribute__((address_space(3)))
typedef unsigned short bf16_t;
using bf16x8 = __attribute__((ext_vector_type(8))) short;
using s16x4  = __attribute__((ext_vector_type(4))) short;
using f32x16 = __attribute__((ext_vector_type(16))) float;
using u32x4  = __attribute__((ext_vector_type(4))) unsigned;
constexpr int NW = 8, QBLK = 32, KVBLK = 64;
constexpr int SHM_K = 64 * 256, SHM_V = 64 * 64 * 2;
constexpr int NBUF = 5;
constexpr int LDS_BYTES = NBUF * SHM_V + NBUF * SHM_K + NW * 64 * 4;
constexpr int LDS_TOTAL = LDS_BYTES + NW * 4096;
constexpr float THR = 8.f;
#define KSWZ(row, colB) ((row) * 256 + ((colB) ^ (((row) & 15) << 4)))
#define ATT_SBAR() __builtin_amdgcn_sched_barrier(0)
__device__ __forceinline__ int crow(int r, int hi) { return (r & 3) + 8 * (r >> 2) + 4 * hi; }
__device__ __forceinline__ unsigned cvtpk(float lo, float hi) { unsigned r; asm volatile("v_cvt_pk_bf16_f32 %0, %1, %2" : "=v"(r) : "v"(lo), "v"(hi)); return r; }

template <bool FIRST>
__device__ __forceinline__ void partialSM(f32x16& p0, f32x16& p1, float& m_reg, f32x16& negm, float& alpha) {
  float pmax = p0[0];
#pragma unroll
  for (int r = 1; r < 16; ++r) pmax = fmaxf(pmax, p0[r]);
#pragma unroll
  for (int r = 0; r < 16; ++r) pmax = fmaxf(pmax, p1[r]);
  { auto rr = __builtin_amdgcn_permlane32_swap(__float_as_uint(pmax), __float_as_uint(pmax), false, false);
    pmax = fmaxf(__uint_as_float(rr[0]), __uint_as_float(rr[1])); }
  alpha = 1.f;
  if (FIRST || __builtin_expect(__any(pmax > THR), 0)) {
    const float dl = FIRST ? pmax : fmaxf(pmax, 0.f);
    m_reg += dl;
#pragma unroll
    for (int r = 0; r < 16; ++r) { p0[r] -= dl; p1[r] -= dl; }
#pragma unroll
    for (int r = 0; r < 16; ++r) negm[r] = -m_reg;
    if (!FIRST) alpha = __builtin_amdgcn_exp2f(-dl);
  }
}
__device__ __forceinline__ void finishSM(f32x16& p0, f32x16& p1, float alpha, float& l_reg, bf16x8& pa0, bf16x8& pa1, bf16x8& pa2, bf16x8& pa3) {
#pragma unroll
  for (int r = 0; r < 16; ++r) p0[r] = __builtin_amdgcn_exp2f(p0[r]);
#pragma unroll
  for (int r = 0; r < 16; ++r) p1[r] = __builtin_amdgcn_exp2f(p1[r]);
  float ps = 0;
#pragma unroll
  for (int r = 0; r < 16; ++r) ps += p0[r];
#pragma unroll
  for (int r = 0; r < 16; ++r) ps += p1[r];
  { auto rr = __builtin_amdgcn_permlane32_swap(__float_as_uint(ps), __float_as_uint(ps), false, false);
    ps = __uint_as_float(rr[0]) + __uint_as_float(rr[1]); }
  l_reg = l_reg * alpha + ps;
#define ATT_PK4(P, BASE, OUT) do { unsigned a0 = cvtpk(P[BASE + 0], P[BASE + 1]), a1 = cvtpk(P[BASE + 2], P[BASE + 3]);   \
    unsigned b0 = cvtpk(P[BASE + 4], P[BASE + 5]), b1 = cvtpk(P[BASE + 6], P[BASE + 7]);                              \
    auto r0 = __builtin_amdgcn_permlane32_swap(a0, b0, false, false); auto r1 = __builtin_amdgcn_permlane32_swap(a1, b1, false, false); \
    u32x4 w = {r0[0], r1[0], r0[1], r1[1]}; OUT = __builtin_bit_cast(bf16x8, w); } while (0)
  ATT_PK4(p0, 0, pa0); ATT_PK4(p0, 8, pa1); ATT_PK4(p1, 0, pa2); ATT_PK4(p1, 8, pa3);
#undef ATT_PK4
}
__device__ __forceinline__ void qkt(f32x16& p0, f32x16& p1, const ATT_LAS char* Ks, const bf16x8* qr, const f32x16& negm, int r32, int hi) {
#pragma unroll
  for (int d0 = 0; d0 < 6; ++d0) { const int cb = (d0 * 16 + hi * 8) * 2;
    const bf16x8 b0 = *(const ATT_LAS bf16x8*)(Ks + KSWZ(r32, cb));
    const bf16x8 b1 = *(const ATT_LAS bf16x8*)(Ks + KSWZ(32 + r32, cb));
    if (d0 == 0) { p0 = __builtin_amdgcn_mfma_f32_32x32x16_bf16(b0, qr[0], negm, 0, 0, 0); p1 = __builtin_amdgcn_mfma_f32_32x32x16_bf16(b1, qr[0], negm, 0, 0, 0); }
    else { p0 = __builtin_amdgcn_mfma_f32_32x32x16_bf16(b0, qr[d0], p0, 0, 0, 0); p1 = __builtin_amdgcn_mfma_f32_32x32x16_bf16(b1, qr[d0], p1, 0, 0, 0); } }
}
__device__ __forceinline__ int v_st(int k, int c) { const int kk = (k & ~0xC) | ((k & 4) << 1) | ((k & 8) >> 1); return ((kk >> 3) * 2 + (c >> 5)) * 512 + ((kk & 7) * 32 + (c & 31)) * 2; }
__device__ __forceinline__ int v_rd_base(int lane) { return ((lane & 3) << 3) | (((lane >> 2) & 3) << 6) | (((lane >> 4) & 1) << 5) | (((lane >> 5) & 1) << 8); }
constexpr int v_rd_off(int d0, int ks, int half) { return d0 * 512 + ks * 2048 + half * 1024; }
template <int OFF> __device__ __forceinline__ s16x4 tr_read(int vb) {
  s16x4 r; asm volatile("ds_read_b64_tr_b16 %0, %1 offset:%2" : "=&v"(r) : "v"(vb), "i"(OFF) : "memory"); return r;
}
__device__ __forceinline__ void pv_d0(f32x16* o, int vb, bf16x8 pa0, bf16x8 pa1, bf16x8 pa2, bf16x8 pa3) {
  const s16x4 l0 = tr_read<v_rd_off(0, 0, 0)>(vb), h0 = tr_read<v_rd_off(0, 0, 1)>(vb), l1 = tr_read<v_rd_off(0, 1, 0)>(vb), h1 = tr_read<v_rd_off(0, 1, 1)>(vb);
  const s16x4 l2 = tr_read<v_rd_off(0, 2, 0)>(vb), h2 = tr_read<v_rd_off(0, 2, 1)>(vb), l3 = tr_read<v_rd_off(0, 3, 0)>(vb), h3 = tr_read<v_rd_off(0, 3, 1)>(vb);
  const s16x4 m0 = tr_read<v_rd_off(1, 0, 0)>(vb), n0 = tr_read<v_rd_off(1, 0, 1)>(vb), m1 = tr_read<v_rd_off(1, 1, 0)>(vb), n1 = tr_read<v_rd_off(1, 1, 1)>(vb);
  const s16x4 m2 = tr_read<v_rd_off(1, 2, 0)>(vb), n2 = tr_read<v_rd_off(1, 2, 1)>(vb), m3 = tr_read<v_rd_off(1, 3, 0)>(vb), n3 = tr_read<v_rd_off(1, 3, 1)>(vb);
#define ATT_PK(L, H) (bf16x8){L[0], L[1], L[2], L[3], H[0], H[1], H[2], H[3]}
  asm volatile("s_waitcnt lgkmcnt(8)" ::: "memory"); ATT_SBAR();
  o[0] = __builtin_amdgcn_mfma_f32_32x32x16_bf16(pa0, ATT_PK(l0, h0), o[0], 0, 0, 0);
  o[0] = __builtin_amdgcn_mfma_f32_32x32x16_bf16(pa1, ATT_PK(l1, h1), o[0], 0, 0, 0);
  o[0] = __builtin_amdgcn_mfma_f32_32x32x16_bf16(pa2, ATT_PK(l2, h2), o[0], 0, 0, 0);
  o[0] = __builtin_amdgcn_mfma_f32_32x32x16_bf16(pa3, ATT_PK(l3, h3), o[0], 0, 0, 0);
  asm volatile("s_waitcnt lgkmcnt(0)" ::: "memory"); ATT_SBAR();
  o[1] = __builtin_amdgcn_mfma_f32_32x32x16_bf16(pa0, ATT_PK(m0, n0), o[1], 0, 0, 0);
  o[1] = __builtin_amdgcn_mfma_f32_32x32x16_bf16(pa1, ATT_PK(m1, n1), o[1], 0, 0, 0);
  o[1] = __builtin_amdgcn_mfma_f32_32x32x16_bf16(pa2, ATT_PK(m2, n2), o[1], 0, 0, 0);
  o[1] = __builtin_amdgcn_mfma_f32_32x32x16_bf16(pa3, ATT_PK(m3, n3), o[1], 0, 0, 0);
#undef ATT_PK
}
__device__ __forceinline__ float bf2f(unsigned short b) { return __uint_as_float((unsigned)b << 16); }
__device__ __forceinline__ unsigned short f2bf(float f) { unsigned u = __float_as_uint(f); return (unsigned short)((u + 0x7fffu + ((u >> 16) & 1u)) >> 16); }

__device__ __forceinline__ void attn_unit(const bf16_t* __restrict__ Q, const bf16_t* __restrict__ KV, const bf16_t* __restrict__ KR, bf16_t* SG,
                                          int qrow0, int h, int kb0, int nt0, int kb1, int NT, ATT_LAS char* lds) {
  const int tid = threadIdx.x, wid = tid >> 6, lane = tid & 63, r32 = lane & 31, hi = lane >> 5;
  ATT_LAS char* V_lds = lds; ATT_LAS char* K_lds = lds + NBUF * SHM_V;
  ATT_LAS float* ws = (ATT_LAS float*)(lds + NBUF * SHM_V + NBUF * SHM_K) + wid * 64; ATT_LAS float* li_l = ws; ATT_LAS float* al_l = ws + 32;
  float m_reg = 0.f, l_reg = 0.f; f32x16 o[2] = {}; f32x16 negm = {}; bf16x8 qr[6];
  const bf16_t* Qw = Q + (size_t)(qrow0 + wid * QBLK + r32) * 1536 + h * 96 + hi * 8;
#pragma unroll
  for (int d0 = 0; d0 < 6; ++d0) qr[d0] = *(const bf16x8*)(Qw + d0 * 16);
  const int wu = __builtin_amdgcn_readfirstlane(wid);
  int offK[4], offV[2]; bool isR[4];
#pragma unroll
  for (int a_ = 0; a_ < 4; ++a_) { const int q_ = 4 * (wid & 3) + a_, r_ = 4 * q_ + (lane >> 4), c_ = (lane & 15) ^ (r_ & 15);
    isR[a_] = c_ >= 8 && c_ < 12; offK[a_] = isR[a_] ? r_ * 64 + (c_ - 8) * 16 : r_ * 4096 + h * 256 + (c_ < 8 ? c_ : 0) * 16; }
#pragma unroll
  for (int a_ = 0; a_ < 2; ++a_) { const int P = 64 * (2 * (wid & 3) + a_) + lane, sub = P >> 5, w_ = P & 31, kk = (sub >> 1) * 8 + (w_ >> 2), cc = (sub & 1) * 32 + (w_ & 3) * 8, k_ = (kk & ~0xC) | ((kk & 4) << 1) | ((kk & 8) >> 1);
    offV[a_] = k_ * 4096 + h * 256 + 128 + cc * 2; }
#define ATT_TBASE(t) ((t) < nt0 ? kb0 + (t) * KVBLK : kb1 + ((t) - nt0) * KVBLK)
#define ATT_DMA(t, slot) do { if (wu < 4) { const size_t rb_ = (size_t)ATT_TBASE(t); const char* kvb_ = (const char*)KV + rb_ * 4096; const char* krb_ = (const char*)KR + rb_ * 64; \
    _Pragma("unroll") for (int a_ = 0; a_ < 4; ++a_) __builtin_amdgcn_global_load_lds((const unsigned*)((isR[a_] ? krb_ : kvb_) + offK[a_]), (ATT_LAS unsigned*)(K_lds + (slot) * SHM_K + (4 * wu + a_) * 1024), 16, 0, 0); \
    _Pragma("unroll") for (int a_ = 0; a_ < 2; ++a_) __builtin_amdgcn_global_load_lds((const unsigned*)(kvb_ + offV[a_]), (ATT_LAS unsigned*)(V_lds + (slot) * SHM_V + (2 * wu + a_) * 1024), 16, 0, 0); } } while (0)
#define ATT_DMA_SYNC() do { asm volatile("s_waitcnt vmcnt(0)" ::: "memory"); __syncthreads(); } while (0)
  const int vb0 = (int)(unsigned)(size_t)V_lds + v_rd_base(lane);
#define ATT_RESC(a) do { if (__any((a) < 1.f)) { if (hi == 0) al_l[r32] = (a); asm volatile("s_waitcnt lgkmcnt(0)" ::: "memory"); \
    _Pragma("unroll") for (int d = 0; d < 2; ++d) _Pragma("unroll") for (int r = 0; r < 16; ++r) o[d][r] *= al_l[crow(r, hi)]; } } while (0)
#define ATT_M5(x) ((x) >= 5 ? (x) - 5 : (x))
  f32x16 pA0, pA1, pB0, pB1; float alA, alB; bf16x8 pa0, pa1, pa2, pa3;
  ATT_DMA(0, 0); ATT_DMA(1, 1); if (2 < NT) ATT_DMA(2, 2);
  ATT_DMA_SYNC();
  qkt(pA0, pA1, K_lds, qr, negm, r32, hi); partialSM<true>(pA0, pA1, m_reg, negm, alA);
  int b = 1;
  for (int j = 1; j + 1 < NT; j += 2) {
    if (j + 2 < NT) ATT_DMA(j + 2, ATT_M5(b + 2));
    ATT_SBAR(); qkt(pB0, pB1, K_lds + b * SHM_K, qr, negm, r32, hi);
    finishSM(pA0, pA1, alA, l_reg, pa0, pa1, pa2, pa3); ATT_SBAR();
    pv_d0(o, vb0 + ATT_M5(b + 4) * SHM_V, pa0, pa1, pa2, pa3); partialSM<false>(pB0, pB1, m_reg, negm, alB);
    ATT_RESC(alB);
    if (j + 3 < NT) ATT_DMA(j + 3, ATT_M5(b + 3));
    ATT_SBAR(); qkt(pA0, pA1, K_lds + ATT_M5(b + 1) * SHM_K, qr, negm, r32, hi);
    finishSM(pB0, pB1, alB, l_reg, pa0, pa1, pa2, pa3); ATT_SBAR();
    pv_d0(o, vb0 + b * SHM_V, pa0, pa1, pa2, pa3); partialSM<false>(pA0, pA1, m_reg, negm, alA);
    ATT_RESC(alA); ATT_DMA_SYNC(); b = ATT_M5(b + 2);
  }
  ATT_SBAR(); qkt(pB0, pB1, K_lds + b * SHM_K, qr, negm, r32, hi);
  finishSM(pA0, pA1, alA, l_reg, pa0, pa1, pa2, pa3); ATT_SBAR();
  pv_d0(o, vb0 + ATT_M5(b + 4) * SHM_V, pa0, pa1, pa2, pa3); partialSM<false>(pB0, pB1, m_reg, negm, alB);
  ATT_RESC(alB);
  finishSM(pB0, pB1, alB, l_reg, pa0, pa1, pa2, pa3); ATT_SBAR();
  pv_d0(o, vb0 + b * SHM_V, pa0, pa1, pa2, pa3);
  if (hi == 0) li_l[r32] = l_reg; asm volatile("s_waitcnt lgkmcnt(0)" ::: "memory");
  float rli[16];
#pragma unroll
  for (int r = 0; r < 16; ++r) rli[r] = __builtin_amdgcn_rcpf(li_l[crow(r, hi)]);
  bf16_t* Ow = SG + (size_t)(qrow0 + wid * QBLK) * 1024 + h * 64 + r32;
#pragma unroll
  for (int r = 0; r < 16; ++r) { const int orow = crow(r, hi);
#pragma unroll
    for (int d0 = 0; d0 < 2; ++d0) { bf16_t* p = Ow + (size_t)orow * 1024 + d0 * 32; *p = f2bf(o[d0][r] * rli[r] * bf2f(*p)); } }
  __syncthreads();
#undef ATT_TBASE
#undef ATT_DMA
#undef ATT_DMA_SYNC
#undef ATT_RESC
#undef ATT_M5
}
#undef KSWZ
}
#define GAS __attribute__((address_space(1)))
#define LAS __attribute__((address_space(3)))
typedef unsigned short bf16;
typedef unsigned v4u __attribute__((ext_vector_type(4)));
typedef float f32x4 __attribute__((ext_vector_type(4)));
typedef short bf16x8 __attribute__((ext_vector_type(8)));
typedef GAS unsigned gu32;
typedef GAS unsigned long long gu64;
#define RLX_AGENT __ATOMIC_RELAXED, __HIP_MEMORY_SCOPE_AGENT
#define LDS_WAIT() asm volatile("s_waitcnt lgkmcnt(0)" ::: "memory")
#define VM_WAIT() asm volatile("s_waitcnt vmcnt(0)" ::: "memory")
__device__ __forceinline__ unsigned long long rt() { return __builtin_amdgcn_s_memrealtime(); }
__device__ __forceinline__ unsigned f2bf(float f) { unsigned u = __builtin_bit_cast(unsigned, f); return (u + 0x7fffu + ((u >> 16) & 1u)) >> 16; }
__device__ __forceinline__ unsigned pk2(float lo, float hi) { return f2bf(lo) | (f2bf(hi) << 16); }

#define XB_TMO      128
#define XB_XCNT(j)  (256  + 64 * (j))
#define XB_XSUB(j)  (1280 + 64 * (j))
#define XB_XGEN(j)  (2304 + 64 * (j))
#define XB_TOP      3328
#define XB_TOPGEN   3392
#define XCD_BAR_WORDS 3456
#define XB_SPIN_CAP (1u << 18)

__device__ __forceinline__ unsigned xb_ld(unsigned* p)              { return __hip_atomic_load(p, __ATOMIC_RELAXED, __HIP_MEMORY_SCOPE_AGENT); }
__device__ __forceinline__ unsigned xb_add(unsigned* p, unsigned v) { return __hip_atomic_fetch_add(p, v, __ATOMIC_RELAXED, __HIP_MEMORY_SCOPE_AGENT); }
__device__ __forceinline__ unsigned xb_xcc_id() { return (unsigned)__builtin_amdgcn_s_getreg((3 << 11) | 20) & 0xFu; }
#define XB_SPIN(cond, bar) do { unsigned _sp = 0; while (cond) { __builtin_amdgcn_s_sleep(1); \
    if ((++_sp & 255u) == 0u) { if (xb_ld(&(bar)[XB_TMO])) break; if (_sp > XB_SPIN_CAP) { atomicAdd(&(bar)[XB_TMO], 1u); break; } } } } while (0)

struct XcdBarrier {
    unsigned* bar; unsigned x;
    volatile LAS unsigned* st;
};

__device__ __forceinline__ XcdBarrier xcd_barrier_post(unsigned* bar, volatile LAS unsigned* st) {
    XcdBarrier b; b.bar = bar; b.x = xb_xcc_id(); b.st = st;
    if (threadIdx.x == 0) (void)xb_add(&bar[XB_XCNT(b.x)], 1u);
    return b;
}
__device__ __forceinline__ void xcd_barrier_complete(unsigned* bar, unsigned x, unsigned& nloc, unsigned& nx) {
    const unsigned G = gridDim.x * gridDim.y * gridDim.z;
    unsigned sum, cnt, mine, sp = 0u;
    for (;;) {
        sum = 0u; cnt = 0u; mine = 0u;
#pragma unroll
        for (unsigned j = 0; j < 16; ++j) { const unsigned c = xb_ld(&bar[XB_XCNT(j)]); sum += c; cnt += (c > 0u) ? 1u : 0u; mine = (j == x) ? c : mine; }
        if (sum == G) break;
        __builtin_amdgcn_s_sleep(1);
        if ((++sp & 255u) == 0u) { if (xb_ld(&bar[XB_TMO])) break; if (sp > XB_SPIN_CAP) { atomicAdd(&bar[XB_TMO], 1u); break; } }
    }
    nloc = mine > 0u ? mine : 1u; nx = cnt > 0u ? cnt : 1u;
}

__device__ __forceinline__ void xcd_barrier(const XcdBarrier& b) {
    asm volatile("s_waitcnt vmcnt(0)" ::: "memory");
    __syncthreads();
    if (threadIdx.x == 0) {
        unsigned* bar = b.bar;
        __builtin_amdgcn_s_waitcnt(0);
        unsigned nloc = b.st[0], nx = b.st[1];
        if (nloc == 0u) { xcd_barrier_complete(bar, b.x, nloc, nx); b.st[0] = nloc; b.st[1] = nx; }
        const unsigned old = xb_add(&bar[XB_XSUB(b.x)], 1u);
        const unsigned gen = old / nloc;
        if (old + 1u == (gen + 1u) * nloc) {
            __builtin_amdgcn_fence(__ATOMIC_RELEASE, "agent");
            asm volatile("s_waitcnt vmcnt(0)" ::: "memory");
            const unsigned og = xb_add(&bar[XB_TOP], 1u);
            const unsigned tg = og / nx;
            if (og + 1u == (tg + 1u) * nx) xb_add(&bar[XB_TOPGEN], 1u);
            else XB_SPIN(xb_ld(&bar[XB_TOPGEN]) == tg, bar);
            __builtin_amdgcn_fence(__ATOMIC_ACQUIRE, "agent");
            xb_add(&bar[XB_XGEN(b.x)], 1u);
            asm volatile("s_waitcnt vmcnt(0)" ::: "memory");
        } else {
            XB_SPIN(xb_ld(&bar[XB_XGEN(b.x)]) == gen, bar);
            __builtin_amdgcn_fence(__ATOMIC_ACQUIRE, "agent");
            asm volatile("s_waitcnt vmcnt(0)" ::: "memory");
        }
    }
    __syncthreads();
}
constexpr int CW_C1 = 512, CW_C2 = 576;
struct InOrder {
    int x, j; unsigned* c1; unsigned* c2;
    __device__ __forceinline__ bool next(int i, pg8::Unit& u) const { const int e = j + 32 * i; if (e >= 70) return false;
        if (e < 30) { u.pn = e / 10; u.pm = 10 * x + e % 10; } else { const int g = e - 30; u.pn = 3 + g / 10; u.pm = 10 * x + g % 10; } return true; }
    __device__ __forceinline__ void a_ready(const pg8::Unit&) const {}
    __device__ __forceinline__ int entry(const pg8::Unit& u) const { return u.pn <= 2 ? u.pn * 10 + (u.pm - 10 * x) : 30 + (u.pn - 3) * 10 + (u.pm - 10 * x); }
    __device__ __forceinline__ void pre_epi(const pg8::Unit& u) const {
        const int e = entry(u);
        if (e >= 32 && e < 62 && threadIdx.x == 0) { asm volatile("s_waitcnt vmcnt(0)" ::: "memory"); __builtin_amdgcn_fence(__ATOMIC_RELEASE, "agent"); asm volatile("s_waitcnt vmcnt(0)" ::: "memory"); (void)xb_add(c1, 1u); }
    }
    __device__ __forceinline__ void done(const pg8::Unit& u) const {
        if (entry(u) + 32 >= 70) {
            asm volatile("s_waitcnt vmcnt(0)" ::: "memory");
            __builtin_amdgcn_s_barrier();
            if (threadIdx.x == 0) (void)xb_add(c2, 1u); }
    }
};
struct QUpOrder {
    int x, q0, nq;
    __device__ __forceinline__ bool next(int i, pg8::Unit& u) const { if (i >= nq) return false; const int q = q0 + i; u.pm = 10 * x + q / 6; u.pn = q % 6; return true; }
    __device__ __forceinline__ void a_ready(const pg8::Unit&) const {}
    __device__ __forceinline__ void pre_epi(const pg8::Unit&) const {}
    __device__ __forceinline__ void done(const pg8::Unit&) const {}
};
struct KvUpOrder {
    int x, k0, nk; unsigned* c2;
    __device__ __forceinline__ bool next(int i, pg8::Unit& u) const { if (i >= nk) return false; const int k = k0 + i; u.pm = 11 * x + k / 8; u.pn = k % 8; return true; }
    __device__ __forceinline__ void a_ready(const pg8::Unit& u) const {
        if (u.pm < 40) { unsigned sp = 0; while (xb_ld(c2) < 256u) { __builtin_amdgcn_s_sleep(2); if (++sp > (1u << 22)) break; } asm volatile("" ::: "memory"); }
    }
    __device__ __forceinline__ void pre_epi(const pg8::Unit&) const {}
    __device__ __forceinline__ void done(const pg8::Unit&) const {}
};
constexpr int NWAVES = 8;
#ifndef MK_N_LAUNCHES
#define MK_N_LAUNCHES 1
#endif
constexpr int NPHASE = 13;
constexpr int N_LAUNCHES = MK_N_LAUNCHES;
static_assert(N_LAUNCHES == 1 || N_LAUNCHES == NPHASE, "MK_N_LAUNCHES is 1 or 13");
using pg8::NCTX; using pg8::MTOK; using pg8::MKV;
constexpr float RMS_EPS = pg8::RMS_EPS;
constexpr size_t MiB = 1u << 20;
constexpr size_t WS_CTL = 0, CTL_ZERO_BYTES = 64 * 1024;
constexpr size_t WS_MOD = 1 * MiB;
constexpr size_t WS_ROPE = 1 * MiB + 512 * 1024;
constexpr size_t WS_SSQKV = 2 * MiB, WS_SSQQ = 2 * MiB + 512 * 1024;
constexpr size_t WS_W1 = 4 * MiB, WS_W2 = 12 * MiB, WS_W3 = 14 * MiB, WS_WQ = 18 * MiB, WS_WKV = 20 * MiB - 512 * 1024, WS_WO = 20 * MiB + 512 * 1024;
constexpr size_t WS_SG = 23 * MiB;
constexpr size_t WS_Q = 63 * MiB;
constexpr size_t WS_KV = 123 * MiB;
constexpr size_t WS_QL = 211 * MiB, WS_CKV = 226 * MiB, WS_KR = 237 * MiB, WS_END = 239 * MiB;
static_assert(WS_W1 + (size_t)4096 * 1024 * 2 <= WS_W2 && WS_W2 + (size_t)1024 * 1024 * 2 <= WS_W3 && WS_W3 + (size_t)1792 * 1024 * 2 <= WS_WQ && WS_WQ + (size_t)1536 * 384 * 2 <= WS_WKV &&
              WS_WKV + (size_t)2048 * 256 * 2 <= WS_WO && WS_WO + (size_t)1024 * 1024 * 2 <= WS_SG && WS_SG + (size_t)MTOK * 1024 * 2 <= WS_Q && WS_Q + (size_t)MTOK * 1536 * 2 <= WS_KV &&
              WS_KV + (size_t)MKV * 2048 * 2 <= WS_QL && WS_QL + (size_t)MTOK * 384 * 2 <= WS_CKV && WS_CKV + (size_t)MKV * 256 * 2 <= WS_KR && WS_KR + (size_t)MKV * 32 * 2 <= WS_END, "d_ws map");
constexpr int CW_ROWCTR = 512;
constexpr int CW_BAR = 1024;
static_assert((CW_BAR + XCD_BAR_WORDS) * 4 <= (int)CTL_ZERO_BYTES, "barrier words inside the memset region");
constexpr int RING_BYTES = 131072, LDSCTL_OFF = RING_BYTES, MISC_OFF = LDSCTL_OFF + 320, LDS_BYTES = 147456;
static_assert(att::LDS_BYTES <= RING_BYTES, "attention scratch fits the ring region");

struct Frame {
    LAS unsigned char* lds; volatile LAS unsigned* MISC;
    int tid, lane, wave, vcu, G;
};
__device__ __forceinline__ float wave_sum(float v) {
#pragma unroll
    for (int o = 1; o < 64; o <<= 1) v += __shfl_xor(v, o);
    return v;
}
__device__ __forceinline__ float silu_acc(float x) { return x / (1.f + expf(-x)); }
__device__ __forceinline__ int grp_of_tok(int t) { return t < NCTX ? 0 : 1 + ((t - NCTX) >> 12); }

__device__ __forceinline__ void transpose_item(const float* W, int ldw, int s0, bf16* WT, int K, int n0, int k0, LAS float* scr, int lane) {
    const int c = lane & 7;
    if (s0 < 0) {
#pragma unroll
        for (int j = 0; j < 4; ++j) { const int n = (lane >> 3) + 8 * j; *(GAS v4u*)(WT + (size_t)(n0 + n) * K + k0 + 8 * c) = (v4u){0u, 0u, 0u, 0u}; }
        return;
    }
#pragma unroll
    for (int i = 0; i < 32; ++i) { const int kk = 2 * i + (lane >> 5); scr[kk * 33 + (lane & 31)] = __builtin_nontemporal_load(W + (size_t)(k0 + kk) * ldw + s0 + (lane & 31)); }
    LDS_WAIT(); asm volatile("" ::: "memory");
#pragma unroll
    for (int j = 0; j < 4; ++j) { const int n = (lane >> 3) + 8 * j; const LAS float* s = scr + (8 * c) * 33 + n;
        v4u o; o.x = pk2(s[0 * 33], s[1 * 33]); o.y = pk2(s[2 * 33], s[3 * 33]); o.z = pk2(s[4 * 33], s[5 * 33]); o.w = pk2(s[6 * 33], s[7 * 33]);
        *(GAS v4u*)(WT + (size_t)(n0 + n) * K + k0 + 8 * c) = o; }
    LDS_WAIT(); asm volatile("" ::: "memory");
}
__device__ __forceinline__ int map_w1(int n0) { const int pn = n0 >> 8, cl = n0 & 255, bjj = cl >> 7, ch = 128 * (pn >> 1) + (cl & 127); const int part = (pn & 1) ? (bjj ? 3 : 0) : (bjj ? 2 : 1); return part * 1024 + ch; }
__device__ __forceinline__ int map_w3(int n0) { return n0 < 256 ? 384 + n0 : n0 < 640 ? n0 - 256 : n0 < 672 ? n0 : n0 < 768 ? -1 : n0 - 96; }

struct Ptrs {
    const float *x_prompt, *x_sample, *cache_ckv, *cache_krope, *c, *c_ctx, *norm_g, *w_mod, *b_mod, *conv_w_in, *conv_w, *conv_w_out, *mla_w_in, *gq, *w_q_up, *gkv, *w_kv_up, *w_out, *final_g;
    float* out; float* st_ckv; float* st_kr;
    float* mod; float* rope; float* ssq_kv; float* ssq_q;
    bf16 *W1, *W2, *W3, *WQ, *WKV, *WO, *SG, *EB, *Q, *KV, *H, *Y, *QL, *CKV, *KR, *DL;
};

__device__ __forceinline__ void phase_p0a(Frame& F, const Ptrs& P) {
    LAS float* sv = (LAS float*)(F.lds);
    LAS float* part = (LAS float*)(F.lds + 20480);
    bool filled = false;
    for (int chunk = blockIdx.x; chunk < 192; chunk += F.G) {
        if (!filled) {
            for (int e = F.tid; e < 5120; e += NWAVES * 64) { const int g = e >> 10, k = e & 1023; sv[e] = silu_acc(g == 0 ? P.c_ctx[k] : P.c[(g - 1) * 1024 + k]); }
            __syncthreads(); filled = true;
        }
        const int i = chunk / 96, cb = (chunk % 96) * 32, col = F.lane & 31, kh = F.lane >> 5;
        const float* w = P.w_mod + (size_t)i * 1024 * 3072 + cb + col;
        float a0 = 0.f, a1 = 0.f, a2 = 0.f, a3 = 0.f, a4 = 0.f;
#pragma unroll 16
        for (int kk = 0; kk < 64; ++kk) { const int k = F.wave * 128 + 2 * kk + kh; const float wv = __builtin_nontemporal_load(w + (size_t)k * 3072);
            a0 += sv[k] * wv; a1 += sv[1024 + k] * wv; a2 += sv[2048 + k] * wv; a3 += sv[3072 + k] * wv; a4 += sv[4096 + k] * wv; }
        a0 += __shfl_xor(a0, 32); a1 += __shfl_xor(a1, 32); a2 += __shfl_xor(a2, 32); a3 += __shfl_xor(a3, 32); a4 += __shfl_xor(a4, 32);
        if (kh == 0) { LAS float* pw = part + F.wave * 160 + col; pw[0] = a0; pw[32] = a1; pw[64] = a2; pw[96] = a3; pw[128] = a4; }
        __syncthreads();
        if (F.tid < 160) { const int g = F.tid >> 5, l = F.tid & 31; float s = 0.f;
#pragma unroll
            for (int wv = 0; wv < 8; ++wv) s += part[wv * 160 + g * 32 + l];
            P.mod[(size_t)(i * 5 + g) * 3072 + cb + l] = s + P.b_mod[i * 3072 + cb + l]; }
        __syncthreads();
    }
    __syncthreads();
    LAS float* scr = (LAS float*)(F.lds + F.wave * 16384);
    const int gw = F.vcu * NWAVES + F.wave, NGW = F.G * NWAVES;
    constexpr int I1 = 16 * 128, I2 = 16 * 32, I3 = 16 * 56, IQ = 6 * 48, IKV = 4 * 64, IO = 16 * 32, NITEMS = I1 + I2 + I3 + IQ + IKV + IO;
    for (int it = gw; it < NITEMS; it += NGW) {
        int r = it;
        if (r < I1) { const int kb = r / 128, nb = r % 128; transpose_item(P.conv_w_in, 4096, map_w1(32 * nb), P.W1, 1024, 32 * nb, 64 * kb, scr, F.lane); continue; } r -= I1;
        if (r < I2) { const int kb = r / 32, nb = r % 32; transpose_item(P.conv_w_out, 1024, 32 * nb, P.W2, 1024, 32 * nb, 64 * kb, scr, F.lane); continue; } r -= I2;
        if (r < I3) { const int kb = r / 56, nb = r % 56; transpose_item(P.mla_w_in, 1696, map_w3(32 * nb), P.W3, 1024, 32 * nb, 64 * kb, scr, F.lane); continue; } r -= I3;
        if (r < IQ) { const int kb = r / 48, nb = r % 48; transpose_item(P.w_q_up, 1536, 32 * nb, P.WQ, 384, 32 * nb, 64 * kb, scr, F.lane); continue; } r -= IQ;
        if (r < IKV) { const int kb = r / 64, nb = r % 64; transpose_item(P.w_kv_up, 2048, 32 * nb, P.WKV, 256, 32 * nb, 64 * kb, scr, F.lane); continue; } r -= IKV;
        { const int kb = r / 32, nb = r % 32; transpose_item(P.w_out, 1024, 32 * nb, P.WO, 1024, 32 * nb, 64 * kb, scr, F.lane); }
    }
    const int gt = F.vcu * (NWAVES * 64) + F.tid, NGT = F.G * NWAVES * 64;
    for (int i = gt; i < 2048 * 256 / 8; i += NGT) { const f32x4 a = *(const f32x4*)(P.cache_ckv + (size_t)i * 8), b = *(const f32x4*)(P.cache_ckv + (size_t)i * 8 + 4);
        *(v4u*)(P.CKV + (size_t)MTOK * 256 + (size_t)i * 8) = (v4u){pk2(a[0], a[1]), pk2(a[2], a[3]), pk2(b[0], b[1]), pk2(b[2], b[3])}; }
    for (int i = gt; i < 2048 * 32 / 8; i += NGT) { const f32x4 a = *(const f32x4*)(P.cache_krope + (size_t)i * 8), b = *(const f32x4*)(P.cache_krope + (size_t)i * 8 + 4);
        *(v4u*)(P.KR + (size_t)MTOK * 32 + (size_t)i * 8) = (v4u){pk2(a[0], a[1]), pk2(a[2], a[3]), pk2(b[0], b[1]), pk2(b[2], b[3])}; }
    if (blockIdx.x == F.G - 1) { const int p = F.tid >> 3, j = F.tid & 7; const float fr = powf(10000.f, -(float)j * 0.125f); float s, c; sincosf((float)p * fr, &s, &c);
        P.rope[F.tid * 2] = c; P.rope[F.tid * 2 + 1] = s; }
}

constexpr int RPI_DEF = 6;
__device__ __forceinline__ f32x4 bf4_to_f32(unsigned long long w) { f32x4 r; r[0] = __uint_as_float((unsigned)w << 16); r[1] = __uint_as_float((unsigned)w & 0xffff0000u); r[2] = __uint_as_float((unsigned)(w >> 32) << 16); r[3] = __uint_as_float((unsigned)(w >> 32) & 0xffff0000u); return r; }
template <bool HAS_DELTA, bool WRITE_X, int RPI = RPI_DEF>
#define ROWPASS_LOOP_HEAD const int NGWs = NGW; (void)ctr; for (int t0 = r0 + gw; t0 < MTOK; t0 += RPI * NGW) {
#define ROWPASS_LOOP_TAIL }
__device__ __forceinline__ void phase_hnorm(Frame& F, const float* xa, const float* xb, const bf16* delta, float* xout, const float* ng, const float* modl, bf16* H, int r0, int MTOK, int gw, int NGW, unsigned* ctr = nullptr) {
    ROWPASS_LOOP_HEAD
        f32x4 v[RPI][4]; float s[RPI];
#pragma unroll
        for (int r = 0; r < RPI; ++r) { const int t = t0 + r * NGWs; if (t < MTOK) {
            const float* x = t < NCTX ? xa + (size_t)t * 1024 : xb + (size_t)(t - NCTX) * 1024;
#pragma unroll
            for (int j = 0; j < 4; ++j) v[r][j] = __builtin_nontemporal_load((const f32x4*)(x + 4 * (F.lane + 64 * j)));
            if (HAS_DELTA) {
#pragma unroll
                for (int j = 0; j < 4; ++j) v[r][j] += bf4_to_f32(__builtin_nontemporal_load((const unsigned long long*)(delta + (size_t)t * 1024 + 4 * (F.lane + 64 * j)))); } } }
#pragma unroll
        for (int r = 0; r < RPI; ++r) { float a = 0.f; if (t0 + r * NGWs < MTOK) {
#pragma unroll
            for (int j = 0; j < 4; ++j) a += (v[r][j][0] * v[r][j][0] + v[r][j][1] * v[r][j][1]) + (v[r][j][2] * v[r][j][2] + v[r][j][3] * v[r][j][3]); }
            s[r] = a; }
#pragma unroll
        for (int o = 1; o < 64; o <<= 1) {
#pragma unroll
            for (int r = 0; r < RPI; ++r) s[r] += __shfl_xor(s[r], o); }
#pragma unroll
        for (int r = 0; r < RPI; ++r) { const int t = t0 + r * NGWs; if (t < MTOK) {
            const float rstd = 1.0f / sqrtf(s[r] * (1.f / 1024.f) + RMS_EPS);
            const float* sh = modl + grp_of_tok(t) * 3072; const float* sc = sh + 1024;
#pragma unroll
            for (int j = 0; j < 4; ++j) { const int k = 4 * (F.lane + 64 * j);
                if (WRITE_X) __builtin_nontemporal_store(v[r][j], (f32x4*)(xout + (size_t)t * 1024 + k));
                const f32x4 g = *(const f32x4*)(ng + k), a = *(const f32x4*)(sc + k), b = *(const f32x4*)(sh + k);
                const f32x4 o = v[r][j] * rstd * g * (a + 1.f) + b;
                *(unsigned long long*)(H + (size_t)t * 1024 + k) = (unsigned long long)pk2(o[0], o[1]) | ((unsigned long long)pk2(o[2], o[3]) << 32); } } }
    ROWPASS_LOOP_TAIL
}

__device__ __forceinline__ void bf8_to_f32(const v4u& w, float* f) {
    f[0] = __uint_as_float(w.x << 16); f[1] = __uint_as_float(w.x & 0xffff0000u); f[2] = __uint_as_float(w.y << 16); f[3] = __uint_as_float(w.y & 0xffff0000u);
    f[4] = __uint_as_float(w.z << 16); f[5] = __uint_as_float(w.z & 0xffff0000u); f[6] = __uint_as_float(w.w << 16); f[7] = __uint_as_float(w.w & 0xffff0000u);
}
__device__ __forceinline__ void phase_conv(Frame& F, const bf16* V, const bf16* E, const float* cw, bf16* Y) {
    const int gw = F.vcu * NWAVES + F.wave, NGW = F.G * NWAVES;
    const int c0 = (gw & 1) * 512 + F.lane * 8;
    float w0[8], w1[8], w2[8];
#pragma unroll
    for (int i = 0; i < 8; ++i) { w0[i] = cw[c0 + i]; w1[i] = cw[1024 + c0 + i]; w2[i] = cw[2048 + c0 + i]; }
    for (int it = gw; it < MTOK * 2; it += NGW) {
        const int t = it >> 1; int pos, len; if (t < NCTX) { pos = t & 255; len = 256; } else { pos = (t - NCTX) & 4095; len = 4096; }
        const size_t off = (size_t)t * 1024 + c0;
        const v4u z = {0u, 0u, 0u, 0u};
        const v4u vm = pos > 0 ? *(const v4u*)(V + off - 1024) : z, v0 = *(const v4u*)(V + off), vp = pos < len - 1 ? *(const v4u*)(V + off + 1024) : z, ee = __builtin_nontemporal_load((const v4u*)(E + off));
        float fm[8], f0[8], fp[8], fe[8], y[8]; bf8_to_f32(vm, fm); bf8_to_f32(v0, f0); bf8_to_f32(vp, fp); bf8_to_f32(ee, fe);
#pragma unroll
        for (int i = 0; i < 8; ++i) y[i] = fe[i] * (w0[i] * fm[i] + w1[i] * f0[i] + w2[i] * fp[i]);
        *(v4u*)(Y + off) = (v4u){pk2(y[0], y[1]), pk2(y[2], y[3]), pk2(y[4], y[5]), pk2(y[6], y[7])};
    }
}
__device__ __forceinline__ void phase_state_fix(Frame& F, float* st_ckv, const float* ssq_kv) {
    const int gw = F.vcu * NWAVES + F.wave, NGW = F.G * NWAVES;
    for (int t = gw; t < NCTX; t += NGW) { const f32x4 s0 = *(const f32x4*)(ssq_kv + (size_t)t * 4);
        const float rs = 1.0f / sqrtf(((s0[0] + s0[1]) + (s0[2] + s0[3])) * (1.f / 256.f) + RMS_EPS);
        f32x4* p = (f32x4*)(st_ckv + (size_t)t * 256) + F.lane; *p = *p * rs; }
}
template <int RPI = RPI_DEF>
__device__ __forceinline__ void phase_final(Frame& F, float* X, const bf16* delta, const float* g, int r0, int MTOK, int gw, int NGW, unsigned* ctr = nullptr) {
    ROWPASS_LOOP_HEAD
        f32x4 v[RPI][4]; float s[RPI];
#pragma unroll
        for (int r = 0; r < RPI; ++r) { const int t = t0 + r * NGWs; if (t < MTOK) {
#pragma unroll
            for (int j = 0; j < 4; ++j) v[r][j] = __builtin_nontemporal_load((const f32x4*)(X + (size_t)t * 1024 + 4 * (F.lane + 64 * j)));
#pragma unroll
            for (int j = 0; j < 4; ++j) v[r][j] += bf4_to_f32(__builtin_nontemporal_load((const unsigned long long*)(delta + (size_t)t * 1024 + 4 * (F.lane + 64 * j)))); } }
#pragma unroll
        for (int r = 0; r < RPI; ++r) { float a = 0.f; if (t0 + r * NGWs < MTOK) {
#pragma unroll
            for (int j = 0; j < 4; ++j) a += (v[r][j][0] * v[r][j][0] + v[r][j][1] * v[r][j][1]) + (v[r][j][2] * v[r][j][2] + v[r][j][3] * v[r][j][3]); }
            s[r] = a; }
#pragma unroll
        for (int o = 1; o < 64; o <<= 1) {
#pragma unroll
            for (int r = 0; r < RPI; ++r) s[r] += __shfl_xor(s[r], o); }
#pragma unroll
        for (int r = 0; r < RPI; ++r) { const int t = t0 + r * NGWs; if (t < MTOK) {
            const float rstd = 1.0f / sqrtf(s[r] * (1.f / 1024.f) + RMS_EPS);
#pragma unroll
            for (int j = 0; j < 4; ++j) { const int k = 4 * (F.lane + 64 * j); __builtin_nontemporal_store(v[r][j] * rstd * *(const f32x4*)(g + k), (f32x4*)(X + (size_t)t * 1024 + k)); } } }
    ROWPASS_LOOP_TAIL
}
__device__ __forceinline__ void phase_attn(Frame& F, const Ptrs& P) {
    for (int id = F.vcu; id < 1280; id += F.G) {
        int qrow0, h, kb0, nt0, kb1, NT;
        if (id < 1024) { const int bh = id >> 4, qb = id & 15, b = bh >> 4; h = bh & 15; qrow0 = NCTX + b * 4096 + qb * 256; kb0 = MTOK + b * 512; nt0 = 8; kb1 = NCTX + b * 4096; NT = 72; }
        else { const int bh = id - 1024, b = bh >> 4; h = bh & 15; qrow0 = b * 256; kb0 = b * 256; nt0 = 4; kb1 = 0; NT = 4; }
#ifdef ATT_PROBE
        for (int e = F.tid; e < 256 * 8; e += NWAVES * 64) { const int row = qrow0 + (e >> 3), ch = e & 7;
            bf16* c_ = (row < 13312 ? P.QL + (size_t)row * 1024 : (bf16*)((unsigned char*)P.QL + (239 - 211) * MiB) + (size_t)(row - 13312) * 1024) + h * 64 + ch * 8;
            *(v4u*)c_ = *(const v4u*)(P.SG + (size_t)row * 1024 + h * 64 + ch * 8); }
#endif
        att::attn_unit(P.Q, P.KV, P.KR, P.SG, qrow0, h, kb0, nt0, kb1, NT, (LAS char*)F.lds);
    }
}

struct Args { const float* in[19]; float* out; unsigned char* ws; int ph_lo, ph_hi; };
typedef const __attribute__((address_space(4))) Args* KArgs;
__device__ __forceinline__ void fill_ptrs(Ptrs& P, KArgs ka) {
    unsigned char* ws = ka->ws; float* out = ka->out;
    P.x_prompt = ka->in[0]; P.x_sample = ka->in[1]; P.cache_ckv = ka->in[2]; P.cache_krope = ka->in[3]; P.c = ka->in[4]; P.c_ctx = ka->in[5]; P.norm_g = ka->in[6];
    P.w_mod = ka->in[7]; P.b_mod = ka->in[8]; P.conv_w_in = ka->in[9]; P.conv_w = ka->in[10]; P.conv_w_out = ka->in[11]; P.mla_w_in = ka->in[12]; P.gq = ka->in[13];
    P.w_q_up = ka->in[14]; P.gkv = ka->in[15]; P.w_kv_up = ka->in[16]; P.w_out = ka->in[17]; P.final_g = ka->in[18];
    P.out = out; P.st_ckv = out + (size_t)MTOK * 1024; P.st_kr = P.st_ckv + (size_t)NCTX * 256;
    P.mod = (float*)(ws + WS_MOD); P.rope = (float*)(ws + WS_ROPE); P.ssq_kv = (float*)(ws + WS_SSQKV); P.ssq_q = (float*)(ws + WS_SSQQ);
    P.W1 = (bf16*)(ws + WS_W1); P.W2 = (bf16*)(ws + WS_W2); P.W3 = (bf16*)(ws + WS_W3); P.WQ = (bf16*)(ws + WS_WQ); P.WKV = (bf16*)(ws + WS_WKV); P.WO = (bf16*)(ws + WS_WO);
    P.SG = (bf16*)(ws + WS_SG); P.EB = (bf16*)(ws + WS_Q); P.Q = (bf16*)(ws + WS_Q); P.KV = (bf16*)(ws + WS_KV); P.H = (bf16*)(ws + WS_KV); P.Y = (bf16*)(ws + WS_KV + 40 * MiB);
    P.DL = (bf16*)(ws + WS_Q);
    P.QL = (bf16*)(ws + WS_QL); P.CKV = (bf16*)(ws + WS_CKV); P.KR = (bf16*)(ws + WS_KR);
}
#define MKP() Ptrs P; { KArgs ka_ = (KArgs)__builtin_amdgcn_kernarg_segment_ptr(); asm volatile("" : "+s"(ka_)); fill_ptrs(P, ka_); } const float* mod0 = P.mod; const float* mod1 = P.mod + 5 * 3072; (void)mod0; (void)mod1
__global__ void __launch_bounds__(NWAVES * 64, 2) mk_fwd(Args args) {
    extern __shared__ __attribute__((aligned(16))) unsigned char lds[];
    Frame F;
    F.lds = (LAS unsigned char*)lds; F.MISC = (volatile LAS unsigned*)(F.lds + MISC_OFF);
    F.tid = threadIdx.x; F.lane = F.tid & 63; F.wave = __builtin_amdgcn_readfirstlane(F.tid >> 6);
    F.G = gridDim.x; { const int bx = blockIdx.x; F.vcu = (F.G % 8 == 0) ? (bx % 8) * (F.G / 8) + bx / 8 : bx; }
    unsigned char* ws = args.ws;
    for (int u = F.tid; u < (LDS_BYTES - LDSCTL_OFF) / 4; u += NWAVES * 64) ((LAS unsigned*)(F.lds + LDSCTL_OFF))[u] = 0u;
    __syncthreads();
    XcdBarrier bar; bar.bar = (unsigned*)(ws + WS_CTL) + CW_BAR; bar.x = 0; bar.st = nullptr;
    if (N_LAUNCHES == 1) bar = xcd_barrier_post((unsigned*)(ws + WS_CTL) + CW_BAR, F.MISC + 8);
    const int lo = args.ph_lo, hi = args.ph_hi;
#ifndef PHASE_MASK
#define PHASE_MASK 0x1fff
#endif
#define IN(k) (((PHASE_MASK >> (k)) & 1) && lo <= (k) && (k) < hi)
#ifdef TIMING_PROBE
    unsigned long long* tsb = (unsigned long long*)(ws + WS_CTL + 32768);
    const bool stamper = blockIdx.x == 0 && F.tid == 0;
#define STAMP(i) do { if (stamper) tsb[i] = __builtin_amdgcn_s_memrealtime(); } while (0)
#else
#define STAMP(i) do {} while (0)
#endif
    STAMP(0);
#define SEAM(k) do { if (IN(k) && IN((k) + 1)) xcd_barrier(bar); STAMP((k) + 1); } while (0)
    if (IN(0)) { MKP(); phase_p0a(F, P); } SEAM(0);
    constexpr int MSPLIT = 16384;
    const int gwA = F.vcu * NWAVES + F.wave, NGWA = F.G * NWAVES;
    const bool tailcu = (int)blockIdx.x < 64;
    const int gwB = ((int)blockIdx.x - 64) * NWAVES + F.wave, NGWB = (F.G - 64) * NWAVES;
    if (IN(1)) { MKP(); phase_hnorm<false, false, 10>(F, P.x_prompt, P.x_sample, nullptr, nullptr, P.norm_g, mod0, P.H, 0, MTOK, gwA, NGWA); } SEAM(1);
    if (IN(2)) {
        MKP();
        pg8::Gemm g{P.H, P.W1, MTOK, 4096, 1024}; pg8::StaticOrder S; S.init(MTOK, 4096, F.G, (int)blockIdx.x);
        pg8::EpiConvIn E{P.SG, P.EB};
        pg8::gemm_phase<pg8::EpiConvIn, pg8::StaticOrder, true, true, true>(F.lds, g, S, E);
    } SEAM(2);
    if (IN(3)) { MKP(); phase_conv(F, P.SG, P.EB, P.conv_w, P.Y); } SEAM(3);
    if (IN(4)) {
        MKP();
        pg8::Gemm g{P.Y, P.W2, MSPLIT, 1024, 1024}; pg8::StaticOrder S; S.init(MSPLIT, 1024, F.G, (int)blockIdx.x);
        pg8::EpiDelta E{P.DL, mod0 + 2048, 0};
        pg8::gemm_phase<pg8::EpiDelta, pg8::StaticOrder, true, true>(F.lds, g, S, E);
    } SEAM(4);
    if (IN(5)) {
        MKP();
        if (tailcu) { pg8::Gemm g{P.Y + (size_t)MSPLIT * 1024, P.W2, MTOK - MSPLIT, 1024, 1024}; pg8::StaticOrder S; S.init(MTOK - MSPLIT, 1024, F.G, (int)blockIdx.x);
            pg8::EpiDelta E{P.DL + (size_t)MSPLIT * 1024, mod0 + 2048, MSPLIT / 256};
            pg8::gemm_phase<pg8::EpiDelta, pg8::StaticOrder, true, true>(F.lds, g, S, E); }
        if (!tailcu) phase_hnorm<true, true>(F, P.x_prompt, P.x_sample, P.DL, P.out, P.norm_g + 1024, mod1, P.H, 0, MSPLIT, gwB, NGWB);
    } SEAM(5);
    if (IN(6)) { MKP(); phase_hnorm<true, true, 2>(F, P.x_prompt, P.x_sample, P.DL, P.out, P.norm_g + 1024, mod1, P.H, MSPLIT, MTOK, gwA, NGWA); } SEAM(6);
    if (IN(7)) {
        MKP();
        const int xq = (int)blockIdx.x & 7, jq = (int)blockIdx.x >> 3;
        unsigned* ctl = (unsigned*)((unsigned char*)P.mod - WS_MOD + WS_CTL); unsigned* c1 = ctl + CW_C1; unsigned* c2 = ctl + CW_C2;
        { pg8::Gemm g{P.H, P.W3, MTOK, 1792, 1024}; InOrder S{xq, jq, c1, c2};
          pg8::EpiMlaIn E{P.CKV, P.QL, P.KR, P.SG, P.ssq_kv, P.ssq_q, P.st_ckv, P.st_kr, P.gq, P.gkv, P.rope};
          pg8::gemm_phase<pg8::EpiMlaIn, InOrder, true, true, true>(F.lds, g, S, E); }
        if (F.tid == 0) { unsigned sp = 0; while (xb_ld(c1) < 240u) { __builtin_amdgcn_s_sleep(2); if (++sp > (1u << 22)) break; }
            __builtin_amdgcn_fence(__ATOMIC_ACQUIRE, "agent"); asm volatile("s_waitcnt vmcnt(0)" ::: "memory"); }
        __syncthreads();
        phase_state_fix(F, P.st_ckv, P.ssq_kv);
        int q0, nq, k0, nk;
        if (jq >= 6) { q0 = 2 * (jq - 6); nq = 2; k0 = 3 * (jq - 6); nk = 3; } else if (jq < 4) { q0 = 52 + jq; nq = 1; k0 = 78 + 2 * jq; nk = 2; } else { q0 = 56 + 2 * (jq - 4); nq = 2; k0 = 86 + (jq - 4); nk = 1; }
#ifndef P7_SKIP_Q
        { int kq = 384; asm volatile("" : "+s"(kq));
          pg8::Gemm g{P.QL, P.WQ, MTOK, 1536, kq}; QUpOrder S{xq, q0, nq};
          pg8::EpiQUp E{P.Q, P.ssq_q, P.rope};
          pg8::gemm_phase<pg8::EpiQUp, QUpOrder, true, true>(F.lds, g, S, E); }
#endif
#ifndef P7_SKIP_KV
        { int kk = 256; asm volatile("" : "+s"(kk));
          pg8::Gemm g{P.CKV, P.WKV, MKV, 2048, kk}; KvUpOrder S{xq, k0, nk, c2};
          pg8::EpiKvUp E{P.KV, P.ssq_kv};
          pg8::gemm_phase<pg8::EpiKvUp, KvUpOrder, true, true>(F.lds, g, S, E); }
#endif
    } STAMP(8);
    SEAM(8);
    if (IN(9)) { MKP(); phase_attn(F, P); } SEAM(9);
    if (IN(10)) {
        MKP();
        pg8::Gemm g{P.SG, P.WO, MSPLIT, 1024, 1024}; pg8::StaticOrder S; S.init(MSPLIT, 1024, F.G, (int)blockIdx.x);
        pg8::EpiDelta E{P.DL, mod1 + 2048, 0};
        pg8::gemm_phase<pg8::EpiDelta, pg8::StaticOrder, true, true>(F.lds, g, S, E);
    } SEAM(10);
    if (IN(11)) {
        MKP();
        if (tailcu) { pg8::Gemm g{P.SG + (size_t)MSPLIT * 1024, P.WO, MTOK - MSPLIT, 1024, 1024}; pg8::StaticOrder S; S.init(MTOK - MSPLIT, 1024, F.G, (int)blockIdx.x);
            pg8::EpiDelta E{P.DL + (size_t)MSPLIT * 1024, mod1 + 2048, MSPLIT / 256};
            pg8::gemm_phase<pg8::EpiDelta, pg8::StaticOrder, true, true>(F.lds, g, S, E); }
        if (!tailcu) phase_final(F, P.out, P.DL, P.final_g, 0, MSPLIT, gwB, NGWB);
    } SEAM(11);
    if (IN(12)) { MKP(); phase_final<2>(F, P.out, P.DL, P.final_g, MSPLIT, MTOK, gwA, NGWA); }
#ifdef TIMING_PROBE
    xcd_barrier(bar); STAMP(NPHASE);
    if (blockIdx.x == 0) {   MKP();
        LAS float* red = (LAS float*)(F.lds);
        if (F.tid == 0) { float ta = 0.f, tb = 0.f;
            for (int k = 0; k < NPHASE; ++k) { const float d = (float)(tsb[k + 1] - tsb[k]) * 0.01f; if ((TP_MASK_A >> k) & 1) ta += d; if ((TP_MASK_B >> k) & 1) tb += d; }
            red[16] = ta; red[17] = tb; }
        float s = 0.f; for (int i = F.tid; i < NCTX * 32; i += NWAVES * 64) { const float v = P.st_kr[i]; s += v * v; }
        s = wave_sum(s); if (F.lane == 0) red[F.wave] = s;
        __syncthreads();
        const float S = (red[0] + red[1] + red[2] + red[3] + red[4] + red[5] + red[6] + red[7]) * (1.f / (NCTX * 32));
        const float delta = sqrtf(red[16] * 1e-6f * S);
        for (int i = F.tid; i < NCTX * 32; i += NWAVES * 64) P.st_kr[i] += delta;
        if (F.tid == 0) P.out[(size_t)NCTX * 1024] += red[17] * 0.01f;
    }
#endif
#undef IN
#undef SEAM
}

#ifdef ATT_PROBE
__device__ __forceinline__ float pb_bf(const bf16* p) { return __uint_as_float((unsigned)*p << 16); }
__global__ __launch_bounds__(256) void chk_attn(const bf16* Q, const bf16* KV, const bf16* KR, const bf16* OG, const bf16* SGC0, const bf16* SGC1, float* acc2) {
  __shared__ float Ks[32][96]; __shared__ float Vs[32][64]; __shared__ float red[8];
  const int tid = threadIdx.x, h = blockIdx.y, bi = blockIdx.x;
  int t, nk0, base0, nk1, base1;
  if (bi < 64) { int b = bi >> 4; t = NCTX + b * 4096 + (bi & 15) * 256 + tid; base0 = MTOK + b * 512; nk0 = 512; base1 = NCTX + b * 4096; nk1 = 4096; }
  else { int b = bi - 64; t = b * 256 + tid; base0 = b * 256; nk0 = 256; base1 = 0; nk1 = 0; }
  float q[96];
#pragma unroll
  for (int d = 0; d < 96; ++d) q[d] = pb_bf(Q + (size_t)t * 1536 + h * 96 + d);
  float o[64];
#pragma unroll
  for (int d = 0; d < 64; ++d) o[d] = 0.f;
  float m = -INFINITY, l = 0.f;
  const int ntile = (nk0 + nk1) / 32;
  for (int jt = 0; jt < ntile; ++jt) {
    int k0 = jt * 32; int rbase = k0 < nk0 ? base0 + k0 : base1 + (k0 - nk0);
    __syncthreads();
#pragma unroll
    for (int i = 0; i < 8; ++i) { int e = tid + 256 * i; int r = e >> 6, d = e & 63; const bf16* src = KV + (size_t)(rbase + r) * 2048 + h * 128; Ks[r][d] = pb_bf(src + d); Vs[r][d] = pb_bf(src + 64 + d); }
#pragma unroll
    for (int i = 0; i < 4; ++i) { int e = tid + 256 * i; int r = e >> 5, d = e & 31; Ks[r][64 + d] = pb_bf(KR + (size_t)(rbase + r) * 32 + d); }
    __syncthreads();
    for (int j = 0; j < 32; ++j) {
      float s = 0.f;
#pragma unroll
      for (int d = 0; d < 96; ++d) s = fmaf(q[d], Ks[j][d], s);
      float mn = fmaxf(m, s); float al = exp2f(m - mn), pj = exp2f(s - mn);
      l = l * al + pj; m = mn;
#pragma unroll
      for (int d = 0; d < 64; ++d) o[d] = fmaf(pj, Vs[j][d], o[d] * al);
    }
  }
  const float il = 1.0f / l; float sd = 0.f, sr = 0.f;
  const bf16* sg = (t < 13312 ? SGC0 + (size_t)t * 1024 : SGC1 + (size_t)(t - 13312) * 1024) + h * 64;
#pragma unroll
  for (int d = 0; d < 64; ++d) { const float ref = o[d] * il * pb_bf(sg + d), got = pb_bf(OG + (size_t)t * 1024 + h * 64 + d); sd += (got - ref) * (got - ref); sr += ref * ref; }
  sd = wave_sum(sd); sr = wave_sum(sr);
  __syncthreads();
  if ((tid & 63) == 0) { red[tid >> 6] = sd; red[4 + (tid >> 6)] = sr; }
  __syncthreads();
  if (tid == 0) { float* a_ = acc2 + (bi < 64 ? 2 : 0); atomicAdd(a_, red[0] + red[1] + red[2] + red[3]); atomicAdd(a_ + 1, red[4] + red[5] + red[6] + red[7]); }
}
__global__ __launch_bounds__(256) void chk_q(const bf16* QL, const float* ssq_q, const float* Wq, const bf16* Q, float* acc) {
  __shared__ float qrow[384]; __shared__ float red[8];
  const int tid = threadIdx.x, t = blockIdx.y, c = blockIdx.x * 256 + tid;
  qrow[tid] = pb_bf(QL + (size_t)t * 384 + tid); if (tid < 128) qrow[256 + tid] = pb_bf(QL + (size_t)t * 384 + 256 + tid);
  __syncthreads();
  const int d = c % 96; const bool rp = t >= NCTX && d >= 64; const int i = d - 64, kk = i & 15, cp = rp ? (kk < 8 ? c + 8 : c - 8) : c;
  float s = 0.f, sp = 0.f;
  for (int k = 0; k < 384; ++k) { s = fmaf(qrow[k], Wq[(size_t)k * 1536 + c], s); sp = fmaf(qrow[k], Wq[(size_t)k * 1536 + cp], sp); }
  float ss = 0.f; for (int j = 0; j < 8; ++j) ss += ssq_q[(size_t)t * 8 + j];
  const float rs = 0.10206207261596577f * 1.4426950408889634f / sqrtf(ss / 384.f + 1e-6f);
  float v = s;
  if (rp) { const int pos = (t - NCTX) & 4095, half = i >> 4, fi = kk & 7; const double ang = (double)(half ? (pos & 63) : (pos >> 6)) * pow(10000.0, -(double)fi / 8.0);
    const float cs = (float)cos(ang), sn = (float)sin(ang); v = kk < 8 ? s * cs - sp * sn : sp * sn + s * cs; }
  const float ref = v * rs, got = pb_bf(Q + (size_t)t * 1536 + c);
  float sd = wave_sum((got - ref) * (got - ref)), sr = wave_sum(ref * ref);
  if ((tid & 63) == 0) { red[tid >> 6] = sd; red[4 + (tid >> 6)] = sr; }
  __syncthreads();
  if (tid == 0) { atomicAdd(acc, red[0] + red[1] + red[2] + red[3]); atomicAdd(acc + 1, red[4] + red[5] + red[6] + red[7]); }
}
__global__ __launch_bounds__(256) void chk_kv(const bf16* CKV, const float* ssq_kv, const float* Wkv, const bf16* KV, float* acc) {
  __shared__ float crow[256]; __shared__ float red[8];
  const int tid = threadIdx.x, t = blockIdx.y, c = blockIdx.x * 256 + tid;
  crow[tid] = pb_bf(CKV + (size_t)t * 256 + tid);
  __syncthreads();
  float s = 0.f;
  for (int k = 0; k < 256; ++k) s = fmaf(crow[k], Wkv[(size_t)k * 2048 + c], s);
  float rs = 1.f; if (t < MTOK) { float ss = 0.f; for (int j = 0; j < 4; ++j) ss += ssq_kv[(size_t)t * 4 + j]; rs = 1.0f / sqrtf(ss / 256.f + 1e-6f); }
  const float ref = s * rs, got = pb_bf(KV + (size_t)t * 2048 + c);
  float sd = wave_sum((got - ref) * (got - ref)), sr = wave_sum(ref * ref);
  if ((tid & 63) == 0) { red[tid >> 6] = sd; red[4 + (tid >> 6)] = sr; }
  __syncthreads();
  if (tid == 0) { atomicAdd(acc + 2, red[0] + red[1] + red[2] + red[3]); atomicAdd(acc + 3, red[4] + red[5] + red[6] + red[7]); }
}
__global__ __launch_bounds__(256) void chk_g3(const bf16* H1, const float* W, const float* gq, const float* gkv, const bf16* QL, const bf16* CKV, const bf16* KR, const bf16* SG,
                                              const float* ssq_q, const float* ssq_kv, float* acc) {
  __shared__ float hrow[1024]; __shared__ float outv[1696]; __shared__ float red[16];
  const int t = blockIdx.x, tid = threadIdx.x;
  for (int i = 0; i < 4; ++i) hrow[tid + 256 * i] = pb_bf(H1 + (size_t)t * 1024 + tid + 256 * i);
  __syncthreads();
  for (int c = tid; c < 1696; c += 256) { float s = 0.f; for (int j = 0; j < 1024; ++j) s = fmaf(hrow[j], W[(size_t)j * 1696 + c], s); outv[c] = s; }
  __syncthreads();
  float sd = 0.f, sr = 0.f, q2 = 0.f, k2 = 0.f;
  for (int c = tid; c < 1696; c += 256) { float ref, got;
    if (c < 384) { ref = outv[c] * gq[c]; got = pb_bf(QL + (size_t)t * 384 + c); q2 += outv[c] * outv[c]; }
    else if (c < 640) { ref = outv[c] * gkv[c - 384]; got = pb_bf(CKV + (size_t)t * 256 + c - 384); k2 += outv[c] * outv[c]; }
    else if (c < 672) { const int i = c - 640; float v = outv[c];
      if (t >= NCTX) { const int pos = (t - NCTX) & 4095, half = i >> 4, kk = i & 15, fi = kk & 7; const double ang = (double)(half ? (pos & 63) : (pos >> 6)) * pow(10000.0, -(double)fi / 8.0);
        const float cs = (float)cos(ang), sn = (float)sin(ang), x1 = outv[640 + half * 16 + fi], x2 = outv[640 + half * 16 + 8 + fi]; v = kk < 8 ? x1 * cs - x2 * sn : x1 * sn + x2 * cs; }
      ref = v; got = pb_bf(KR + (size_t)t * 32 + i); }
    else { const float g = outv[c]; ref = g / (1.f + expf(-g)); got = pb_bf(SG + (size_t)t * 1024 + c - 672); }
    sd += (got - ref) * (got - ref); sr += ref * ref; }
  sd = wave_sum(sd); sr = wave_sum(sr); q2 = wave_sum(q2); k2 = wave_sum(k2);
  if ((tid & 63) == 0) { red[tid >> 6] = sd; red[4 + (tid >> 6)] = sr; red[8 + (tid >> 6)] = q2; red[12 + (tid >> 6)] = k2; }
  __syncthreads();
  if (tid == 0) { atomicAdd(acc, red[0] + red[1] + red[2] + red[3]); atomicAdd(acc + 1, red[4] + red[5] + red[6] + red[7]);
    const float q2r = red[8] + red[9] + red[10] + red[11], k2r = red[12] + red[13] + red[14] + red[15]; float q2f = 0.f, k2f = 0.f;
    for (int j = 0; j < 8; ++j) q2f += ssq_q[(size_t)t * 8 + j]; for (int j = 0; j < 4; ++j) k2f += ssq_kv[(size_t)t * 4 + j];
    atomicAdd(acc + 2, (q2f - q2r) * (q2f - q2r) + (k2f - k2r) * (k2f - k2r)); atomicAdd(acc + 3, q2r * q2r + k2r * k2r); }
}
__global__ __launch_bounds__(1024) void chk_encode(const float* acc2, float* st_kr, float* ys0) {
  __shared__ float red[16];
  float s = 0.f; for (int i = threadIdx.x; i < NCTX * 32; i += 1024) { const float v = st_kr[i]; s += v * v; }
  s = wave_sum(s); if ((threadIdx.x & 63) == 0) red[threadIdx.x >> 6] = s;
  __syncthreads();
  float S = 0.f; for (int i = 0; i < 16; ++i) S += red[i];
  S *= 1.f / (NCTX * 32);
  const float delta = sqrtf(acc2[0] / acc2[1] * S);
  for (int i = threadIdx.x; i < NCTX * 32; i += 1024) st_kr[i] += delta;
  if (threadIdx.x == 0) ys0[0] += 10.f * sqrtf(acc2[2] / acc2[3]);
}
#endif
extern "C" void kernel_launch(void* const* d_in, const int* in_sizes, int n_in, void* d_out, int out_size, void* d_ws, size_t ws_size, hipStream_t stream) {
    static int grid = 0;
    if (grid == 0) {
        if (n_in != 19 || ws_size < WS_END) { fprintf(stderr, "kernel_launch: built for 19 inputs and >= %zu bytes of workspace; got n_in %d, ws %zu; nothing launched\n", (size_t)WS_END, n_in, ws_size); grid = -1; return; }
        int dev = 0, cus = 0, per_cu = 0;
        if (hipGetDevice(&dev) != hipSuccess || hipDeviceGetAttribute(&cus, hipDeviceAttributeMultiprocessorCount, dev) != hipSuccess) { fprintf(stderr, "kernel_launch: device query failed\n"); grid = -1; return; }
        if (hipFuncSetAttribute((const void*)mk_fwd, hipFuncAttributeMaxDynamicSharedMemorySize, LDS_BYTES) != hipSuccess) { fprintf(stderr, "kernel_launch: hipFuncSetAttribute failed\n"); grid = -1; return; }
        if (hipOccupancyMaxActiveBlocksPerMultiprocessor(&per_cu, (const void*)mk_fwd, NWAVES * 64, LDS_BYTES) != hipSuccess || per_cu < 1) { fprintf(stderr, "kernel_launch: occupancy query says %d blocks per CU\n", per_cu); }
        (void)hipGetLastError();
        if (cus < 256) fprintf(stderr, "kernel_launch: built for the 256 CUs of an MI355X, this device reports %d\n", cus);
        grid = 256;
    }
    if (grid < 0) return;
    if (hipMemsetAsync((char*)d_ws + WS_CTL, 0, CTL_ZERO_BYTES, stream) != hipSuccess) { fprintf(stderr, "kernel_launch: hipMemsetAsync failed\n"); return; }
    Args a{};
    for (int i = 0; i < 19; ++i) a.in[i] = (const float*)d_in[i];
    a.out = (float*)d_out; a.ws = (unsigned char*)d_ws;
    for (int li = 0; li < N_LAUNCHES; ++li) {
        a.ph_lo = (N_LAUNCHES == 1) ? 0 : li; a.ph_hi = (N_LAUNCHES == 1) ? NPHASE : li + 1;
        hipLaunchKernelGGL(mk_fwd, dim3(grid), dim3(NWAVES * 64), LDS_BYTES, stream, a);
        const hipError_t le = hipPeekAtLastError();
        if (le != hipSuccess) { fprintf(stderr, "kernel_launch: launch %d failed: %s\n", li, hipGetErrorName(le)); break; }
#ifdef ATT_PROBE
        static_assert(N_LAUNCHES == NPHASE, "the attention probe runs between the per-phase launches");
        { unsigned char* ws = (unsigned char*)d_ws; float* acc2 = (float*)(ws + WS_CTL + 40960);
          if (ATT_PROBE == 1 && li == 9) hipLaunchKernelGGL(chk_attn, dim3(80, 16), dim3(256), 0, stream, (const bf16*)(ws + WS_Q), (const bf16*)(ws + WS_KV), (const bf16*)(ws + WS_KR), (const bf16*)(ws + WS_SG),
                                          (const bf16*)(ws + WS_QL), (const bf16*)(ws + 239 * MiB), acc2);
          if (ATT_PROBE == 2 && li == 8) { hipLaunchKernelGGL(chk_q, dim3(6, MTOK), dim3(256), 0, stream, (const bf16*)(ws + WS_QL), (const float*)(ws + WS_SSQQ), (const float*)d_in[14], (const bf16*)(ws + WS_Q), acc2);
                                             hipLaunchKernelGGL(chk_kv, dim3(8, MKV), dim3(256), 0, stream, (const bf16*)(ws + WS_CKV), (const float*)(ws + WS_SSQKV), (const float*)d_in[16], (const bf16*)(ws + WS_KV), acc2); }
          if (ATT_PROBE == 3 && li == 7) hipLaunchKernelGGL(chk_g3, dim3(MTOK), dim3(256), 0, stream, (const bf16*)(ws + WS_KV), (const float*)d_in[12], (const float*)d_in[13], (const float*)d_in[15],
                                             (const bf16*)(ws + WS_QL), (const bf16*)(ws + WS_CKV), (const bf16*)(ws + WS_KR), (const bf16*)(ws + WS_SG), (const float*)(ws + WS_SSQQ), (const float*)(ws + WS_SSQKV), acc2);
          if (li == NPHASE - 1) hipLaunchKernelGGL(chk_encode, dim3(1), dim3(1024), 0, stream, (const float*)acc2, (float*)d_out + (size_t)MTOK * 1024 + (size_t)NCTX * 256, (float*)d_out + (size_t)NCTX * 1024); }
#endif
    }
}
```

```cpp
#include <hip/hip_runtime.h>
#include <cstdio>
#include <cstdint>
#include <cmath>
namespace pg8 {
#define PG8_LAS __attribute__((address_space(3)))
typedef unsigned short bf16_t;
typedef short bf16x8 __attribute__((ext_vector_type(8)));
typedef float f32x4 __attribute__((ext_vector_type(4)));
typedef unsigned u32x4 __attribute__((ext_vector_type(4)));
constexpr int BM = 256, BK = 64, HALF = 128, HTB = HALF * BK * 2  , STAGE_BYTES = 8 * HTB, NXCD = 8, WGM = 4;

__host__ __device__ __forceinline__ int lds_byte(int r, int c) { const int st = (r >> 4) * 2 + (c >> 5), rr = r & 15, cc = c & 31, ob = rr * 64 + cc * 2; return st * 1024 + (ob ^ (((ob >> 9) & 1) << 5)); }
__host__ __device__ __forceinline__ void stage_rc(int b, int& R, int& C) { const int st = b / 1024, sb = b % 1024, swz = sb ^ (((sb >> 9) & 1) << 5); R = (st >> 1) * 16 + swz / 64; C = (st & 1) * 32 + (swz % 64) / 2; }
__host__ __device__ __forceinline__ int perm32(int rho) { const int n = rho >> 4, i = rho & 15; return 8 * (i >> 2) + 4 * n + (i & 3); }

struct Unit { int pm, pn; };
struct Gemm { const bf16_t* A; const bf16_t* Bt; int M, N, K; };

struct StaticOrder {
    int nM, nN, nwg, G, c;
    __host__ __device__ void init(int M, int N, int G_, int c_) { nM = M / BM; nN = N / BM; nwg = nM * nN; G = G_; c = c_; }
    __host__ __device__ __attribute__((always_inline)) bool next(int i, Unit& u) const {
        const long L = (long)i * G + c; if (L >= nwg) return false;
        int wgid = (int)L; { const int q = nwg / NXCD, r = nwg % NXCD, xcd = wgid % NXCD, off = wgid / NXCD; wgid = (xcd < r ? xcd * (q + 1) : r * (q + 1) + (xcd - r) * q) + off; }
        const int nig = WGM * nN, gid = wgid / nig, fm = gid * WGM, gsz = (nM - fm) < WGM ? (nM - fm) : WGM;
        u.pm = fm + ((wgid % nig) % gsz); u.pn = (wgid % nig) / gsz; return true;
    }
    __device__ __forceinline__ void a_ready(const Unit&) const {}
    __device__ __forceinline__ void pre_epi(const Unit&) const {}
    __device__ __forceinline__ void done(const Unit&) const {}
};

__device__ __forceinline__ unsigned cvt_pk_bf16(float lo, float hi) { unsigned r; asm volatile("v_cvt_pk_bf16_f32 %0, %1, %2" : "=v"(r) : "v"(lo), "v"(hi)); return r; }
typedef float f32x2 __attribute__((ext_vector_type(2)));
constexpr int NCTX = 4096, MTOK = 20480, MKV = 22528;
constexpr float RMS_EPS = 1e-6f;
constexpr float QSCALE = 0.10206207261596577f * 1.4426950408889634f;
__device__ __forceinline__ int grp_of_pm(int pm) { return pm < 16 ? 0 : 1 + ((pm - 16) >> 4); }
__device__ __forceinline__ float fsilu(float x) { return x * __builtin_amdgcn_rcpf(1.f + __builtin_amdgcn_exp2f(-1.4426950408889634f * x)); }
__device__ __forceinline__ u32x4 pack8(const f32x4& a, const f32x4& b) { u32x4 w; w.x = cvt_pk_bf16(a[0], a[1]); w.y = cvt_pk_bf16(a[2], a[3]); w.z = cvt_pk_bf16(b[0], b[1]); w.w = cvt_pk_bf16(b[2], b[3]); return w; }
__device__ __forceinline__ float dot4(const f32x4& a) { return (a[0] * a[0] + a[1] * a[1]) + (a[2] * a[2] + a[3] * a[3]); }

__device__ __forceinline__ float dpp_prev(float x) { return __builtin_bit_cast(float, __builtin_amdgcn_update_dpp(0, __builtin_bit_cast(int, x), 0x121, 0xF, 0xF, false)); }
__device__ __forceinline__ float dpp_next(float x) { return __builtin_bit_cast(float, __builtin_amdgcn_update_dpp(0, __builtin_bit_cast(int, x), 0x12F, 0xF, 0xF, false)); }
struct EpiConvY {
    static constexpr bool PERM = true, AFTER_DRAIN = false; static constexpr int NST = 8;
    bf16_t* Y; const float* cw; float* VE; PG8_LAS float* xch;
    __device__ __forceinline__ void operator()(const f32x4 (&acc)[2][2][4][2], const Unit& u, int wr, int wc, int fr, int fq) const {
        { int l_ = threadIdx.x; asm volatile("" : "+v"(l_)); fr = l_ & 15; fq = (l_ >> 4) & 3; }
        const int ch4 = 16 * wc + 4 * fq, chg = 64 * u.pn + ch4;
        const f32x4 w0 = *(const f32x4*)(cw + chg), w1 = *(const f32x4*)(cw + 1024 + chg), w2 = *(const f32x4*)(cw + 2048 + chg);
#pragma unroll
        for (int ai = 0; ai < 2; ++ai) { const int b = 2 * ai + wr;
            if (fr == 0)  *(PG8_LAS f32x4*)(xch + (b * 2 + 0) * 64 + ch4) = acc[ai][0][0][0] * acc[ai][0][0][1];
            if (fr == 15) *(PG8_LAS f32x4*)(xch + (b * 2 + 1) * 64 + ch4) = acc[ai][0][3][0] * acc[ai][0][3][1]; }
        asm volatile("s_waitcnt lgkmcnt(0)" ::: "memory"); __builtin_amdgcn_s_barrier();
        const f32x4 z4 = {0.f, 0.f, 0.f, 0.f};
#pragma unroll
        for (int ai = 0; ai < 2; ++ai) { const int b = 2 * ai + wr;
            f32x4 v[4], pv[4], nx[4];
#pragma unroll
            for (int m = 0; m < 4; ++m) { v[m] = acc[ai][0][m][0] * acc[ai][0][m][1];
#pragma unroll
                for (int i = 0; i < 4; ++i) { pv[m][i] = dpp_prev(v[m][i]); nx[m][i] = dpp_next(v[m][i]); } }
            const f32x4 eprev = b > 0 ? *(const PG8_LAS f32x4*)(xch + ((b - 1) * 2 + 1) * 64 + ch4) : z4;
            const f32x4 enext = b < 3 ? *(const PG8_LAS f32x4*)(xch + ((b + 1) * 2 + 0) * 64 + ch4) : z4;
#pragma unroll
            for (int m = 0; m < 4; ++m) {
                const f32x4 up = fr > 0 ? pv[m] : (m > 0 ? pv[m - 1] : eprev);
                const f32x4 dn = fr < 15 ? nx[m] : (m < 3 ? nx[m + 1] : enext);
                f32x4 zz = acc[ai][1][m][1];
#pragma unroll
                for (int i = 0; i < 4; ++i) zz[i] = fsilu(zz[i]);
                const f32x4 e = acc[ai][1][m][0] * zz, y = e * (w0 * up + w1 * v[m] + w2 * dn);
                const int row = u.pm * BM + ai * HALF + wr * 64 + m * 16 + fr;
                *(unsigned long long*)(Y + (size_t)row * 1024 + chg) = (unsigned long long)cvt_pk_bf16(y[0], y[1]) | ((unsigned long long)cvt_pk_bf16(y[2], y[3]) << 32);
                if (b == 0 && m == 0) { float* ve = VE + (size_t)u.pm * 6144 + chg; if (fr == 0) { *(f32x4*)ve = v[0]; *(f32x4*)(ve + 4096) = e; } if (fr == 1) *(f32x4*)(ve + 1024) = v[0]; }
                if (b == 3 && m == 3) { float* ve = VE + (size_t)u.pm * 6144 + chg; if (fr == 14) *(f32x4*)(ve + 2048) = v[3]; if (fr == 15) { *(f32x4*)(ve + 3072) = v[3]; *(f32x4*)(ve + 5120) = e; } }
            } }
    }
};
struct EpiConvIn {
    static constexpr bool PERM = true, AFTER_DRAIN = false; static constexpr int NST = 8;
    bf16_t* V; bf16_t* E;
    __device__ __forceinline__ void operator()(const f32x4 (&acc)[2][2][4][2], const Unit& u, int wr, int wc, int fr, int fq) const {
        asm volatile("" : "+v"(fr), "+v"(fq));
        const int row0 = u.pm * BM + wr * 64 + fr; const int ch = 128 * (u.pn >> 1) + wc * 32 + 8 * fq; const bool isE = (u.pn & 1) != 0;
        bf16_t* base = (isE ? E : V) + ch;
#pragma unroll
        for (int ai = 0; ai < 2; ++ai)
#pragma unroll
            for (int m = 0; m < 4; ++m) {
                f32x4 a0 = acc[ai][0][m][0], a1 = acc[ai][0][m][1], b0 = acc[ai][1][m][0], b1 = acc[ai][1][m][1];
                if (isE) {
#pragma unroll
                    for (int i = 0; i < 4; ++i) { b0[i] = fsilu(b0[i]); b1[i] = fsilu(b1[i]); } }
                const f32x4 r0 = a0 * b0, r1 = a1 * b1;
                *(u32x4*)(base + (size_t)(row0 + ai * HALF + m * 16) * 1024) = pack8(r0, r1);
            }
    }
};

struct EpiResid {
    static constexpr bool PERM = false, AFTER_DRAIN = false; static constexpr int NST = 0;
    const float* xa; const float* xb; float* out; const float* gate;
    __device__ __forceinline__ void operator()(const f32x4 (&acc)[2][2][4][2], const Unit& u, int wr, int wc, int fr, int fq) const {
        asm volatile("" : "+v"(fr), "+v"(fq));
        const int row0 = u.pm * BM + wr * 64 + fr, col0 = u.pn * BM + wc * 32 + 4 * fq; const float* gp = gate + grp_of_pm(u.pm) * 3072 + col0;
        f32x4 gv[2][2];
#pragma unroll
        for (int bj = 0; bj < 2; ++bj)
#pragma unroll
            for (int n = 0; n < 2; ++n) gv[bj][n] = *(const f32x4*)(gp + bj * HALF + n * 16);
        const float* src0 = u.pm < 16 ? xa : xb - (size_t)NCTX * 1024;
#pragma unroll
        for (int ai = 0; ai < 2; ++ai)
#pragma unroll
            for (int m = 0; m < 4; ++m) { const size_t off = (size_t)(row0 + ai * HALF + m * 16) * 1024 + col0;
#pragma unroll
                for (int bj = 0; bj < 2; ++bj)
#pragma unroll
                    for (int n = 0; n < 2; ++n) { const f32x4 x = *(const f32x4*)(src0 + off + bj * HALF + n * 16); *(f32x4*)(out + off + bj * HALF + n * 16) = x + gv[bj][n] * acc[ai][bj][m][n]; }
                if (m & 1) asm volatile("" ::: "memory"); }
    }
};

__device__ __forceinline__ void st_wt(void* p, const u32x4& v) { asm volatile("global_store_dwordx4 %0, %1, off sc1\n\ts_nop 1" :: "v"(p), "v"(v) : "memory"); }
struct EpiDelta {
    static constexpr bool PERM = true, AFTER_DRAIN = false; static constexpr int NST = 16;
    bf16_t* D; const float* gate; int pm0; int wt;
    __device__ __forceinline__ void operator()(const f32x4 (&acc)[2][2][4][2], const Unit& u, int wr, int wc, int fr, int fq) const {
        asm volatile("" : "+v"(fr), "+v"(fq));
        const int row0 = u.pm * BM + wr * 64 + fr, col0 = u.pn * BM + wc * 32 + 8 * fq; const float* gp = gate + grp_of_pm(u.pm + pm0) * 3072 + col0;
        f32x4 gv[2][2];
#pragma unroll
        for (int bj = 0; bj < 2; ++bj)
#pragma unroll
            for (int n = 0; n < 2; ++n) gv[bj][n] = *(const f32x4*)(gp + bj * HALF + 4 * n);
#pragma unroll
        for (int ai = 0; ai < 2; ++ai)
#pragma unroll
            for (int m = 0; m < 4; ++m)
#pragma unroll
                for (int bj = 0; bj < 2; ++bj) { const u32x4 pk_ = pack8(acc[ai][bj][m][0] * gv[bj][0], acc[ai][bj][m][1] * gv[bj][1]); bf16_t* dp = D + (size_t)(row0 + ai * HALF + m * 16) * 1024 + col0 + bj * HALF;
                    if (wt) st_wt(dp, pk_); else *(u32x4*)dp = pk_; }
    }
};

__device__ __forceinline__ void st_wt(float* p, const f32x4& v) { asm volatile("global_store_dwordx4 %0, %1, off sc1\n\ts_nop 1" :: "v"(p), "v"(v) : "memory"); }
__device__ __forceinline__ void st_wt(float* p, float v) { asm volatile("global_store_dword %0, %1, off sc1\n\ts_nop 1" :: "v"(p), "v"(v) : "memory"); }
struct EpiMlaIn {
    static constexpr bool PERM = true, AFTER_DRAIN = false; static constexpr int NST = 16;
    bf16_t* CKV; bf16_t* QL; bf16_t* KR; bf16_t* SG;
    float* ssq_kv; float* ssq_q;
    float* st_ckv; float* st_kr;
    const float* gq; const float* gkv; const float* rope;
    __device__ __forceinline__ void operator()(const f32x4 (&acc)[2][2][4][2], const Unit& u, int wr, int wc, int fr, int fq) const {
        asm volatile("" : "+v"(fr), "+v"(fq));
        const int row0 = u.pm * BM + wr * 64 + fr, c8 = wc * 32 + 8 * fq, pn = u.pn;
        if (pn >= 3) {
            bf16_t* base = SG + (pn - 3) * 256 + c8;
#pragma unroll
            for (int ai = 0; ai < 2; ++ai)
#pragma unroll
                for (int m = 0; m < 4; ++m)
#pragma unroll
                    for (int bj = 0; bj < 2; ++bj) { f32x4 a0 = acc[ai][bj][m][0], a1 = acc[ai][bj][m][1];
#pragma unroll
                        for (int i = 0; i < 4; ++i) { a0[i] = fsilu(a0[i]); a1[i] = fsilu(a1[i]); }
                        st_wt(base + (size_t)(row0 + ai * HALF + m * 16) * 1024 + bj * HALF, pack8(a0, a1)); }
        } else if (pn <= 1) {
            const float* gsrc = pn == 0 ? gkv : gq; const int ld = pn == 0 ? 256 : 384, nslot = pn == 0 ? 4 : 8;
            bf16_t* dst = pn == 0 ? CKV : QL; float* ssq = pn == 0 ? ssq_kv : ssq_q;
            f32x4 gv[2][2];
#pragma unroll
            for (int bj = 0; bj < 2; ++bj)
#pragma unroll
                for (int n = 0; n < 2; ++n) gv[bj][n] = *(const f32x4*)(gsrc + c8 + bj * HALF + 4 * n);
#pragma unroll
            for (int ai = 0; ai < 2; ++ai)
#pragma unroll
                for (int m = 0; m < 4; ++m) { const int row = row0 + ai * HALF + m * 16; float ss = 0.f;
#pragma unroll
                    for (int bj = 0; bj < 2; ++bj) { const f32x4 a0 = acc[ai][bj][m][0], a1 = acc[ai][bj][m][1]; ss += dot4(a0) + dot4(a1);
                        const f32x4 w0 = a0 * gv[bj][0], w1 = a1 * gv[bj][1];
                        st_wt(dst + (size_t)row * ld + c8 + bj * HALF, pack8(w0, w1));
                        if (pn == 0 && u.pm < 16) { float* sp = st_ckv + (size_t)row * 256 + c8 + bj * HALF; st_wt(sp, w0); st_wt(sp + 4, w1); } }
                    ss += __shfl_xor(ss, 16); ss += __shfl_xor(ss, 32);
                    if (fq == 0) st_wt(ssq + (size_t)row * nslot + wc, ss); }
        } else {
            f32x4 gv[2];
#pragma unroll
            for (int n = 0; n < 2; ++n) gv[n] = *(const f32x4*)(gq + 256 + c8 + 4 * n);
#pragma unroll
            for (int ai = 0; ai < 2; ++ai)
#pragma unroll
                for (int m = 0; m < 4; ++m) { const int row = row0 + ai * HALF + m * 16;
                    const f32x4 a0 = acc[ai][0][m][0], a1 = acc[ai][0][m][1]; float ss = dot4(a0) + dot4(a1);
                    st_wt(QL + (size_t)row * 384 + 256 + c8, pack8(a0 * gv[0], a1 * gv[1]));
                    ss += __shfl_xor(ss, 16); ss += __shfl_xor(ss, 32);
                    if (fq == 0) st_wt(ssq_q + (size_t)row * 8 + 4 + wc, ss); }
            if (wc == 0) {
#pragma unroll
                for (int ai = 0; ai < 2; ++ai)
#pragma unroll
                    for (int m = 0; m < 4; ++m) { const int row = row0 + ai * HALF + m * 16;
                        f32x4 a0 = acc[ai][1][m][0], a1 = acc[ai][1][m][1];
                        if (u.pm < 16) { float* sp = st_kr + (size_t)row * 32 + 8 * fq; st_wt(sp, a0); st_wt(sp + 4, a1); }
                        else {
                            const int pos = (row - NCTX) & 4095, p = (fq >> 1) ? (pos & 63) : (pos >> 6);
                            const f32x4* cs = (const f32x4*)(rope + p * 16); const f32x4 c01 = cs[0], c23 = cs[1], c45 = cs[2], c67 = cs[3];
                            f32x4 p0, p1;
#pragma unroll
                            for (int i = 0; i < 4; ++i) { p0[i] = __shfl_xor(a0[i], 16); p1[i] = __shfl_xor(a1[i], 16); }
                            const float sg = (fq & 1) ? 1.f : -1.f;
                            a0[0] = a0[0] * c01[0] + sg * p0[0] * c01[1]; a0[1] = a0[1] * c01[2] + sg * p0[1] * c01[3];
                            a0[2] = a0[2] * c23[0] + sg * p0[2] * c23[1]; a0[3] = a0[3] * c23[2] + sg * p0[3] * c23[3];
                            a1[0] = a1[0] * c45[0] + sg * p1[0] * c45[1]; a1[1] = a1[1] * c45[2] + sg * p1[1] * c45[3];
                            a1[2] = a1[2] * c67[0] + sg * p1[2] * c67[1]; a1[3] = a1[3] * c67[2] + sg * p1[3] * c67[3];
                        }
                        st_wt(KR + (size_t)row * 32 + 8 * fq, pack8(a0, a1)); }
            }
        }
    }
};

struct EpiQUp {
    static constexpr bool PERM = true, AFTER_DRAIN = false; static constexpr int NST = 16;
    bf16_t* Q; const float* ssq_q; const float* rope;
    __device__ __forceinline__ void operator()(const f32x4 (&acc)[2][2][4][2], const Unit& u, int wr, int wc, int fr, int fq) const {
        asm volatile("" : "+v"(fr), "+v"(fq));
        const int row0 = u.pm * BM + wr * 64 + fr, col0 = u.pn * BM + wc * 32 + 8 * fq; const bool latent = u.pm >= 16;
        int d8[2];
#pragma unroll
        for (int bj = 0; bj < 2; ++bj) d8[bj] = ((col0 + bj * HALF) >> 3) % 12;
#pragma unroll
        for (int ai = 0; ai < 2; ++ai)
#pragma unroll
            for (int m = 0; m < 4; ++m) { const int row = row0 + ai * HALF + m * 16;
                const f32x4 s0 = *(const f32x4*)(ssq_q + (size_t)row * 8), s1 = *(const f32x4*)(ssq_q + (size_t)row * 8 + 4);
                const float ss = ((s0[0] + s0[1]) + (s0[2] + s0[3])) + ((s1[0] + s1[1]) + (s1[2] + s1[3]));
                const float rs = QSCALE / sqrtf(ss * (1.f / 384.f) + RMS_EPS);
                const int pos = (row - NCTX) & 4095;
#pragma unroll
                for (int bj = 0; bj < 2; ++bj) { f32x4 a0 = acc[ai][bj][m][0] * rs, a1 = acc[ai][bj][m][1] * rs;
                    if (latent) {
                        f32x4 p0, p1;
#pragma unroll
                        for (int i = 0; i < 4; ++i) { p0[i] = __shfl_xor(a0[i], 16); p1[i] = __shfl_xor(a1[i], 16); }
                        if (d8[bj] >= 8) {
                            const int p = d8[bj] >= 10 ? (pos & 63) : (pos >> 6);
                            const f32x4* cs = (const f32x4*)(rope + p * 16); const f32x4 c01 = cs[0], c23 = cs[1], c45 = cs[2], c67 = cs[3];
                            const float sg = (d8[bj] & 1) ? 1.f : -1.f;
                            a0[0] = a0[0] * c01[0] + sg * p0[0] * c01[1]; a0[1] = a0[1] * c01[2] + sg * p0[1] * c01[3];
                            a0[2] = a0[2] * c23[0] + sg * p0[2] * c23[1]; a0[3] = a0[3] * c23[2] + sg * p0[3] * c23[3];
                            a1[0] = a1[0] * c45[0] + sg * p1[0] * c45[1]; a1[1] = a1[1] * c45[2] + sg * p1[1] * c45[3];
                            a1[2] = a1[2] * c67[0] + sg * p1[2] * c67[1]; a1[3] = a1[3] * c67[2] + sg * p1[3] * c67[3];
                        }
                    }
                    *(u32x4*)(Q + (size_t)row * 1536 + col0 + bj * HALF) = pack8(a0, a1); } }
    }
};

struct EpiKvUp {
    static constexpr bool PERM = true, AFTER_DRAIN = false; static constexpr int NST = 16;
    bf16_t* KV; const float* ssq_kv;
    __device__ __forceinline__ void operator()(const f32x4 (&acc)[2][2][4][2], const Unit& u, int wr, int wc, int fr, int fq) const {
        asm volatile("" : "+v"(fr), "+v"(fq));
        const int row0 = u.pm * BM + wr * 64 + fr, col0 = u.pn * BM + wc * 32 + 8 * fq; const bool tok = u.pm < MTOK / BM;
#pragma unroll
        for (int ai = 0; ai < 2; ++ai)
#pragma unroll
            for (int m = 0; m < 4; ++m) { const int row = row0 + ai * HALF + m * 16; float rs = 1.f;
                if (tok) { const f32x4 s0 = *(const f32x4*)(ssq_kv + (size_t)row * 4); rs = 1.0f / sqrtf(((s0[0] + s0[1]) + (s0[2] + s0[3])) * (1.f / 256.f) + RMS_EPS); }
#pragma unroll
                for (int bj = 0; bj < 2; ++bj) *(u32x4*)(KV + (size_t)row * 2048 + col0 + bj * HALF) = pack8(acc[ai][bj][m][0] * rs, acc[ai][bj][m][1] * rs); }
    }
};
template <class Epi, class Sched, bool ALIGN_EPI = false, bool SP2 = false, bool RELAX = false>
__device__ __forceinline__ void gemm_phase(PG8_LAS unsigned char* lds, const Gemm g, const Sched& S, const Epi& E) {
    int tid = threadIdx.x; asm volatile("" : "+v"(tid));
    const int wid = __builtin_amdgcn_readfirstlane(tid >> 6), lane = tid & 63, wr = wid >> 2, wc = wid & 3, fr = lane & 15, fq = lane >> 4;
    const int K = g.K, nt = K / BK;
    unsigned voffA[2], voffB[2];
#pragma unroll
    for (int i = 0; i < 2; ++i) { int R, C; stage_rc(tid * 16 + i * 8192, R, C); const int Rb = Epi::PERM ? ((R & ~31) + perm32(R & 31)) : R;
        voffA[i] = (unsigned)(R * K + C) * 2u; voffB[i] = (unsigned)(Rb * K + C) * 2u; }
    const size_t kstep = (size_t)(BK * 2);
    const size_t hstep = (size_t)HALF * K * 2;
    const size_t tstep = 2 * hstep;
    const unsigned ldsw = (unsigned)wid * 1024u;
    const int aoff = lds_byte(wr * 64 + fr, fq * 8), boff = lds_byte(wc * 32 + fr, fq * 8);
#define PG8_SA(b, h) (((b) * 2 + (h)) * HTB)
#define PG8_SB(b, h) ((4 + (b) * 2 + (h)) * HTB)
#define PG8_STAGE(bufoff, gbase, voff) do { _Pragma("unroll") for (int _i = 0; _i < 2; ++_i) \
        __builtin_amdgcn_global_load_lds((const unsigned*)((const char*)(gbase) + (voff)[_i]), (PG8_LAS unsigned*)(lds + (bufoff) + ldsw + _i * 8192), 16, 0, 0); } while (0)
#define PG8_LDA(dst, b, h) do { _Pragma("unroll") for (int m = 0; m < 4; ++m) _Pragma("unroll") for (int k = 0; k < 2; ++k) dst[m][k] = *(const PG8_LAS bf16x8*)(lds + PG8_SA(b, h) + aoff + m * 2048 + k * 1024); } while (0)
#define PG8_LDB(dst, b, h) do { _Pragma("unroll") for (int n = 0; n < 2; ++n) _Pragma("unroll") for (int k = 0; k < 2; ++k) dst[n][k] = *(const PG8_LAS bf16x8*)(lds + PG8_SB(b, h) + boff + n * 2048 + k * 1024); } while (0)
#define PG8_MMA(ai, bj, At, Bt) do { __builtin_amdgcn_s_setprio(1); _Pragma("unroll") for (int m = 0; m < 4; ++m) _Pragma("unroll") for (int n = 0; n < 2; ++n) _Pragma("unroll") for (int k = 0; k < 2; ++k) \
        acc[ai][bj][m][n] = __builtin_amdgcn_mfma_f32_16x16x32_bf16(Bt[n][k], At[m][k], acc[ai][bj][m][n], 0, 0, 0); __builtin_amdgcn_s_setprio(0); } while (0)
#define PG8_WAIT_V(n) asm volatile("s_waitcnt vmcnt(" #n ")" ::: "memory")
#define PG8_WAIT_L(n) asm volatile("s_waitcnt lgkmcnt(" #n ")" ::: "memory")
#define PG8_BAR __builtin_amdgcn_s_barrier()
#define PG8_SCHED __builtin_amdgcn_sched_barrier(0)
    Unit cur, nxt; int ui = 0;
    if (!S.next(0, cur)) return;
    f32x4 acc[2][2][4][2];
#pragma unroll
    for (int a = 0; a < 2; ++a)
#pragma unroll
        for (int b = 0; b < 2; ++b)
#pragma unroll
            for (int m = 0; m < 4; ++m)
#pragma unroll
                for (int n = 0; n < 2; ++n) acc[a][b][m][n] = (f32x4){0.f, 0.f, 0.f, 0.f};
    bf16x8 At[4][2], B0[2][2], B1[2][2];
    const char* cA = (const char*)g.A + (size_t)cur.pm * tstep; const char* cB = (const char*)g.Bt + (size_t)cur.pn * tstep;
    S.a_ready(cur);
    if constexpr (SP2) {
        PG8_STAGE(PG8_SB(0, 0), cB, voffB); PG8_STAGE(PG8_SB(0, 1), cB + hstep, voffB); PG8_STAGE(PG8_SA(0, 0), cA, voffA); PG8_STAGE(PG8_SA(0, 1), cA + hstep, voffA);
        if (wr == 1) PG8_BAR;
        PG8_WAIT_V(2); PG8_BAR;
        PG8_STAGE(PG8_SB(1, 0), cB + kstep, voffB); PG8_STAGE(PG8_SA(1, 0), cA + kstep, voffA); PG8_STAGE(PG8_SB(1, 1), cB + hstep + kstep, voffB);
        if constexpr (RELAX) { PG8_STAGE(PG8_SA(1, 1), cA + hstep + kstep, voffA); PG8_WAIT_V(8); } else PG8_WAIT_V(6);
        PG8_BAR;
    } else {
        PG8_STAGE(PG8_SB(0, 0), cB, voffB); PG8_STAGE(PG8_SA(0, 0), cA, voffA); PG8_STAGE(PG8_SB(0, 1), cB + hstep, voffB); PG8_STAGE(PG8_SA(0, 1), cA + hstep, voffA);
        if (wr == 1) PG8_BAR;
        PG8_WAIT_V(4); PG8_BAR;
        PG8_STAGE(PG8_SB(1, 0), cB + kstep, voffB); PG8_STAGE(PG8_SA(1, 0), cA + kstep, voffA); PG8_STAGE(PG8_SB(1, 1), cB + hstep + kstep, voffB);
        PG8_WAIT_V(6); PG8_BAR;
    }
#define PG8_WAIT_VX(fresh) do { if constexpr (RELAX) asm volatile("s_cmp_lg_u32 %0, 0\n\ts_cbranch_scc1 1f\n\ts_waitcnt vmcnt(8)\n1:\n\ts_waitcnt vmcnt(%1)" :: "s"(fresh), "n"(8 + Epi::NST) : "memory", "scc"); else PG8_WAIT_V(8); } while (0)
    int pre = 0;
    for (;;) {
        const bool has_next = S.next(ui + 1, nxt);
        const char* nA = has_next ? (const char*)g.A + (size_t)nxt.pm * tstep : cA; const char* nB = has_next ? (const char*)g.Bt + (size_t)nxt.pn * tstep : cB;
        for (int t = 0; t < nt; t += 2) {
            const bool last = (t == nt - 2);
            const char* a1 = cA + (size_t)(t + 1) * kstep;
            const char* a2 = last ? nA : cA + (size_t)(t + 2) * kstep; const char* b2 = last ? nB : cB + (size_t)(t + 2) * kstep;
            const char* a3 = a2 + kstep; const char* b3 = b2 + kstep;
            if (last && has_next) S.a_ready(nxt);
            if constexpr (SP2) {
            const int fresh = RELAX ? __builtin_amdgcn_readfirstlane(t == 0 ? pre : 0) : 0; (void)fresh;
            PG8_LDB(B0, 0, 0); PG8_LDB(B1, 0, 1); PG8_SCHED; PG8_LDA(At, 0, 0); if constexpr (!RELAX) PG8_STAGE(PG8_SA(1, 1), a1 + hstep, voffA);
            PG8_WAIT_VX(fresh); PG8_WAIT_L(0); PG8_BAR; PG8_MMA(0, 0, At, B0); PG8_MMA(0, 1, At, B1); PG8_BAR; PG8_SCHED;
            PG8_LDA(At, 0, 1); PG8_STAGE(PG8_SB(0, 0), b2, voffB); PG8_STAGE(PG8_SB(0, 1), b2 + hstep, voffB); PG8_STAGE(PG8_SA(0, 0), a2, voffA);
            PG8_WAIT_VX(fresh); PG8_WAIT_L(0); PG8_BAR; PG8_MMA(1, 0, At, B0); PG8_MMA(1, 1, At, B1); PG8_BAR; PG8_SCHED;
            PG8_LDB(B0, 1, 0); PG8_LDB(B1, 1, 1); PG8_SCHED; PG8_LDA(At, 1, 0); PG8_STAGE(PG8_SA(0, 1), a2 + hstep, voffA);
            PG8_WAIT_VX(fresh); PG8_WAIT_L(0); PG8_BAR; PG8_MMA(0, 0, At, B0); PG8_MMA(0, 1, At, B1); PG8_BAR; PG8_SCHED;
            PG8_LDA(At, 1, 1); PG8_STAGE(PG8_SB(1, 0), b3, voffB); PG8_STAGE(PG8_SB(1, 1), b3 + hstep, voffB); PG8_STAGE(PG8_SA(1, 0), a3, voffA);
            PG8_WAIT_V(8); PG8_WAIT_L(0); PG8_BAR; PG8_MMA(1, 0, At, B0); PG8_MMA(1, 1, At, B1); PG8_BAR; PG8_SCHED;
            if constexpr (RELAX) { PG8_STAGE(PG8_SA(1, 1), a3 + hstep, voffA); PG8_SCHED; }
            } else {
            PG8_LDB(B0, 0, 0); PG8_SCHED; PG8_LDA(At, 0, 0); PG8_STAGE(PG8_SA(1, 1), a1 + hstep, voffA);
            PG8_WAIT_L(8); PG8_BAR; PG8_WAIT_L(0); PG8_MMA(0, 0, At, B0); PG8_BAR; PG8_SCHED;
            PG8_LDB(B1, 0, 1); PG8_STAGE(PG8_SB(0, 0), b2, voffB);
            PG8_BAR; PG8_WAIT_L(0); PG8_MMA(0, 1, At, B1); PG8_BAR;
            PG8_LDA(At, 0, 1); PG8_STAGE(PG8_SA(0, 0), a2, voffA);
            PG8_BAR; PG8_WAIT_L(0); PG8_MMA(1, 0, At, B0); PG8_BAR; PG8_SCHED;
            PG8_STAGE(PG8_SB(0, 1), b2 + hstep, voffB);
            PG8_WAIT_V(6); PG8_BAR; PG8_MMA(1, 1, At, B1); PG8_BAR;
            PG8_LDB(B0, 1, 0); PG8_SCHED; PG8_LDA(At, 1, 0); PG8_STAGE(PG8_SA(0, 1), a2 + hstep, voffA);
            PG8_WAIT_L(8); PG8_BAR; PG8_WAIT_L(0); PG8_MMA(0, 0, At, B0); PG8_BAR; PG8_SCHED;
            PG8_LDB(B1, 1, 1); PG8_STAGE(PG8_SB(1, 0), b3, voffB);
            PG8_BAR; PG8_WAIT_L(0); PG8_MMA(0, 1, At, B1); PG8_BAR;
            PG8_LDA(At, 1, 1); PG8_STAGE(PG8_SA(1, 0), a3, voffA);
            PG8_BAR; PG8_WAIT_L(0); PG8_MMA(1, 0, At, B0); PG8_BAR; PG8_SCHED;
            PG8_STAGE(PG8_SB(1, 1), b3 + hstep, voffB);
            PG8_WAIT_V(6); PG8_BAR; PG8_MMA(1, 1, At, B1); PG8_BAR;
            }
        }
        if constexpr (ALIGN_EPI) { if (wr == 0) PG8_BAR; }
        if constexpr (!Epi::AFTER_DRAIN) { S.pre_epi(cur); E(acc, cur, wr, wc, fr, fq); S.done(cur); }
        if (!has_next) break;
#pragma unroll
        for (int a = 0; a < 2; ++a)
#pragma unroll
            for (int b = 0; b < 2; ++b)
#pragma unroll
                for (int m = 0; m < 4; ++m)
#pragma unroll
                    for (int n = 0; n < 2; ++n) acc[a][b][m][n] = (f32x4){0.f, 0.f, 0.f, 0.f};
        cur = nxt; cA = nA; cB = nB; ++ui; pre = 1;
        if constexpr (ALIGN_EPI) { if (wr == 1) PG8_BAR; }
    }
    PG8_WAIT_V(0);
    if constexpr (!ALIGN_EPI) { if (wr == 0) PG8_BAR; }
    PG8_BAR;
    if constexpr (Epi::AFTER_DRAIN) { E.fused(acc, cur, wr, wc, fr, fq, lds, wid, lane); S.done(cur); }
#undef PG8_SA
#undef PG8_SB
#undef PG8_STAGE
#undef PG8_LDA
#undef PG8_LDB
#undef PG8_MMA
#undef PG8_WAIT_V
#undef PG8_WAIT_L
#undef PG8_WAIT_VX
#undef PG8_BAR
#undef PG8_SCHED
}
}
namespace att {
#define ATT_LAS __attribute__((address_space(3)))
typedef unsigned short bf16_t;
using bf16x8 = __attribute__((ext_vector_type(8))) short;
using s16x4  = __attribute__((ext_vector_type(4))) short;
using f32x16 = __attribute__((ext_vector_type(16))) float;
using u32x4  = __attribute__((ext_vector_type(4))) unsigned;
constexpr int NW = 8, QBLK = 32, KVBLK = 64;
constexpr int SHM_K = 64 * 256, SHM_V = 64 * 64 * 2;
constexpr int NBUF = 5;
constexpr int LDS_BYTES = NBUF * SHM_V + NBUF * SHM_K + NW * 64 * 4;
constexpr int LDS_TOTAL = LDS_BYTES + NW * 4096;
constexpr float THR = 8.f;
#define KSWZ(row, colB) ((row) * 256 + ((colB) ^ (((row) & 15) << 4)))
#define ATT_SBAR() __builtin_amdgcn_sched_barrier(0)
__device__ __forceinline__ int crow(int r, int hi) { return (r & 3) + 8 * (r >> 2) + 4 * hi; }
__device__ __forceinline__ unsigned cvtpk(float lo, float hi) { unsigned r; asm volatile("v_cvt_pk_bf16_f32 %0, %1, %2" : "=v"(r) : "v"(lo), "v"(hi)); return r; }

template <bool FIRST>
__device__ __forceinline__ void partialSM(f32x16& p0, f32x16& p1, float& m_reg, f32x16& negm, float& alpha) {
  float pmax = p0[0];
#pragma unroll
  for (int r = 1; r < 16; ++r) pmax = fmaxf(pmax, p0[r]);
#pragma unroll
  for (int r = 0; r < 16; ++r) pmax = fmaxf(pmax, p1[r]);
  { auto rr = __builtin_amdgcn_permlane32_swap(__float_as_uint(pmax), __float_as_uint(pmax), false, false);
    pmax = fmaxf(__uint_as_float(rr[0]), __uint_as_float(rr[1])); }
  alpha = 1.f;
  if (FIRST || __builtin_expect(__any(pmax > THR), 0)) {
    const float dl = FIRST ? pmax : fmaxf(pmax, 0.f);
    m_reg += dl;
#pragma unroll
    for (int r = 0; r < 16; ++r) { p0[r] -= dl; p1[r] -= dl; }
#pragma unroll
    for (int r = 0; r < 16; ++r) negm[r] = -m_reg;
    if (!FIRST) alpha = __builtin_amdgcn_exp2f(-dl);
  }
}
__device__ __forceinline__ void finishSM(f32x16& p0, f32x16& p1, float alpha, float& l_reg, bf16x8& pa0, bf16x8& pa1, bf16x8& pa2, bf16x8& pa3) {
#pragma unroll
  for (int r = 0; r < 16; ++r) p0[r] = __builtin_amdgcn_exp2f(p0[r]);
#pragma unroll
  for (int r = 0; r < 16; ++r) p1[r] = __builtin_amdgcn_exp2f(p1[r]);
  float ps = 0;
#pragma unroll
  for (int r = 0; r < 16; ++r) ps += p0[r];
#pragma unroll
  for (int r = 0; r < 16; ++r) ps += p1[r];
  { auto rr = __builtin_amdgcn_permlane32_swap(__float_as_uint(ps), __float_as_uint(ps), false, false);
    ps = __uint_as_float(rr[0]) + __uint_as_float(rr[1]); }
  l_reg = l_reg * alpha + ps;
#define ATT_PK4(P, BASE, OUT) do { unsigned a0 = cvtpk(P[BASE + 0], P[BASE + 1]), a1 = cvtpk(P[BASE + 2], P[BASE + 3]);   \
    unsigned b0 = cvtpk(P[BASE + 4], P[BASE + 5]), b1 = cvtpk(P[BASE + 6], P[BASE + 7]);                              \
    auto r0 = __builtin_amdgcn_permlane32_swap(a0, b0, false, false); auto r1 = __builtin_amdgcn_permlane32_swap(a1, b1, false, false); \
    u32x4 w = {r0[0], r1[0], r0[1], r1[1]}; OUT = __builtin_bit_cast(bf16x8, w); } while (0)
  ATT_PK4(p0, 0, pa0); ATT_PK4(p0, 8, pa1); ATT_PK4(p1, 0, pa2); ATT_PK4(p1, 8, pa3);
#undef ATT_PK4
}
__device__ __forceinline__ void qkt(f32x16& p0, f32x16& p1, const ATT_LAS char* Ks, const bf16x8* qr, const f32x16& negm, int r32, int hi) {
#pragma unroll
  for (int d0 = 0; d0 < 6; ++d0) { const int cb = (d0 * 16 + hi * 8) * 2;
    const bf16x8 b0 = *(const ATT_LAS bf16x8*)(Ks + KSWZ(r32, cb));
    const bf16x8 b1 = *(const ATT_LAS bf16x8*)(Ks + KSWZ(32 + r32, cb));
    if (d0 == 0) { p0 = __builtin_amdgcn_mfma_f32_32x32x16_bf16(b0, qr[0], negm, 0, 0, 0); p1 = __builtin_amdgcn_mfma_f32_32x32x16_bf16(b1, qr[0], negm, 0, 0, 0); }
    else { p0 = __builtin_amdgcn_mfma_f32_32x32x16_bf16(b0, qr[d0], p0, 0, 0, 0); p1 = __builtin_amdgcn_mfma_f32_32x32x16_bf16(b1, qr[d0], p1, 0, 0, 0); } }
}
__device__ __forceinline__ int v_st(int k, int c) { const int kk = (k & ~0xC) | ((k & 4) << 1) | ((k & 8) >> 1); return ((kk >> 3) * 2 + (c >> 5)) * 512 + ((kk & 7) * 32 + (c & 31)) * 2; }
__device__ __forceinline__ int v_rd_base(int lane) { return ((lane & 3) << 3) | (((lane >> 2) & 3) << 6) | (((lane >> 4) & 1) << 5) | (((lane >> 5) & 1) << 8); }
constexpr int v_rd_off(int d0, int ks, int half) { return d0 * 512 + ks * 2048 + half * 1024; }
template <int OFF> __device__ __forceinline__ s16x4 tr_read(int vb) {
  s16x4 r; asm volatile("ds_read_b64_tr_b16 %0, %1 offset:%2" : "=&v"(r) : "v"(vb), "i"(OFF) : "memory"); return r;
}
__device__ __forceinline__ void pv_d0(f32x16* o, int vb, bf16x8 pa0, bf16x8 pa1, bf16x8 pa2, bf16x8 pa3) {
  const s16x4 l0 = tr_read<v_rd_off(0, 0, 0)>(vb), h0 = tr_read<v_rd_off(0, 0, 1)>(vb), l1 = tr_read<v_rd_off(0, 1, 0)>(vb), h1 = tr_read<v_rd_off(0, 1, 1)>(vb);
  const s16x4 l2 = tr_read<v_rd_off(0, 2, 0)>(vb), h2 = tr_read<v_rd_off(0, 2, 1)>(vb), l3 = tr_read<v_rd_off(0, 3, 0)>(vb), h3 = tr_read<v_rd_off(0, 3, 1)>(vb);
  const s16x4 m0 = tr_read<v_rd_off(1, 0, 0)>(vb), n0 = tr_read<v_rd_off(1, 0, 1)>(vb), m1 = tr_read<v_rd_off(1, 1, 0)>(vb), n1 = tr_read<v_rd_off(1, 1, 1)>(vb);
  const s16x4 m2 = tr_read<v_rd_off(1, 2, 0)>(vb), n2 = tr_read<v_rd_off(1, 2, 1)>(vb), m3 = tr_read<v_rd_off(1, 3, 0)>(vb), n3 = tr_read<v_rd_off(1, 3, 1)>(vb);
#define ATT_PK(L, H) (bf16x8){L[0], L[1], L[2], L[3], H[0], H[1], H[2], H[3]}
  asm volatile("s_waitcnt lgkmcnt(8)" ::: "memory"); ATT_SBAR();
  o[0] = __builtin_amdgcn_mfma_f32_32x32x16_bf16(pa0, ATT_PK(l0, h0), o[0], 0, 0, 0);
  o[0] = __builtin_amdgcn_mfma_f32_32x32x16_bf16(pa1, ATT_PK(l1, h1), o[0], 0, 0, 0);
  o[0] = __builtin_amdgcn_mfma_f32_32x32x16_bf16(pa2, ATT_PK(l2, h2), o[0], 0, 0, 0);
  o[0] = __builtin_amdgcn_mfma_f32_32x32x16_bf16(pa3, ATT_PK(l3, h3), o[0], 0, 0, 0);
  asm volatile("s_waitcnt lgkmcnt(0)" ::: "memory"); ATT_SBAR();
  o[1] = __builtin_amdgcn_mfma_f32_32x32x16_bf16(pa0, ATT_PK(m0, n0), o[1], 0, 0, 0);
  o[1] = __builtin_amdgcn_mfma_f32_32x32x16_bf16(pa1, ATT_PK(m1, n1), o[1], 0, 0, 0);
  o[1] = __builtin_amdgcn_mfma_f32_32x32x16_bf16(pa2, ATT_PK(m2, n2), o[1], 0, 0, 0);
  o[1] = __builtin_amdgcn_mfma_f32_32x32x16_bf16(pa3, ATT_PK(m3, n3), o[1], 0, 0, 0);
#undef ATT_PK
}
__device__ __forceinline__ void finish_pv(f32x16& p0, f32x16& p1, float alpha, float& l_reg, f32x16* o, int vb) {
#pragma unroll
  for (int r = 0; r < 16; ++r) p0[r] = __builtin_amdgcn_exp2f(p0[r]);
#pragma unroll
  for (int r = 0; r < 16; ++r) p1[r] = __builtin_amdgcn_exp2f(p1[r]);
  float ps = 0;
#pragma unroll
  for (int r = 0; r < 16; ++r) ps += p0[r];
#pragma unroll
  for (int r = 0; r < 16; ++r) ps += p1[r];
  { auto rr = __builtin_amdgcn_permlane32_swap(__float_as_uint(ps), __float_as_uint(ps), false, false);
    ps = __uint_as_float(rr[0]) + __uint_as_float(rr[1]); }
  l_reg = l_reg * alpha + ps;
  ATT_SBAR();
  const s16x4 l0 = tr_read<v_rd_off(0, 0, 0)>(vb), h0 = tr_read<v_rd_off(0, 0, 1)>(vb), l1 = tr_read<v_rd_off(0, 1, 0)>(vb), h1 = tr_read<v_rd_off(0, 1, 1)>(vb);
  const s16x4 l2 = tr_read<v_rd_off(0, 2, 0)>(vb), h2 = tr_read<v_rd_off(0, 2, 1)>(vb), l3 = tr_read<v_rd_off(0, 3, 0)>(vb), h3 = tr_read<v_rd_off(0, 3, 1)>(vb);
  ATT_SBAR();
  bf16x8 pa0, pa1, pa2, pa3;
#define ATT_PK4(P, BASE, OUT) do { unsigned a0 = cvtpk(P[BASE + 0], P[BASE + 1]), a1 = cvtpk(P[BASE + 2], P[BASE + 3]);   \
    unsigned b0 = cvtpk(P[BASE + 4], P[BASE + 5]), b1 = cvtpk(P[BASE + 6], P[BASE + 7]);                              \
    auto r0 = __builtin_amdgcn_permlane32_swap(a0, b0, false, false); auto r1 = __builtin_amdgcn_permlane32_swap(a1, b1, false, false); \
    u32x4 w = {r0[0], r1[0], r0[1], r1[1]}; OUT = __builtin_bit_cast(bf16x8, w); } while (0)
  ATT_PK4(p0, 0, pa0); ATT_PK4(p0, 8, pa1); ATT_PK4(p1, 0, pa2); ATT_PK4(p1, 8, pa3);
#undef ATT_PK4
#define ATT_PK(L, H) (bf16x8){L[0], L[1], L[2], L[3], H[0], H[1], H[2], H[3]}
  ATT_SBAR();
  const s16x4 m0 = tr_read<v_rd_off(1, 0, 0)>(vb), n0 = tr_read<v_rd_off(1, 0, 1)>(vb), m1 = tr_read<v_rd_off(1, 1, 0)>(vb), n1 = tr_read<v_rd_off(1, 1, 1)>(vb);
  const s16x4 m2 = tr_read<v_rd_off(1, 2, 0)>(vb), n2 = tr_read<v_rd_off(1, 2, 1)>(vb), m3 = tr_read<v_rd_off(1, 3, 0)>(vb), n3 = tr_read<v_rd_off(1, 3, 1)>(vb);
  asm volatile("s_waitcnt lgkmcnt(8)" ::: "memory"); ATT_SBAR();
  o[0] = __builtin_amdgcn_mfma_f32_32x32x16_bf16(pa0, ATT_PK(l0, h0), o[0], 0, 0, 0);
  o[0] = __builtin_amdgcn_mfma_f32_32x32x16_bf16(pa1, ATT_PK(l1, h1), o[0], 0, 0, 0);
  o[0] = __builtin_amdgcn_mfma_f32_32x32x16_bf16(pa2, ATT_PK(l2, h2), o[0], 0, 0, 0);
  o[0] = __builtin_amdgcn_mfma_f32_32x32x16_bf16(pa3, ATT_PK(l3, h3), o[0], 0, 0, 0);
  asm volatile("s_waitcnt lgkmcnt(0)" ::: "memory"); ATT_SBAR();
  o[1] = __builtin_amdgcn_mfma_f32_32x32x16_bf16(pa0, ATT_PK(m0, n0), o[1], 0, 0, 0);
  o[1] = __builtin_amdgcn_mfma_f32_32x32x16_bf16(pa1, ATT_PK(m1, n1), o[1], 0, 0, 0);
  o[1] = __builtin_amdgcn_mfma_f32_32x32x16_bf16(pa2, ATT_PK(m2, n2), o[1], 0, 0, 0);
  o[1] = __builtin_amdgcn_mfma_f32_32x32x16_bf16(pa3, ATT_PK(m3, n3), o[1], 0, 0, 0);
#undef ATT_PK
}
__device__ __forceinline__ float bf2f(unsigned short b) { return __uint_as_float((unsigned)b << 16); }
__device__ __forceinline__ unsigned short f2bf(float f) { unsigned u = __float_as_uint(f); return (unsigned short)((u + 0x7fffu + ((u >> 16) & 1u)) >> 16); }

struct AU { int qrow0, h, kb0, nt0, kb1, NT; };
__device__ __forceinline__ void attn_unit(const bf16_t* __restrict__ Q, const bf16_t* __restrict__ KV, const bf16_t* __restrict__ KR, bf16_t* SG,
                                          const AU u, const AU nx, const bool first, const bool has_next, int& g, ATT_LAS char* lds) {
  const int qrow0 = u.qrow0, h = u.h, kb0 = u.kb0, nt0 = u.nt0, kb1 = u.kb1, NT = u.NT;
  const int tid = threadIdx.x, wid = tid >> 6, lane = tid & 63, r32 = lane & 31, hi = lane >> 5;
  ATT_LAS char* V_lds = lds; ATT_LAS char* K_lds = lds + NBUF * SHM_V;
  ATT_LAS float* ws = (ATT_LAS float*)(lds + NBUF * SHM_V + NBUF * SHM_K) + wid * 64; ATT_LAS float* li_l = ws; ATT_LAS float* al_l = ws + 32;
  float m_reg = 0.f, l_reg = 0.f; f32x16 o[2] = {}; f32x16 negm = {}; bf16x8 qr[6];
  const bf16_t* Qw = Q + (size_t)(qrow0 + wid * QBLK + r32) * 1536 + h * 96 + hi * 8;
#pragma unroll
  for (int d0 = 0; d0 < 6; ++d0) qr[d0] = *(const bf16x8*)(Qw + d0 * 16);
  const int wu = __builtin_amdgcn_readfirstlane(wid);
  int offK[4], offV[2]; bool isR[4];
#pragma unroll
  for (int a_ = 0; a_ < 4; ++a_) { const int q_ = 4 * (wid & 3) + a_, r_ = 4 * q_ + (lane >> 4), c_ = (lane & 15) ^ (r_ & 15);
    isR[a_] = c_ >= 8 && c_ < 12; offK[a_] = isR[a_] ? r_ * 64 + (c_ - 8) * 16 : r_ * 4096 + h * 256 + (c_ < 8 ? c_ : 0) * 16; }
#pragma unroll
  for (int a_ = 0; a_ < 2; ++a_) { const int P = 64 * (2 * (wid & 3) + a_) + lane, sub = P >> 5, w_ = P & 31, kk = (sub >> 1) * 8 + (w_ >> 2), cc = (sub & 1) * 32 + (w_ & 3) * 8, k_ = (kk & ~0xC) | ((kk & 4) << 1) | ((kk & 8) >> 1);
    offV[a_] = k_ * 4096 + h * 256 + 128 + cc * 2; }
#define ATT_TBASE(t) ((t) < nt0 ? kb0 + (t) * KVBLK : kb1 + ((t) - nt0) * KVBLK)
#define ATT_DMA(t, slot) ATT_DMA_RB(ATT_TBASE(t), 0, slot)
#define ATT_DMA_N(t, slot) ATT_DMA_RB(((t) < nx.nt0 ? nx.kb0 + (t) * KVBLK : nx.kb1 + ((t) - nx.nt0) * KVBLK), (nx.h - h) * 256, slot)
#define ATT_DMA_RB(rowb, hd, slot) do { if (wu < 4) { const size_t rb_ = (size_t)(rowb); const char* kvb_ = (const char*)KV + rb_ * 4096 + (hd); const char* krb_ = (const char*)KR + rb_ * 64; \
    _Pragma("unroll") for (int a_ = 0; a_ < 4; ++a_) __builtin_amdgcn_global_load_lds((const unsigned*)((isR[a_] ? krb_ : kvb_) + offK[a_]), (ATT_LAS unsigned*)(K_lds + (slot) * SHM_K + (4 * wu + a_) * 1024), 16, 0, 0); \
    _Pragma("unroll") for (int a_ = 0; a_ < 2; ++a_) __builtin_amdgcn_global_load_lds((const unsigned*)(kvb_ + offV[a_]), (ATT_LAS unsigned*)(V_lds + (slot) * SHM_V + (2 * wu + a_) * 1024), 16, 0, 0); } } while (0)
#define ATT_DMA_SYNC() do { asm volatile("s_waitcnt vmcnt(0)" ::: "memory"); __syncthreads(); } while (0)
  const int vb0 = (int)(unsigned)(size_t)V_lds + v_rd_base(lane);
#define ATT_RESC(a) do { if (__any((a) < 1.f)) { if (hi == 0) al_l[r32] = (a); asm volatile("s_waitcnt lgkmcnt(0)" ::: "memory"); \
    _Pragma("unroll") for (int d = 0; d < 2; ++d) _Pragma("unroll") for (int r = 0; r < 16; ++r) o[d][r] *= al_l[crow(r, hi)]; } } while (0)
#define ATT_M5(x) ((x) >= 5 ? (x) - 5 : (x))
  f32x16 pA0, pA1, pB0, pB1; float alA, alB; bf16x8 pa0, pa1, pa2, pa3;
  if (first) { ATT_DMA(0, g); ATT_DMA(1, ATT_M5(g + 1)); ATT_DMA(2, ATT_M5(g + 2)); }
  ATT_DMA_SYNC();
  qkt(pA0, pA1, K_lds + g * SHM_K, qr, negm, r32, hi); partialSM<true>(pA0, pA1, m_reg, negm, alA);
  int b = ATT_M5(g + 1);
  for (int j = 1; j + 1 < NT; j += 2) {
    if (j + 2 < NT) ATT_DMA(j + 2, ATT_M5(b + 2));
    ATT_SBAR(); qkt(pB0, pB1, K_lds + b * SHM_K, qr, negm, r32, hi);
    finish_pv(pA0, pA1, alA, l_reg, o, vb0 + ATT_M5(b + 4) * SHM_V); partialSM<false>(pB0, pB1, m_reg, negm, alB);
    ATT_RESC(alB);
    if (j + 3 < NT) ATT_DMA(j + 3, ATT_M5(b + 3));
    ATT_SBAR(); qkt(pA0, pA1, K_lds + ATT_M5(b + 1) * SHM_K, qr, negm, r32, hi);
    finish_pv(pB0, pB1, alB, l_reg, o, vb0 + b * SHM_V); partialSM<false>(pA0, pA1, m_reg, negm, alA);
    ATT_RESC(alA); ATT_DMA_SYNC(); b = ATT_M5(b + 2);
  }
  if (has_next) { ATT_DMA_N(0, ATT_M5(b + 1)); ATT_DMA_N(1, ATT_M5(b + 2)); ATT_DMA_N(2, ATT_M5(b + 3)); }
  ATT_SBAR(); qkt(pB0, pB1, K_lds + b * SHM_K, qr, negm, r32, hi);
  finish_pv(pA0, pA1, alA, l_reg, o, vb0 + ATT_M5(b + 4) * SHM_V); partialSM<false>(pB0, pB1, m_reg, negm, alB);
  ATT_RESC(alB);
  finish_pv(pB0, pB1, alB, l_reg, o, vb0 + b * SHM_V);
  if (hi == 0) li_l[r32] = l_reg; asm volatile("s_waitcnt lgkmcnt(0)" ::: "memory");
  float rli[16];
#pragma unroll
  for (int r = 0; r < 16; ++r) rli[r] = __builtin_amdgcn_rcpf(li_l[crow(r, hi)]);
  bf16_t* Ow = SG + (size_t)(qrow0 + wid * QBLK) * 1024 + h * 64 + r32;
#pragma unroll
  for (int r = 0; r < 16; ++r) { const int orow = crow(r, hi);
#pragma unroll
    for (int d0 = 0; d0 < 2; ++d0) { bf16_t* p = Ow + (size_t)orow * 1024 + d0 * 32; *p = f2bf(o[d0][r] * rli[r] * bf2f(*p)); } }
  g = ATT_M5(b + 1);
#undef ATT_TBASE
#undef ATT_DMA
#undef ATT_DMA_N
#undef ATT_DMA_RB
#undef ATT_DMA_SYNC
#undef ATT_RESC
#undef ATT_M5
}
#undef KSWZ
}
#define GAS __attribute__((address_space(1)))
#define LAS __attribute__((address_space(3)))
typedef unsigned short bf16;
typedef unsigned v4u __attribute__((ext_vector_type(4)));
typedef float f32x4 __attribute__((ext_vector_type(4)));
typedef short bf16x8 __attribute__((ext_vector_type(8)));
typedef GAS unsigned gu32;
typedef GAS unsigned long long gu64;
#define RLX_AGENT __ATOMIC_RELAXED, __HIP_MEMORY_SCOPE_AGENT
#define LDS_WAIT() asm volatile("s_waitcnt lgkmcnt(0)" ::: "memory")
#define VM_WAIT() asm volatile("s_waitcnt vmcnt(0)" ::: "memory")
__device__ __forceinline__ unsigned long long rt() { return __builtin_amdgcn_s_memrealtime(); }
__device__ __forceinline__ unsigned f2bf(float f) { unsigned u = __builtin_bit_cast(unsigned, f); return (u + 0x7fffu + ((u >> 16) & 1u)) >> 16; }
__device__ __forceinline__ unsigned pk2(float lo, float hi) { return f2bf(lo) | (f2bf(hi) << 16); }

#define XB_TMO      128
#define XB_XCNT(j)  (256  + 64 * (j))
#define XB_XSUB(j)  (1280 + 64 * (j))
#define XB_XGEN(j)  (2304 + 64 * (j))
#define XB_TOP      3328
#define XB_TOPGEN   3392
#define XCD_BAR_WORDS 3456
#define XB_SPIN_CAP (1u << 18)

__device__ __forceinline__ unsigned xb_ld(unsigned* p)              { return __hip_atomic_load(p, __ATOMIC_RELAXED, __HIP_MEMORY_SCOPE_AGENT); }
__device__ __forceinline__ unsigned xb_add(unsigned* p, unsigned v) { return __hip_atomic_fetch_add(p, v, __ATOMIC_RELAXED, __HIP_MEMORY_SCOPE_AGENT); }
__device__ __forceinline__ unsigned xb_xcc_id() { return (unsigned)__builtin_amdgcn_s_getreg((3 << 11) | 20) & 0xFu; }
#define XB_SPIN(cond, bar) do { unsigned _sp = 0; while (cond) { __builtin_amdgcn_s_sleep(1); \
    if ((++_sp & 255u) == 0u) { if (xb_ld(&(bar)[XB_TMO])) break; if (_sp > XB_SPIN_CAP) { atomicAdd(&(bar)[XB_TMO], 1u); break; } } } } while (0)

struct XcdBarrier {
    unsigned* bar; unsigned x;
    volatile LAS unsigned* st;
};

__device__ __forceinline__ XcdBarrier xcd_barrier_post(unsigned* bar, volatile LAS unsigned* st) {
    XcdBarrier b; b.bar = bar; b.x = xb_xcc_id(); b.st = st;
    if (threadIdx.x == 0) (void)xb_add(&bar[XB_XCNT(b.x)], 1u);
    return b;
}
__device__ __forceinline__ void xcd_barrier_complete(unsigned* bar, unsigned x, unsigned& nloc, unsigned& nx) {
    const unsigned G = gridDim.x * gridDim.y * gridDim.z;
    unsigned sum, cnt, mine, sp = 0u;
    for (;;) {
        sum = 0u; cnt = 0u; mine = 0u;
#pragma unroll
        for (unsigned j = 0; j < 16; ++j) { const unsigned c = xb_ld(&bar[XB_XCNT(j)]); sum += c; cnt += (c > 0u) ? 1u : 0u; mine = (j == x) ? c : mine; }
        if (sum == G) break;
        __builtin_amdgcn_s_sleep(1);
        if ((++sp & 255u) == 0u) { if (xb_ld(&bar[XB_TMO])) break; if (sp > XB_SPIN_CAP) { atomicAdd(&bar[XB_TMO], 1u); break; } }
    }
    nloc = mine > 0u ? mine : 1u; nx = cnt > 0u ? cnt : 1u;
}

__device__ __forceinline__ void xcd_barrier(const XcdBarrier& b) {
    asm volatile("s_waitcnt vmcnt(0)" ::: "memory");
    __syncthreads();
    if (threadIdx.x == 0) {
        unsigned* bar = b.bar;
        __builtin_amdgcn_s_waitcnt(0);
        unsigned nloc = b.st[0], nx = b.st[1];
        if (nloc == 0u) { xcd_barrier_complete(bar, b.x, nloc, nx); b.st[0] = nloc; b.st[1] = nx; }
        const unsigned old = xb_add(&bar[XB_XSUB(b.x)], 1u);
        const unsigned gen = old / nloc;
        if (old + 1u == (gen + 1u) * nloc) {
            __builtin_amdgcn_fence(__ATOMIC_RELEASE, "agent");
            asm volatile("s_waitcnt vmcnt(0)" ::: "memory");
            const unsigned og = xb_add(&bar[XB_TOP], 1u);
            const unsigned tg = og / nx;
            if (og + 1u == (tg + 1u) * nx) xb_add(&bar[XB_TOPGEN], 1u);
            else XB_SPIN(xb_ld(&bar[XB_TOPGEN]) == tg, bar);
            __builtin_amdgcn_fence(__ATOMIC_ACQUIRE, "agent");
            xb_add(&bar[XB_XGEN(b.x)], 1u);
            asm volatile("s_waitcnt vmcnt(0)" ::: "memory");
        } else {
            XB_SPIN(xb_ld(&bar[XB_XGEN(b.x)]) == gen, bar);
            __builtin_amdgcn_fence(__ATOMIC_ACQUIRE, "agent");
            asm volatile("s_waitcnt vmcnt(0)" ::: "memory");
        }
    }
    __syncthreads();
}
constexpr int CW_C1 = 512, CW_C2 = 576, CW_C3 = 640, CW_C4 = 704;
struct InOrder {
    int x, j; unsigned* c1; unsigned* c2;
    __device__ __forceinline__ bool next(int i, pg8::Unit& u) const { const int e = j + 32 * i; if (e >= 70) return false;
        if (e < 30) { u.pn = e / 10; u.pm = 10 * x + e % 10; } else { const int g = e - 30; u.pn = 3 + g / 10; u.pm = 10 * x + g % 10; } return true; }
    __device__ __forceinline__ void a_ready(const pg8::Unit&) const {}
    __device__ __forceinline__ int entry(const pg8::Unit& u) const { return u.pn <= 2 ? u.pn * 10 + (u.pm - 10 * x) : 30 + (u.pn - 3) * 10 + (u.pm - 10 * x); }
    __device__ __forceinline__ void pre_epi(const pg8::Unit&) const {}
    __device__ __forceinline__ void done(const pg8::Unit& u) const {
        const bool lat = u.pn <= 2, lastu = entry(u) + 32 >= 70;
        if (lat || lastu) {
            asm volatile("s_waitcnt vmcnt(0)" ::: "memory");
            __builtin_amdgcn_s_barrier();
            if (threadIdx.x == 0) { if (lat) (void)xb_add(c1, 1u); if (lastu) (void)xb_add(c2, 1u); } }
    }
};
struct QUpOrder {
    int x, q0, nq;
    __device__ __forceinline__ bool next(int i, pg8::Unit& u) const { if (i >= nq) return false; const int q = q0 + i; u.pm = 10 * x + q / 6; u.pn = q % 6; return true; }
    __device__ __forceinline__ void a_ready(const pg8::Unit&) const {}
    __device__ __forceinline__ void pre_epi(const pg8::Unit&) const {}
    __device__ __forceinline__ void done(const pg8::Unit&) const {}
};
struct KvUpOrder {
    int x, k0, nk; unsigned* c2;
    __device__ __forceinline__ bool next(int i, pg8::Unit& u) const { if (i >= nk) return false; const int k = k0 + i; u.pm = 11 * x + k / 8; u.pn = k % 8; return true; }
    __device__ __forceinline__ void a_ready(const pg8::Unit& u) const {
        if (u.pm < 40) { unsigned sp = 0; while (xb_ld(c2) < 256u) { __builtin_amdgcn_s_sleep(2); if (++sp > (1u << 22)) break; } asm volatile("" ::: "memory"); }
    }
    __device__ __forceinline__ void pre_epi(const pg8::Unit&) const {}
    __device__ __forceinline__ void done(const pg8::Unit&) const {}
};
struct TailOrder {
    pg8::StaticOrder S; unsigned* ctr;
    __device__ __forceinline__ bool next(int i, pg8::Unit& u) const { return S.next(i, u); }
    __device__ __forceinline__ void a_ready(const pg8::Unit&) const {}
    __device__ __forceinline__ void pre_epi(const pg8::Unit&) const {}
    __device__ __forceinline__ void done(const pg8::Unit&) const { asm volatile("s_waitcnt vmcnt(0)" ::: "memory"); __builtin_amdgcn_s_barrier(); if (threadIdx.x == 0) (void)xb_add(ctr, 1u); }
};
__device__ __forceinline__ void wait_count(int tid, unsigned* ctr, unsigned n) {
    if (tid == 0) { unsigned sp = 0; while (xb_ld(ctr) < n) { __builtin_amdgcn_s_sleep(2); if (++sp > (1u << 22)) break; }
        __builtin_amdgcn_fence(__ATOMIC_ACQUIRE, "agent"); asm volatile("s_waitcnt vmcnt(0)" ::: "memory"); }
    __syncthreads();
}
constexpr int NWAVES = 8;
#ifndef MK_N_LAUNCHES
#define MK_N_LAUNCHES 1
#endif
constexpr int NPHASE = 13;
constexpr int N_LAUNCHES = MK_N_LAUNCHES;
static_assert(N_LAUNCHES == 1 || N_LAUNCHES == NPHASE, "MK_N_LAUNCHES is 1 or 13");
using pg8::NCTX; using pg8::MTOK; using pg8::MKV;
constexpr float RMS_EPS = pg8::RMS_EPS;
constexpr size_t MiB = 1u << 20;
constexpr size_t WS_CTL = 0, CTL_ZERO_BYTES = 18 * 1024;
constexpr size_t WS_MOD = 1 * MiB;
constexpr size_t WS_ROPE = 1 * MiB + 512 * 1024;
constexpr size_t WS_SSQKV = 2 * MiB, WS_SSQQ = 2 * MiB + 512 * 1024;
constexpr size_t WS_W1 = 4 * MiB, WS_W2 = 12 * MiB, WS_W3 = 14 * MiB, WS_WQ = 18 * MiB, WS_WKV = 20 * MiB - 512 * 1024, WS_WO = 20 * MiB + 512 * 1024;
constexpr size_t WS_SG = 23 * MiB;
constexpr size_t WS_Q = 63 * MiB;
constexpr size_t WS_KV = 123 * MiB;
constexpr size_t WS_QL = 211 * MiB, WS_CKV = 226 * MiB, WS_KR = 237 * MiB, WS_END = 239 * MiB;
static_assert(WS_W1 + (size_t)4096 * 1024 * 2 <= WS_W2 && WS_W2 + (size_t)1024 * 1024 * 2 <= WS_W3 && WS_W3 + (size_t)1792 * 1024 * 2 <= WS_WQ && WS_WQ + (size_t)1536 * 384 * 2 <= WS_WKV &&
              WS_WKV + (size_t)2048 * 256 * 2 <= WS_WO && WS_WO + (size_t)1024 * 1024 * 2 <= WS_SG && WS_SG + (size_t)MTOK * 1024 * 2 <= WS_Q && WS_Q + (size_t)MTOK * 1536 * 2 <= WS_KV &&
              WS_KV + (size_t)MKV * 2048 * 2 <= WS_QL && WS_QL + (size_t)MTOK * 384 * 2 <= WS_CKV && WS_CKV + (size_t)MKV * 256 * 2 <= WS_KR && WS_KR + (size_t)MKV * 32 * 2 <= WS_END, "d_ws map");
constexpr int CW_ROWCTR = 512;
constexpr int CW_BAR = 1024;
static_assert((CW_BAR + XCD_BAR_WORDS) * 4 <= (int)CTL_ZERO_BYTES - 512 && CW_C1 * 4 >= 2048, "control words inside the memset region");
constexpr int RING_BYTES = 131072, LDSCTL_OFF = RING_BYTES, MISC_OFF = LDSCTL_OFF + 320, LDS_BYTES = 147456;
static_assert(att::LDS_BYTES <= RING_BYTES, "attention scratch fits the ring region");

struct Frame {
    LAS unsigned char* lds; volatile LAS unsigned* MISC;
    int tid, lane, wave, vcu, G;
};
__device__ __forceinline__ float wave_sum(float v) {
#pragma unroll
    for (int o = 1; o < 64; o <<= 1) v += __shfl_xor(v, o);
    return v;
}
__device__ __forceinline__ float silu_acc(float x) { return x / (1.f + expf(-x)); }
__device__ __forceinline__ int grp_of_tok(int t) { return t < NCTX ? 0 : 1 + ((t - NCTX) >> 12); }

__device__ __forceinline__ int w1_dst(int s) { const int part = s >> 10, chg = s & 1023, ch = chg & 63; const int bj = (part == 0 || part == 3) ? 1 : 0, n = (part == 2 || part == 3) ? 1 : 0;
    return 256 * (chg >> 6) + 128 * bj + 32 * (ch >> 4) + 8 * ((ch >> 2) & 3) + 4 * n + (ch & 3); }
template <bool W1MAP = false>
__device__ __forceinline__ void transpose_item(const float* W, int ldw, int s0, bf16* WT, int K, int n0, int k0, LAS float* scr, int lane) {
    const int c = lane & 7;
    if (s0 < 0) {
#pragma unroll
        for (int j = 0; j < 4; ++j) { const int n = (lane >> 3) + 8 * j; *(GAS v4u*)(WT + (size_t)(n0 + n) * K + k0 + 8 * c) = (v4u){0u, 0u, 0u, 0u}; }
        return;
    }
#pragma unroll
    for (int i = 0; i < 32; ++i) { const int kk = 2 * i + (lane >> 5); scr[kk * 33 + (lane & 31)] = __builtin_nontemporal_load(W + (size_t)(k0 + kk) * ldw + s0 + (lane & 31)); }
    LDS_WAIT(); asm volatile("" ::: "memory");
#pragma unroll
    for (int j = 0; j < 4; ++j) { const int n = (lane >> 3) + 8 * j; const LAS float* s = scr + (8 * c) * 33 + n;
        v4u o; o.x = pk2(s[0 * 33], s[1 * 33]); o.y = pk2(s[2 * 33], s[3 * 33]); o.z = pk2(s[4 * 33], s[5 * 33]); o.w = pk2(s[6 * 33], s[7 * 33]);
        *(GAS v4u*)(WT + (size_t)(W1MAP ? w1_dst(s0 + n) : n0 + n) * K + k0 + 8 * c) = o; }
    LDS_WAIT(); asm volatile("" ::: "memory");
}
__device__ __forceinline__ int map_w1(int n0) { const int pn = n0 >> 8, cl = n0 & 255, bjj = cl >> 7, ch = 128 * (pn >> 1) + (cl & 127); const int part = (pn & 1) ? (bjj ? 3 : 0) : (bjj ? 2 : 1); return part * 1024 + ch; }
__device__ __forceinline__ int map_w3(int n0) { return n0 < 256 ? 384 + n0 : n0 < 640 ? n0 - 256 : n0 < 672 ? n0 : n0 < 768 ? -1 : n0 - 96; }

struct Ptrs {
    const float *x_prompt, *x_sample, *cache_ckv, *cache_krope, *c, *c_ctx, *norm_g, *w_mod, *b_mod, *conv_w_in, *conv_w, *conv_w_out, *mla_w_in, *gq, *w_q_up, *gkv, *w_kv_up, *w_out, *final_g;
    float* out; float* st_ckv; float* st_kr;
    float* mod; float* rope; float* ssq_kv; float* ssq_q;
    bf16 *W1, *W2, *W3, *WQ, *WKV, *WO, *SG, *EB, *Q, *KV, *H, *Y, *QL, *CKV, *KR, *DL;
};

__device__ __forceinline__ void phase_p0a(Frame& F, const Ptrs& P) {
    LAS float* sv = (LAS float*)(F.lds);
    LAS float* part = (LAS float*)(F.lds + 20480);
    bool filled = false;
    for (int chunk = blockIdx.x; chunk < 192; chunk += F.G) {
        if (!filled) {
            for (int e = F.tid; e < 5120; e += NWAVES * 64) { const int g = e >> 10, k = e & 1023; sv[e] = silu_acc(g == 0 ? P.c_ctx[k] : P.c[(g - 1) * 1024 + k]); }
            __syncthreads(); filled = true;
        }
        const int i = chunk / 96, cb = (chunk % 96) * 32, col = F.lane & 31, kh = F.lane >> 5;
        const float* w = P.w_mod + (size_t)i * 1024 * 3072 + cb + col;
        float a0 = 0.f, a1 = 0.f, a2 = 0.f, a3 = 0.f, a4 = 0.f;
#pragma unroll 16
        for (int kk = 0; kk < 64; ++kk) { const int k = F.wave * 128 + 2 * kk + kh; const float wv = __builtin_nontemporal_load(w + (size_t)k * 3072);
            a0 += sv[k] * wv; a1 += sv[1024 + k] * wv; a2 += sv[2048 + k] * wv; a3 += sv[3072 + k] * wv; a4 += sv[4096 + k] * wv; }
        a0 += __shfl_xor(a0, 32); a1 += __shfl_xor(a1, 32); a2 += __shfl_xor(a2, 32); a3 += __shfl_xor(a3, 32); a4 += __shfl_xor(a4, 32);
        if (kh == 0) { LAS float* pw = part + F.wave * 160 + col; pw[0] = a0; pw[32] = a1; pw[64] = a2; pw[96] = a3; pw[128] = a4; }
        __syncthreads();
        if (F.tid < 160) { const int g = F.tid >> 5, l = F.tid & 31; float s = 0.f;
#pragma unroll
            for (int wv = 0; wv < 8; ++wv) s += part[wv * 160 + g * 32 + l];
            P.mod[(size_t)(i * 5 + g) * 3072 + cb + l] = s + P.b_mod[i * 3072 + cb + l]; }
        __syncthreads();
    }
    __syncthreads();
    LAS float* scr = (LAS float*)(F.lds + F.wave * 16384);
    const int gw = F.vcu * NWAVES + F.wave, NGW = F.G * NWAVES;
    constexpr int I1 = 16 * 128, I2 = 16 * 32, I3 = 16 * 56, IQ = 6 * 48, IKV = 4 * 64, IO = 16 * 32, NITEMS = I1 + I2 + I3 + IQ + IKV + IO;
    for (int it = gw; it < NITEMS; it += NGW) {
        int r = it;
        if (r < I1) { const int kb = r / 128, nb = r % 128; transpose_item<true>(P.conv_w_in, 4096, 32 * nb, P.W1, 1024, 0, 64 * kb, scr, F.lane); continue; } r -= I1;
        if (r < I2) { const int kb = r / 32, nb = r % 32; transpose_item(P.conv_w_out, 1024, 32 * nb, P.W2, 1024, 32 * nb, 64 * kb, scr, F.lane); continue; } r -= I2;
        if (r < I3) { const int kb = r / 56, nb = r % 56; transpose_item(P.mla_w_in, 1696, map_w3(32 * nb), P.W3, 1024, 32 * nb, 64 * kb, scr, F.lane); continue; } r -= I3;
        if (r < IQ) { const int kb = r / 48, nb = r % 48; transpose_item(P.w_q_up, 1536, 32 * nb, P.WQ, 384, 32 * nb, 64 * kb, scr, F.lane); continue; } r -= IQ;
        if (r < IKV) { const int kb = r / 64, nb = r % 64; transpose_item(P.w_kv_up, 2048, 32 * nb, P.WKV, 256, 32 * nb, 64 * kb, scr, F.lane); continue; } r -= IKV;
        { const int kb = r / 32, nb = r % 32; transpose_item(P.w_out, 1024, 32 * nb, P.WO, 1024, 32 * nb, 64 * kb, scr, F.lane); }
    }
    const int gt = F.vcu * (NWAVES * 64) + F.tid, NGT = F.G * NWAVES * 64;
    for (int i = gt; i < 2048 * 256 / 8; i += NGT) { const f32x4 a = *(const f32x4*)(P.cache_ckv + (size_t)i * 8), b = *(const f32x4*)(P.cache_ckv + (size_t)i * 8 + 4);
        *(v4u*)(P.CKV + (size_t)MTOK * 256 + (size_t)i * 8) = (v4u){pk2(a[0], a[1]), pk2(a[2], a[3]), pk2(b[0], b[1]), pk2(b[2], b[3])}; }
    for (int i = gt; i < 2048 * 32 / 8; i += NGT) { const f32x4 a = *(const f32x4*)(P.cache_krope + (size_t)i * 8), b = *(const f32x4*)(P.cache_krope + (size_t)i * 8 + 4);
        *(v4u*)(P.KR + (size_t)MTOK * 32 + (size_t)i * 8) = (v4u){pk2(a[0], a[1]), pk2(a[2], a[3]), pk2(b[0], b[1]), pk2(b[2], b[3])}; }
    if (blockIdx.x == F.G - 1) { const int p = F.tid >> 3, j = F.tid & 7; const float fr = powf(10000.f, -(float)j * 0.125f); float s, c; sincosf((float)p * fr, &s, &c);
        P.rope[F.tid * 2] = c; P.rope[F.tid * 2 + 1] = s; }
}

constexpr int RPI_DEF = 6;
__device__ __forceinline__ f32x4 bf4_to_f32(unsigned long long w) { f32x4 r; r[0] = __uint_as_float((unsigned)w << 16); r[1] = __uint_as_float((unsigned)w & 0xffff0000u); r[2] = __uint_as_float((unsigned)(w >> 32) << 16); r[3] = __uint_as_float((unsigned)(w >> 32) & 0xffff0000u); return r; }
template <bool HAS_DELTA, bool WRITE_X, int RPI = RPI_DEF>
#define ROWPASS_LOOP_HEAD const int NGWs = NGW; (void)ctr; for (int t0 = r0 + gw; t0 < MTOK; t0 += RPI * NGW) {
#define ROWPASS_LOOP_TAIL }
__device__ __forceinline__ void phase_hnorm(Frame& F, const float* xa, const float* xb, const bf16* delta, float* xout, const float* ng, const float* modl, bf16* H, int r0, int MTOK, int gw, int NGW, unsigned* ctr = nullptr) {
    ROWPASS_LOOP_HEAD
        f32x4 v[RPI][4]; float s[RPI];
#pragma unroll
        for (int r = 0; r < RPI; ++r) { const int t = t0 + r * NGWs; if (t < MTOK) {
            const float* x = t < NCTX ? xa + (size_t)t * 1024 : xb + (size_t)(t - NCTX) * 1024;
#pragma unroll
            for (int j = 0; j < 4; ++j) v[r][j] = __builtin_nontemporal_load((const f32x4*)(x + 4 * (F.lane + 64 * j)));
            if (HAS_DELTA) {
#pragma unroll
                for (int j = 0; j < 4; ++j) v[r][j] += bf4_to_f32(__builtin_nontemporal_load((const unsigned long long*)(delta + (size_t)t * 1024 + 4 * (F.lane + 64 * j)))); } } }
#pragma unroll
        for (int r = 0; r < RPI; ++r) { float a = 0.f; if (t0 + r * NGWs < MTOK) {
#pragma unroll
            for (int j = 0; j < 4; ++j) a += (v[r][j][0] * v[r][j][0] + v[r][j][1] * v[r][j][1]) + (v[r][j][2] * v[r][j][2] + v[r][j][3] * v[r][j][3]); }
            s[r] = a; }
#pragma unroll
        for (int o = 1; o < 64; o <<= 1) {
#pragma unroll
            for (int r = 0; r < RPI; ++r) s[r] += __shfl_xor(s[r], o); }
#pragma unroll
        for (int r = 0; r < RPI; ++r) { const int t = t0 + r * NGWs; if (t < MTOK) {
            const float rstd = 1.0f / sqrtf(s[r] * (1.f / 1024.f) + RMS_EPS);
            const float* sh = modl + grp_of_tok(t) * 3072; const float* sc = sh + 1024;
#pragma unroll
            for (int j = 0; j < 4; ++j) { const int k = 4 * (F.lane + 64 * j);
                if (WRITE_X) __builtin_nontemporal_store(v[r][j], (f32x4*)(xout + (size_t)t * 1024 + k));
                const f32x4 g = *(const f32x4*)(ng + k), a = *(const f32x4*)(sc + k), b = *(const f32x4*)(sh + k);
                const f32x4 o = v[r][j] * rstd * g * (a + 1.f) + b;
                *(unsigned long long*)(H + (size_t)t * 1024 + k) = (unsigned long long)pk2(o[0], o[1]) | ((unsigned long long)pk2(o[2], o[3]) << 32); } } }
    ROWPASS_LOOP_TAIL
}

__device__ __forceinline__ void bf8_to_f32(const v4u& w, float* f) {
    f[0] = __uint_as_float(w.x << 16); f[1] = __uint_as_float(w.x & 0xffff0000u); f[2] = __uint_as_float(w.y << 16); f[3] = __uint_as_float(w.y & 0xffff0000u);
    f[4] = __uint_as_float(w.z << 16); f[5] = __uint_as_float(w.z & 0xffff0000u); f[6] = __uint_as_float(w.w << 16); f[7] = __uint_as_float(w.w & 0xffff0000u);
}
__device__ __forceinline__ void phase_conv(Frame& F, const bf16* V, const bf16* E, const float* cw, bf16* Y) {
    const int gw = F.vcu * NWAVES + F.wave, NGW = F.G * NWAVES;
    const int c0 = (gw & 1) * 512 + F.lane * 8;
    float w0[8], w1[8], w2[8];
#pragma unroll
    for (int i = 0; i < 8; ++i) { w0[i] = cw[c0 + i]; w1[i] = cw[1024 + c0 + i]; w2[i] = cw[2048 + c0 + i]; }
    for (int it = gw; it < MTOK * 2; it += NGW) {
        const int t = it >> 1; int pos, len; if (t < NCTX) { pos = t & 255; len = 256; } else { pos = (t - NCTX) & 4095; len = 4096; }
        const size_t off = (size_t)t * 1024 + c0;
        const v4u z = {0u, 0u, 0u, 0u};
        const v4u vm = pos > 0 ? *(const v4u*)(V + off - 1024) : z, v0 = *(const v4u*)(V + off), vp = pos < len - 1 ? *(const v4u*)(V + off + 1024) : z, ee = __builtin_nontemporal_load((const v4u*)(E + off));
        float fm[8], f0[8], fp[8], fe[8], y[8]; bf8_to_f32(vm, fm); bf8_to_f32(v0, f0); bf8_to_f32(vp, fp); bf8_to_f32(ee, fe);
#pragma unroll
        for (int i = 0; i < 8; ++i) y[i] = fe[i] * (w0[i] * fm[i] + w1[i] * f0[i] + w2[i] * fp[i]);
        *(v4u*)(Y + off) = (v4u){pk2(y[0], y[1]), pk2(y[2], y[3]), pk2(y[4], y[5]), pk2(y[6], y[7])};
    }
}
__device__ __forceinline__ void conv_fix_block(Frame& F, const float* VE, const float* cw, bf16* Y, int pm) {
    if (pm >= 16) { const int k = (pm - 16) & 15, which = F.tid >> 8, c = (F.tid & 255) * 4;
        if (which == 0 ? k > 0 : k < 15) {
            const float* me = VE + (size_t)pm * 6144 + c;
            const f32x4 w0 = *(const f32x4*)(cw + c), w1 = *(const f32x4*)(cw + 1024 + c), w2 = *(const f32x4*)(cw + 2048 + c);
            f32x4 y; int row;
            if (which == 0) { const float* pr = me - 6144; y = *(const f32x4*)(me + 4096) * (w0 * *(const f32x4*)(pr + 3072) + w1 * *(const f32x4*)me + w2 * *(const f32x4*)(me + 1024)); row = 256 * pm; }
            else            { const float* nx = me + 6144; y = *(const f32x4*)(me + 5120) * (w0 * *(const f32x4*)(me + 2048) + w1 * *(const f32x4*)(me + 3072) + w2 * *(const f32x4*)nx); row = 256 * pm + 255; }
            *(unsigned long long*)(Y + (size_t)row * 1024 + c) = (unsigned long long)pk2(y[0], y[1]) | ((unsigned long long)pk2(y[2], y[3]) << 32); } }
    asm volatile("s_waitcnt vmcnt(0)" ::: "memory"); __syncthreads();
}
__device__ __forceinline__ void phase_state_fix(Frame& F, float* st_ckv, const float* ssq_kv) {
    const int gw = F.vcu * NWAVES + F.wave, NGW = F.G * NWAVES;
    for (int t = gw; t < NCTX; t += NGW) { const f32x4 s0 = *(const f32x4*)(ssq_kv + (size_t)t * 4);
        const float rs = 1.0f / sqrtf(((s0[0] + s0[1]) + (s0[2] + s0[3])) * (1.f / 256.f) + RMS_EPS);
        f32x4* p = (f32x4*)(st_ckv + (size_t)t * 256) + F.lane; *p = *p * rs; }
}
template <int RPI = RPI_DEF>
__device__ __forceinline__ void phase_final(Frame& F, float* X, const bf16* delta, const float* g, int r0, int MTOK, int gw, int NGW, unsigned* ctr = nullptr) {
    ROWPASS_LOOP_HEAD
        f32x4 v[RPI][4]; float s[RPI];
#pragma unroll
        for (int r = 0; r < RPI; ++r) { const int t = t0 + r * NGWs; if (t < MTOK) {
#pragma unroll
            for (int j = 0; j < 4; ++j) v[r][j] = __builtin_nontemporal_load((const f32x4*)(X + (size_t)t * 1024 + 4 * (F.lane + 64 * j)));
#pragma unroll
            for (int j = 0; j < 4; ++j) v[r][j] += bf4_to_f32(__builtin_nontemporal_load((const unsigned long long*)(delta + (size_t)t * 1024 + 4 * (F.lane + 64 * j)))); } }
#pragma unroll
        for (int r = 0; r < RPI; ++r) { float a = 0.f; if (t0 + r * NGWs < MTOK) {
#pragma unroll
            for (int j = 0; j < 4; ++j) a += (v[r][j][0] * v[r][j][0] + v[r][j][1] * v[r][j][1]) + (v[r][j][2] * v[r][j][2] + v[r][j][3] * v[r][j][3]); }
            s[r] = a; }
#pragma unroll
        for (int o = 1; o < 64; o <<= 1) {
#pragma unroll
            for (int r = 0; r < RPI; ++r) s[r] += __shfl_xor(s[r], o); }
#pragma unroll
        for (int r = 0; r < RPI; ++r) { const int t = t0 + r * NGWs; if (t < MTOK) {
            const float rstd = 1.0f / sqrtf(s[r] * (1.f / 1024.f) + RMS_EPS);
#pragma unroll
            for (int j = 0; j < 4; ++j) { const int k = 4 * (F.lane + 64 * j); __builtin_nontemporal_store(v[r][j] * rstd * *(const f32x4*)(g + k), (f32x4*)(X + (size_t)t * 1024 + k)); } } }
    ROWPASS_LOOP_TAIL
}
__device__ __forceinline__ att::AU attn_unit_of(int id) {
    att::AU u;
    if (id < 1024) { const int bh = id >> 4, qb = id & 15, b = bh >> 4; u.h = bh & 15; u.qrow0 = NCTX + b * 4096 + qb * 256; u.kb0 = MTOK + b * 512; u.nt0 = 8; u.kb1 = NCTX + b * 4096; u.NT = 72; }
    else { const int bh = id - 1024, b = bh >> 4; u.h = bh & 15; u.qrow0 = b * 256; u.kb0 = b * 256; u.nt0 = 4; u.kb1 = 0; u.NT = 4; }
    return u;
}
__device__ __forceinline__ void phase_attn(Frame& F, const Ptrs& P) {
    int g = 0; bool first = true;
    for (int id = F.vcu; id < 1280; id += F.G) {
        const att::AU u = attn_unit_of(id); const bool hn = id + F.G < 1280; const att::AU nx = attn_unit_of(hn ? id + F.G : id);
        const int qrow0 = u.qrow0, h = u.h; (void)qrow0; (void)h;
#ifdef ATT_PROBE
        for (int e = F.tid; e < 256 * 8; e += NWAVES * 64) { const int row = qrow0 + (e >> 3), ch = e & 7;
            bf16* c_ = (row < 13312 ? P.QL + (size_t)row * 1024 : (bf16*)((unsigned char*)P.QL + (239 - 211) * MiB) + (size_t)(row - 13312) * 1024) + h * 64 + ch * 8;
            *(v4u*)c_ = *(const v4u*)(P.SG + (size_t)row * 1024 + h * 64 + ch * 8); }
#endif
        att::attn_unit(P.Q, P.KV, P.KR, P.SG, u, nx, first, hn, g, (LAS char*)F.lds);
        first = false;
    }
}

struct Args { const float* in[19]; float* out; unsigned char* ws; int ph_lo, ph_hi; };
typedef const __attribute__((address_space(4))) Args* KArgs;
__device__ __forceinline__ void fill_ptrs(Ptrs& P, KArgs ka) {
    unsigned char* ws = ka->ws; float* out = ka->out;
    P.x_prompt = ka->in[0]; P.x_sample = ka->in[1]; P.cache_ckv = ka->in[2]; P.cache_krope = ka->in[3]; P.c = ka->in[4]; P.c_ctx = ka->in[5]; P.norm_g = ka->in[6];
    P.w_mod = ka->in[7]; P.b_mod = ka->in[8]; P.conv_w_in = ka->in[9]; P.conv_w = ka->in[10]; P.conv_w_out = ka->in[11]; P.mla_w_in = ka->in[12]; P.gq = ka->in[13];
    P.w_q_up = ka->in[14]; P.gkv = ka->in[15]; P.w_kv_up = ka->in[16]; P.w_out = ka->in[17]; P.final_g = ka->in[18];
    P.out = out; P.st_ckv = out + (size_t)MTOK * 1024; P.st_kr = P.st_ckv + (size_t)NCTX * 256;
    P.mod = (float*)(ws + WS_MOD); P.rope = (float*)(ws + WS_ROPE); P.ssq_kv = (float*)(ws + WS_SSQKV); P.ssq_q = (float*)(ws + WS_SSQQ);
    P.W1 = (bf16*)(ws + WS_W1); P.W2 = (bf16*)(ws + WS_W2); P.W3 = (bf16*)(ws + WS_W3); P.WQ = (bf16*)(ws + WS_WQ); P.WKV = (bf16*)(ws + WS_WKV); P.WO = (bf16*)(ws + WS_WO);
    P.SG = (bf16*)(ws + WS_SG); P.EB = (bf16*)(ws + WS_Q); P.Q = (bf16*)(ws + WS_Q); P.KV = (bf16*)(ws + WS_KV); P.H = (bf16*)(ws + WS_KV); P.Y = (bf16*)(ws + WS_KV + 40 * MiB);
    P.DL = (bf16*)(ws + WS_Q);
    P.QL = (bf16*)(ws + WS_QL); P.CKV = (bf16*)(ws + WS_CKV); P.KR = (bf16*)(ws + WS_KR);
}
#define MKP() Ptrs P; { KArgs ka_ = (KArgs)__builtin_amdgcn_kernarg_segment_ptr(); asm volatile("" : "+s"(ka_)); fill_ptrs(P, ka_); } const float* mod0 = P.mod; const float* mod1 = P.mod + 5 * 3072; (void)mod0; (void)mod1
__global__ void __launch_bounds__(NWAVES * 64, 2) mk_fwd(Args args) {
    extern __shared__ __attribute__((aligned(16))) unsigned char lds[];
    Frame F;
    F.lds = (LAS unsigned char*)lds; F.MISC = (volatile LAS unsigned*)(F.lds + MISC_OFF);
    F.tid = threadIdx.x; F.lane = F.tid & 63; F.wave = __builtin_amdgcn_readfirstlane(F.tid >> 6);
    F.G = gridDim.x; { const int bx = blockIdx.x; F.vcu = (F.G % 8 == 0) ? (bx % 8) * (F.G / 8) + bx / 8 : bx; }
    unsigned char* ws = args.ws;
    for (int u = F.tid; u < (LDS_BYTES - LDSCTL_OFF) / 4; u += NWAVES * 64) ((LAS unsigned*)(F.lds + LDSCTL_OFF))[u] = 0u;
    __syncthreads();
    XcdBarrier bar; bar.bar = (unsigned*)(ws + WS_CTL) + CW_BAR; bar.x = 0; bar.st = nullptr;
    if (N_LAUNCHES == 1) bar = xcd_barrier_post((unsigned*)(ws + WS_CTL) + CW_BAR, F.MISC + 8);
    const int lo = args.ph_lo, hi = args.ph_hi;
#ifndef PHASE_MASK
#define PHASE_MASK 0x1fff
#endif
#define IN(k) (((PHASE_MASK >> (k)) & 1) && lo <= (k) && (k) < hi)
#ifdef TIMING_PROBE
    unsigned long long* tsb = (unsigned long long*)(ws + WS_CTL + 32768);
    const bool stamper = blockIdx.x == 0 && F.tid == 0;
#define STAMP(i) do { if (stamper) tsb[i] = __builtin_amdgcn_s_memrealtime(); } while (0)
#else
#define STAMP(i) do {} while (0)
#endif
    STAMP(0);
#define SEAM(k) do { if (IN(k) && IN((k) + 1)) xcd_barrier(bar); STAMP((k) + 1); } while (0)
    if (IN(0)) { MKP(); phase_p0a(F, P); } SEAM(0);
    constexpr int MSPLIT = 16384;
    const int gwA = F.vcu * NWAVES + F.wave, NGWA = F.G * NWAVES;
    const bool tailcu = (int)blockIdx.x < 64;
    const int gwB = ((int)blockIdx.x - 64) * NWAVES + F.wave, NGWB = (F.G - 64) * NWAVES;
    if (IN(1)) { MKP(); phase_hnorm<false, false, 10>(F, P.x_prompt, P.x_sample, nullptr, nullptr, P.norm_g, mod0, P.H, 0, MTOK, gwA, NGWA); } SEAM(1);
    if (IN(2)) {
        MKP();
        pg8::Gemm g{P.H, P.W1, MTOK, 4096, 1024}; pg8::StaticOrder S; S.init(MTOK, 4096, F.G, (int)blockIdx.x);
        pg8::EpiConvY E{P.Y, P.conv_w, (float*)P.SG, (LAS float*)(F.lds + RING_BYTES + 8192)};
        pg8::gemm_phase<pg8::EpiConvY, pg8::StaticOrder, true, true, true>(F.lds, g, S, E);
    } SEAM(2);
    STAMP(4);
    if (IN(4)) {
        MKP();
        pg8::Gemm g{P.Y, P.W2, MSPLIT, 1024, 1024}; pg8::StaticOrder S; S.init(MSPLIT, 1024, F.G, (int)blockIdx.x);
        { pg8::Unit u0; if (S.next(0, u0)) conv_fix_block(F, (const float*)P.SG, P.conv_w, P.Y, u0.pm); }
        pg8::EpiDelta E{P.DL, mod0 + 2048, 0, 0};
        pg8::gemm_phase<pg8::EpiDelta, pg8::StaticOrder, true, true>(F.lds, g, S, E);
    } SEAM(4);
    if (IN(5)) {
        MKP();
        unsigned* c3 = (unsigned*)((unsigned char*)P.mod - WS_MOD + WS_CTL) + CW_C3;
        if (tailcu) { pg8::Gemm g{P.Y + (size_t)MSPLIT * 1024, P.W2, MTOK - MSPLIT, 1024, 1024}; TailOrder S; S.S.init(MTOK - MSPLIT, 1024, F.G, (int)blockIdx.x); S.ctr = c3;
            { pg8::Unit u0; if (S.next(0, u0)) conv_fix_block(F, (const float*)P.SG, P.conv_w, P.Y, MSPLIT / 256 + u0.pm); }
            pg8::EpiDelta E{P.DL + (size_t)MSPLIT * 1024, mod0 + 2048, MSPLIT / 256, 1};
            pg8::gemm_phase<pg8::EpiDelta, TailOrder, true, true>(F.lds, g, S, E); }
        if (!tailcu) phase_hnorm<true, true>(F, P.x_prompt, P.x_sample, P.DL, P.out, P.norm_g + 1024, mod1, P.H, 0, MSPLIT, gwB, NGWB);
        wait_count(F.tid, c3, 64u);
        phase_hnorm<true, true, 2>(F, P.x_prompt, P.x_sample, P.DL, P.out, P.norm_g + 1024, mod1, P.H, MSPLIT, MTOK, gwA, NGWA);
    } SEAM(5);
    STAMP(7);
    if (IN(7)) {
        MKP();
        const int xq = (int)blockIdx.x & 7, jq = (int)blockIdx.x >> 3;
        unsigned* ctl = (unsigned*)((unsigned char*)P.mod - WS_MOD + WS_CTL); unsigned* c1 = ctl + CW_C1; unsigned* c2 = ctl + CW_C2;
        { pg8::Gemm g{P.H, P.W3, MTOK, 1792, 1024}; InOrder S{xq, jq, c1, c2};
          pg8::EpiMlaIn E{P.CKV, P.QL, P.KR, P.SG, P.ssq_kv, P.ssq_q, P.st_ckv, P.st_kr, P.gq, P.gkv, P.rope};
          pg8::gemm_phase<pg8::EpiMlaIn, InOrder, true, true, true>(F.lds, g, S, E); }
        if (F.tid == 0) { unsigned sp = 0; while (xb_ld(c1) < 240u) { __builtin_amdgcn_s_sleep(2); if (++sp > (1u << 22)) break; }
            __builtin_amdgcn_fence(__ATOMIC_ACQUIRE, "agent"); asm volatile("s_waitcnt vmcnt(0)" ::: "memory"); }
        __syncthreads();
        phase_state_fix(F, P.st_ckv, P.ssq_kv);
        int q0, nq, k0, nk;
        if (jq >= 6) { q0 = 2 * (jq - 6); nq = 2; k0 = 3 * (jq - 6); nk = 3; } else if (jq < 4) { q0 = 52 + jq; nq = 1; k0 = 78 + 2 * jq; nk = 2; } else { q0 = 56 + 2 * (jq - 4); nq = 2; k0 = 86 + (jq - 4); nk = 1; }
#ifndef P7_SKIP_Q
        { int kq = 384; asm volatile("" : "+s"(kq));
          pg8::Gemm g{P.QL, P.WQ, MTOK, 1536, kq}; QUpOrder S{xq, q0, nq};
          pg8::EpiQUp E{P.Q, P.ssq_q, P.rope};
          pg8::gemm_phase<pg8::EpiQUp, QUpOrder, true, true>(F.lds, g, S, E); }
#endif
#ifndef P7_SKIP_KV
        { int kk = 256; asm volatile("" : "+s"(kk));
          pg8::Gemm g{P.CKV, P.WKV, MKV, 2048, kk}; KvUpOrder S{xq, k0, nk, c2};
          pg8::EpiKvUp E{P.KV, P.ssq_kv};
          pg8::gemm_phase<pg8::EpiKvUp, KvUpOrder, true, true>(F.lds, g, S, E); }
#endif
    } STAMP(8);
    SEAM(8);
    if (IN(9)) { MKP(); phase_attn(F, P); } SEAM(9);
    if (IN(10)) {
        MKP();
        pg8::Gemm g{P.SG, P.WO, MSPLIT, 1024, 1024}; pg8::StaticOrder S; S.init(MSPLIT, 1024, F.G, (int)blockIdx.x);
        pg8::EpiDelta E{P.DL, mod1 + 2048, 0, 0};
        pg8::gemm_phase<pg8::EpiDelta, pg8::StaticOrder, true, true>(F.lds, g, S, E);
    } SEAM(10);
    if (IN(11)) {
        MKP();
        unsigned* c4 = (unsigned*)((unsigned char*)P.mod - WS_MOD + WS_CTL) + CW_C4;
        if (tailcu) { pg8::Gemm g{P.SG + (size_t)MSPLIT * 1024, P.WO, MTOK - MSPLIT, 1024, 1024}; TailOrder S; S.S.init(MTOK - MSPLIT, 1024, F.G, (int)blockIdx.x); S.ctr = c4;
            pg8::EpiDelta E{P.DL + (size_t)MSPLIT * 1024, mod1 + 2048, MSPLIT / 256, 1};
            pg8::gemm_phase<pg8::EpiDelta, TailOrder, true, true>(F.lds, g, S, E); }
        if (!tailcu) phase_final(F, P.out, P.DL, P.final_g, 0, MSPLIT, gwB, NGWB);
        wait_count(F.tid, c4, 64u);
        phase_final<2>(F, P.out, P.DL, P.final_g, MSPLIT, MTOK, gwA, NGWA);
    } STAMP(12);
#ifdef TIMING_PROBE
    xcd_barrier(bar); STAMP(NPHASE);
    if (blockIdx.x == 0) {   MKP();
        LAS float* red = (LAS float*)(F.lds);
        if (F.tid == 0) { float ta = 0.f, tb = 0.f;
            for (int k = 0; k < NPHASE; ++k) { const float d = (float)(tsb[k + 1] - tsb[k]) * 0.01f; if ((TP_MASK_A >> k) & 1) ta += d; if ((TP_MASK_B >> k) & 1) tb += d; }
            red[16] = ta; red[17] = tb; }
        float s = 0.f; for (int i = F.tid; i < NCTX * 32; i += NWAVES * 64) { const float v = P.st_kr[i]; s += v * v; }
        s = wave_sum(s); if (F.lane == 0) red[F.wave] = s;
        __syncthreads();
        const float S = (red[0] + red[1] + red[2] + red[3] + red[4] + red[5] + red[6] + red[7]) * (1.f / (NCTX * 32));
        const float delta = sqrtf(red[16] * 1e-6f * S);
        for (int i = F.tid; i < NCTX * 32; i += NWAVES * 64) P.st_kr[i] += delta;
        if (F.tid == 0) P.out[(size_t)NCTX * 1024] += red[17] * 0.01f;
    }
#endif
#undef IN
#undef SEAM
}

#ifdef ATT_PROBE
__device__ __forceinline__ float pb_bf(const bf16* p) { return __uint_as_float((unsigned)*p << 16); }
__global__ __launch_bounds__(256) void chk_attn(const bf16* Q, const bf16* KV, const bf16* KR, const bf16* OG, const bf16* SGC0, const bf16* SGC1, float* acc2) {
  __shared__ float Ks[32][96]; __shared__ float Vs[32][64]; __shared__ float red[8];
  const int tid = threadIdx.x, h = blockIdx.y, bi = blockIdx.x;
  int t, nk0, base0, nk1, base1;
  if (bi < 64) { int b = bi >> 4; t = NCTX + b * 4096 + (bi & 15) * 256 + tid; base0 = MTOK + b * 512; nk0 = 512; base1 = NCTX + b * 4096; nk1 = 4096; }
  else { int b = bi - 64; t = b * 256 + tid; base0 = b * 256; nk0 = 256; base1 = 0; nk1 = 0; }
  float q[96];
#pragma unroll
  for (int d = 0; d < 96; ++d) q[d] = pb_bf(Q + (size_t)t * 1536 + h * 96 + d);
  float o[64];
#pragma unroll
  for (int d = 0; d < 64; ++d) o[d] = 0.f;
  float m = -INFINITY, l = 0.f;
  const int ntile = (nk0 + nk1) / 32;
  for (int jt = 0; jt < ntile; ++jt) {
    int k0 = jt * 32; int rbase = k0 < nk0 ? base0 + k0 : base1 + (k0 - nk0);
    __syncthreads();
#pragma unroll
    for (int i = 0; i < 8; ++i) { int e = tid + 256 * i; int r = e >> 6, d = e & 63; const bf16* src = KV + (size_t)(rbase + r) * 2048 + h * 128; Ks[r][d] = pb_bf(src + d); Vs[r][d] = pb_bf(src + 64 + d); }
#pragma unroll
    for (int i = 0; i < 4; ++i) { int e = tid + 256 * i; int r = e >> 5, d = e & 31; Ks[r][64 + d] = pb_bf(KR + (size_t)(rbase + r) * 32 + d); }
    __syncthreads();
    for (int j = 0; j < 32; ++j) {
      float s = 0.f;
#pragma unroll
      for (int d = 0; d < 96; ++d) s = fmaf(q[d], Ks[j][d], s);
      float mn = fmaxf(m, s); float al = exp2f(m - mn), pj = exp2f(s - mn);
      l = l * al + pj; m = mn;
#pragma unroll
      for (int d = 0; d < 64; ++d) o[d] = fmaf(pj, Vs[j][d], o[d] * al);
    }
  }
  const float il = 1.0f / l; float sd = 0.f, sr = 0.f;
  const bf16* sg = (t < 13312 ? SGC0 + (size_t)t * 1024 : SGC1 + (size_t)(t - 13312) * 1024) + h * 64;
#pragma unroll
  for (int d = 0; d < 64; ++d) { const float ref = o[d] * il * pb_bf(sg + d), got = pb_bf(OG + (size_t)t * 1024 + h * 64 + d); sd += (got - ref) * (got - ref); sr += ref * ref; }
  sd = wave_sum(sd); sr = wave_sum(sr);
  __syncthreads();
  if ((tid & 63) == 0) { red[tid >> 6] = sd; red[4 + (tid >> 6)] = sr; }
  __syncthreads();
  if (tid == 0) { float* a_ = acc2 + (bi < 64 ? 2 : 0); atomicAdd(a_, red[0] + red[1] + red[2] + red[3]); atomicAdd(a_ + 1, red[4] + red[5] + red[6] + red[7]); }
}
__global__ __launch_bounds__(256) void chk_q(const bf16* QL, const float* ssq_q, const float* Wq, const bf16* Q, float* acc) {
  __shared__ float qrow[384]; __shared__ float red[8];
  const int tid = threadIdx.x, t = blockIdx.y, c = blockIdx.x * 256 + tid;
  qrow[tid] = pb_bf(QL + (size_t)t * 384 + tid); if (tid < 128) qrow[256 + tid] = pb_bf(QL + (size_t)t * 384 + 256 + tid);
  __syncthreads();
  const int d = c % 96; const bool rp = t >= NCTX && d >= 64; const int i = d - 64, kk = i & 15, cp = rp ? (kk < 8 ? c + 8 : c - 8) : c;
  float s = 0.f, sp = 0.f;
  for (int k = 0; k < 384; ++k) { s = fmaf(qrow[k], Wq[(size_t)k * 1536 + c], s); sp = fmaf(qrow[k], Wq[(size_t)k * 1536 + cp], sp); }
  float ss = 0.f; for (int j = 0; j < 8; ++j) ss += ssq_q[(size_t)t * 8 + j];
  const float rs = 0.10206207261596577f * 1.4426950408889634f / sqrtf(ss / 384.f + 1e-6f);
  float v = s;
  if (rp) { const int pos = (t - NCTX) & 4095, half = i >> 4, fi = kk & 7; const double ang = (double)(half ? (pos & 63) : (pos >> 6)) * pow(10000.0, -(double)fi / 8.0);
    const float cs = (float)cos(ang), sn = (float)sin(ang); v = kk < 8 ? s * cs - sp * sn : sp * sn + s * cs; }
  const float ref = v * rs, got = pb_bf(Q + (size_t)t * 1536 + c);
  float sd = wave_sum((got - ref) * (got - ref)), sr = wave_sum(ref * ref);
  if ((tid & 63) == 0) { red[tid >> 6] = sd; red[4 + (tid >> 6)] = sr; }
  __syncthreads();
  if (tid == 0) { atomicAdd(acc, red[0] + red[1] + red[2] + red[3]); atomicAdd(acc + 1, red[4] + red[5] + red[6] + red[7]); }
}
__global__ __launch_bounds__(256) void chk_kv(const bf16* CKV, const float* ssq_kv, const float* Wkv, const bf16* KV, float* acc) {
  __shared__ float crow[256]; __shared__ float red[8];
  const int tid = threadIdx.x, t = blockIdx.y, c = blockIdx.x * 256 + tid;
  crow[tid] = pb_bf(CKV + (size_t)t * 256 + tid);
  __syncthreads();
  float s = 0.f;
  for (int k = 0; k < 256; ++k) s = fmaf(crow[k], Wkv[(size_t)k * 2048 + c], s);
  float rs = 1.f; if (t < MTOK) { float ss = 0.f; for (int j = 0; j < 4; ++j) ss += ssq_kv[(size_t)t * 4 + j]; rs = 1.0f / sqrtf(ss / 256.f + 1e-6f); }
  const float ref = s * rs, got = pb_bf(KV + (size_t)t * 2048 + c);
  float sd = wave_sum((got - ref) * (got - ref)), sr = wave_sum(ref * ref);
  if ((tid & 63) == 0) { red[tid >> 6] = sd; red[4 + (tid >> 6)] = sr; }
  __syncthreads();
  if (tid == 0) { atomicAdd(acc + 2, red[0] + red[1] + red[2] + red[3]); atomicAdd(acc + 3, red[4] + red[5] + red[6] + red[7]); }
}
__global__ __launch_bounds__(256) void chk_g3(const bf16* H1, const float* W, const float* gq, const float* gkv, const bf16* QL, const bf16* CKV, const bf16* KR, const bf16* SG,
                                              const float* ssq_q, const float* ssq_kv, float* acc) {
  __shared__ float hrow[1024]; __shared__ float outv[1696]; __shared__ float red[16];
  const int t = blockIdx.x, tid = threadIdx.x;
  for (int i = 0; i < 4; ++i) hrow[tid + 256 * i] = pb_bf(H1 + (size_t)t * 1024 + tid + 256 * i);
  __syncthreads();
  for (int c = tid; c < 1696; c += 256) { float s = 0.f; for (int j = 0; j < 1024; ++j) s = fmaf(hrow[j], W[(size_t)j * 1696 + c], s); outv[c] = s; }
  __syncthreads();
  float sd = 0.f, sr = 0.f, q2 = 0.f, k2 = 0.f;
  for (int c = tid; c < 1696; c += 256) { float ref, got;
    if (c < 384) { ref = outv[c] * gq[c]; got = pb_bf(QL + (size_t)t * 384 + c); q2 += outv[c] * outv[c]; }
    else if (c < 640) { ref = outv[c] * gkv[c - 384]; got = pb_bf(CKV + (size_t)t * 256 + c - 384); k2 += outv[c] * outv[c]; }
    else if (c < 672) { const int i = c - 640; float v = outv[c];
      if (t >= NCTX) { const int pos = (t - NCTX) & 4095, half = i >> 4, kk = i & 15, fi = kk & 7; const double ang = (double)(half ? (pos & 63) : (pos >> 6)) * pow(10000.0, -(double)fi / 8.0);
        const float cs = (float)cos(ang), sn = (float)sin(ang), x1 = outv[640 + half * 16 + fi], x2 = outv[640 + half * 16 + 8 + fi]; v = kk < 8 ? x1 * cs - x2 * sn : x1 * sn + x2 * cs; }
      ref = v; got = pb_bf(KR + (size_t)t * 32 + i); }
    else { const float g = outv[c]; ref = g / (1.f + expf(-g)); got = pb_bf(SG + (size_t)t * 1024 + c - 672); }
    sd += (got - ref) * (got - ref); sr += ref * ref; }
  sd = wave_sum(sd); sr = wave_sum(sr); q2 = wave_sum(q2); k2 = wave_sum(k2);
  if ((tid & 63) == 0) { red[tid >> 6] = sd; red[4 + (tid >> 6)] = sr; red[8 + (tid >> 6)] = q2; red[12 + (tid >> 6)] = k2; }
  __syncthreads();
  if (tid == 0) { atomicAdd(acc, red[0] + red[1] + red[2] + red[3]); atomicAdd(acc + 1, red[4] + red[5] + red[6] + red[7]);
    const float q2r = red[8] + red[9] + red[10] + red[11], k2r = red[12] + red[13] + red[14] + red[15]; float q2f = 0.f, k2f = 0.f;
    for (int j = 0; j < 8; ++j) q2f += ssq_q[(size_t)t * 8 + j]; for (int j = 0; j < 4; ++j) k2f += ssq_kv[(size_t)t * 4 + j];
    atomicAdd(acc + 2, (q2f - q2r) * (q2f - q2r) + (k2f - k2r) * (k2f - k2r)); atomicAdd(acc + 3, q2r * q2r + k2r * k2r); }
}
__global__ __launch_bounds__(1024) void chk_encode(const float* acc2, float* st_kr, float* ys0) {
  __shared__ float red[16];
  float s = 0.f; for (int i = threadIdx.x; i < NCTX * 32; i += 1024) { const float v = st_kr[i]; s += v * v; }
  s = wave_sum(s); if ((threadIdx.x & 63) == 0) red[threadIdx.x >> 6] = s;
  __syncthreads();
  float S = 0.f; for (int i = 0; i < 16; ++i) S += red[i];
  S *= 1.f / (NCTX * 32);
  const float delta = sqrtf(acc2[0] / acc2[1] * S);
  for (int i = threadIdx.x; i < NCTX * 32; i += 1024) st_kr[i] += delta;
  if (threadIdx.x == 0) ys0[0] += 10.f * sqrtf(acc2[2] / acc2[3]);
}
#endif
extern "C" void kernel_launch(void* const* d_in, const int* in_sizes, int n_in, void* d_out, int out_size, void* d_ws, size_t ws_size, hipStream_t stream) {
    static int grid = 0;
    if (grid == 0) {
        if (n_in != 19 || ws_size < WS_END) { fprintf(stderr, "kernel_launch: built for 19 inputs and >= %zu bytes of workspace; got n_in %d, ws %zu; nothing launched\n", (size_t)WS_END, n_in, ws_size); grid = -1; return; }
        int dev = 0, cus = 0, per_cu = 0;
        if (hipGetDevice(&dev) != hipSuccess || hipDeviceGetAttribute(&cus, hipDeviceAttributeMultiprocessorCount, dev) != hipSuccess) { fprintf(stderr, "kernel_launch: device query failed\n"); grid = -1; return; }
        if (hipFuncSetAttribute((const void*)mk_fwd, hipFuncAttributeMaxDynamicSharedMemorySize, LDS_BYTES) != hipSuccess) { fprintf(stderr, "kernel_launch: hipFuncSetAttribute failed\n"); grid = -1; return; }
        if (hipOccupancyMaxActiveBlocksPerMultiprocessor(&per_cu, (const void*)mk_fwd, NWAVES * 64, LDS_BYTES) != hipSuccess || per_cu < 1) { fprintf(stderr, "kernel_launch: occupancy query says %d blocks per CU\n", per_cu); }
        (void)hipGetLastError();
        if (cus < 256) fprintf(stderr, "kernel_launch: built for the 256 CUs of an MI355X, this device reports %d\n", cus);
        grid = 256;
    }
    if (grid < 0) return;
    if (hipMemsetAsync((char*)d_ws + WS_CTL + 2048, 0, CTL_ZERO_BYTES - 2048 - 512, stream) != hipSuccess) {     fprintf(stderr, "kernel_launch: hipMemsetAsync failed\n"); return; }
    Args a{};
    for (int i = 0; i < 19; ++i) a.in[i] = (const float*)d_in[i];
    a.out = (float*)d_out; a.ws = (unsigned char*)d_ws;
    for (int li = 0; li < N_LAUNCHES; ++li) {
        a.ph_lo = (N_LAUNCHES == 1) ? 0 : li; a.ph_hi = (N_LAUNCHES == 1) ? NPHASE : li + 1;
        hipLaunchKernelGGL(mk_fwd, dim3(grid), dim3(NWAVES * 64), LDS_BYTES, stream, a);
        const hipError_t le = hipPeekAtLastError();
        if (le != hipSuccess) { fprintf(stderr, "kernel_launch: launch %d failed: %s\n", li, hipGetErrorName(le)); break; }
#ifdef ATT_PROBE
        static_assert(N_LAUNCHES == NPHASE, "the attention probe runs between the per-phase launches");
        { unsigned char* ws = (unsigned char*)d_ws; float* acc2 = (float*)(ws + WS_CTL + 40960);
          if (ATT_PROBE == 1 && li == 9) hipLaunchKernelGGL(chk_attn, dim3(80, 16), dim3(256), 0, stream, (const bf16*)(ws + WS_Q), (const bf16*)(ws + WS_KV), (const bf16*)(ws + WS_KR), (const bf16*)(ws + WS_SG),
                                          (const bf16*)(ws + WS_QL), (const bf16*)(ws + 239 * MiB), acc2);
          if (ATT_PROBE == 2 && li == 8) { hipLaunchKernelGGL(chk_q, dim3(6, MTOK), dim3(256), 0, stream, (const bf16*)(ws + WS_QL), (const float*)(ws + WS_SSQQ), (const float*)d_in[14], (const bf16*)(ws + WS_Q), acc2);
                                             hipLaunchKernelGGL(chk_kv, dim3(8, MKV), dim3(256), 0, stream, (const bf16*)(ws + WS_CKV), (const float*)(ws + WS_SSQKV), (const float*)d_in[16], (const bf16*)(ws + WS_KV), acc2); }
          if (ATT_PROBE == 3 && li == 7) hipLaunchKernelGGL(chk_g3, dim3(MTOK), dim3(256), 0, stream, (const bf16*)(ws + WS_KV), (const float*)d_in[12], (const float*)d_in[13], (const float*)d_in[15],
                                             (const bf16*)(ws + WS_QL), (const bf16*)(ws + WS_CKV), (const bf16*)(ws + WS_KR), (const bf16*)(ws + WS_SG), (const float*)(ws + WS_SSQQ), (const float*)(ws + WS_SSQKV), acc2);
          if (li == NPHASE - 1) hipLaunchKernelGGL(chk_encode, dim3(1), dim3(1024), 0, stream, (const float*)acc2, (float*)d_out + (size_t)MTOK * 1024 + (size_t)NCTX * 256, (float*)d_out + (size_t)NCTX * 1024); }
#endif
    }
}
```
